# Optimizing an MI355X kernel written in HIP

```python
import jax, jax.numpy as jnp
from jax import lax
import numpy as np

D_MODEL = 1024
BATCH = 16
SEQ = 2048
DEPTH = 2

GRID_W = 64
CTX_LEN = 256
HEAD_DIM = 64
NA_HEADS = 8
NA_WIDTH = NA_HEADS * HEAD_DIM
KH_MAX = 8
KW = 16
FN_GROUPS = 8
FN_GROUP_DIM = 64
FN_WIDTH = FN_GROUPS * FN_GROUP_DIM
AB_IN = 3 * NA_WIDTH + FN_WIDTH
AB_OUT = NA_WIDTH + FN_WIDTH
CONV_K = 3
PEER_HEADS = 8
PEER_NKEYS = 128
PEER_EXPERTS = PEER_NKEYS * PEER_NKEYS
PEER_DK = 256
PEER_DK_HALF = PEER_DK // 2
PEER_TOPK = 16
PEER_BLOCK = 128
EPS = 1e-6

kernel_name = "hybrid_natten_fnet_shortconv_peer_dit"


def rmsnorm(x, g):
    x32 = x.astype(jnp.float32)
    y = x32 * lax.rsqrt(jnp.mean(x32 * x32, axis=-1, keepdims=True) + EPS)
    return y.astype(x.dtype) * g


def adaln_chunks(cvec, w, b):
    m = jax.nn.silu(cvec) @ w + b
    return jnp.split(m.reshape(-1, 1, m.shape[-1]), 6, axis=-1)


def modulate(x, shift, scale):
    return x * (1 + scale) + shift


def split_heads(t):
    b, n, _ = t.shape
    return t.reshape(b, n, NA_HEADS, HEAD_DIM)


def neighbourhood_attention(q, k, v, k_ctx, v_ctx, rpb):
    b, s, h, dh = q.shape
    rows = s // GRID_W
    kh = min(KH_MAX, rows)
    qg = (q * dh ** -0.5).reshape(b, rows, GRID_W, h, dh)
    kg = k.reshape(b, rows, GRID_W, h, dh)
    vg = v.reshape(b, rows, GRID_W, h, dh)
    cols = np.arange(GRID_W)
    col_start = np.clip(cols - KW // 2, 0, GRID_W - KW)
    in_win = (cols[None, :] >= col_start[:, None]) & (cols[None, :] < col_start[:, None] + KW)
    col_off = np.clip(cols[None, :] - cols[:, None] + KW - 1, 0, 2 * KW - 2)
    rpb32 = rpb.astype(jnp.float32)
    n_win = kh * GRID_W

    def row_step(r):
        start = jnp.clip(r - kh // 2, 0, rows - kh)
        q_r = lax.dynamic_index_in_dim(qg, r, axis=1, keepdims=False)
        k_b = lax.dynamic_slice_in_dim(kg, start, kh, axis=1)
        v_b = lax.dynamic_slice_in_dim(vg, start, kh, axis=1)
        row_off = start + jnp.arange(kh) - r + KH_MAX - 1
        bias = rpb32[:, row_off[:, None, None], col_off[None]]
        bias = jnp.where(in_win[None, None], bias, -jnp.inf).transpose(0, 2, 1, 3)
        s_win = jnp.einsum('bqhd,brkhd->bhqrk', q_r, k_b).astype(jnp.float32) + bias
        s_ctx = jnp.einsum('bqhd,blhd->bhql', q_r, k_ctx).astype(jnp.float32)
        logits = jnp.concatenate([s_win.reshape(b, h, GRID_W, n_win), s_ctx], axis=-1)
        p = jax.nn.softmax(logits, axis=-1).astype(v.dtype)
        p_win = p[..., :n_win].reshape(b, h, GRID_W, kh, GRID_W)
        p_ctx = p[..., n_win:]
        return (jnp.einsum('bhqrk,brkhd->bqhd', p_win, v_b)
                + jnp.einsum('bhql,blhd->bqhd', p_ctx, v_ctx))

    out = lax.map(row_step, jnp.arange(rows))
    return out.transpose(1, 0, 2, 3, 4).reshape(b, s, h * dh)


def context_attention(q, k, v):
    b, n, h, dh = q.shape
    s = jnp.einsum('bqhd,bkhd->bhqk', q * dh ** -0.5, k).astype(jnp.float32)
    p = jax.nn.softmax(s, axis=-1).astype(v.dtype)
    return jnp.einsum('bhqk,bkhd->bqhd', p, v).reshape(b, n, h * dh)


def fourier_mix(f, w):
    b, n, _ = f.shape
    fg = f.reshape(b, n, FN_GROUPS, FN_GROUP_DIM).astype(jnp.float32)
    spec = jnp.fft.fft2(fg, axes=(1, 3), norm="ortho").real.astype(f.dtype)
    return jnp.einsum('bngc,gce->bnge', spec, w).reshape(b, n, FN_WIDTH)


def ab_mixer(h, h_ctx, w_in, w_out, rpb, fn_w, ctx_out):
    q, k, v, f = jnp.split(h @ w_in, [NA_WIDTH, 2 * NA_WIDTH, 3 * NA_WIDTH], axis=-1)
    kc, vc = jnp.split(h_ctx @ w_in[:, NA_WIDTH:3 * NA_WIDTH], 2, axis=-1)
    kc, vc = split_heads(kc), split_heads(vc)
    a = neighbourhood_attention(split_heads(q), split_heads(k), split_heads(v), kc, vc, rpb)
    out = jnp.concatenate([a, fourier_mix(f, fn_w)], axis=-1) @ w_out
    if not ctx_out:
        return out, None
    qc = split_heads(h_ctx @ w_in[:, :NA_WIDTH])
    fc = h_ctx @ w_in[:, 3 * NA_WIDTH:]
    out_c = jnp.concatenate([context_attention(qc, kc, vc), fourier_mix(fc, fn_w)], axis=-1) @ w_out
    return out, out_c


def conv_mixer(h, w_in, conv_w, w_out):
    bg, cg, v = jnp.split(h @ w_in, 3, axis=-1)
    u = jnp.pad(cg * v, ((0, 0), (1, 1), (0, 0)))
    y = conv_w[0] * u[:, :-2] + conv_w[1] * u[:, 1:-1] + conv_w[2] * u[:, 2:]
    return (bg * y) @ w_out


def peer(h, w_q, keys, down, up):
    shape = h.shape
    blocks = h.reshape(-1, PEER_BLOCK, shape[-1])

    def block_fn(hb):
        t = hb.shape[0]
        q = (hb @ w_q).reshape(t, PEER_HEADS, 2, PEER_DK_HALF)
        s = jnp.einsum('thpk,hpnk->thpn', q, keys).astype(jnp.float32)
        vals, idx = lax.top_k(s, PEER_TOPK)
        cand = (vals[:, :, 0, :, None] + vals[:, :, 1, None, :]).reshape(t, PEER_HEADS, PEER_TOPK * PEER_TOPK)
        cand_idx = (idx[:, :, 0, :, None] * PEER_NKEYS + idx[:, :, 1, None, :]).reshape(t, PEER_HEADS, PEER_TOPK * PEER_TOPK)
        top_s, pos = lax.top_k(cand, PEER_TOPK)
        eidx = jnp.take_along_axis(cand_idx, pos, axis=-1)
        g = jax.nn.softmax(top_s, axis=-1)
        act = jax.nn.gelu(jnp.einsum('td,thkd->thk', hb, down[eidx]).astype(jnp.float32), approximate=False)
        w_e = (g * act).astype(hb.dtype)
        return jnp.einsum('thk,thkd->td', w_e, up[eidx])

    return lax.map(block_fn, blocks).reshape(shape)


def setup_inputs(seed: int = 0) -> dict:
    key = jax.random.key(seed)
    ks = jax.random.split(key, 20)
    n_even = (DEPTH + 1) // 2
    n_odd = DEPTH // 2
    D = D_MODEL

    def nrm(k, shape, scale):
        return jax.random.normal(k, shape, jnp.float32) * scale

    return {
        "x": nrm(ks[0], (BATCH, SEQ, D), 1.0),
        "c": nrm(ks[1], (BATCH, D), 1.0),
        "ctx": nrm(ks[2], (BATCH, CTX_LEN, D), 1.0),
        "c_ctx": nrm(ks[3], (D,), 1.0),
        "ada_w": nrm(ks[4], (DEPTH, D, 6 * D), 0.5 * D ** -0.5),
        "ada_b": nrm(ks[5], (DEPTH, 6 * D), 0.02),
        "norm1_g": 1.0 + nrm(ks[6], (DEPTH, D), 0.02),
        "norm2_g": 1.0 + nrm(ks[7], (DEPTH, D), 0.02),
        "final_g": 1.0 + nrm(ks[8], (D,), 0.02),
        "ab_w_in": nrm(ks[9], (n_even, D, AB_IN), D ** -0.5),
        "ab_w_out": nrm(ks[10], (n_even, AB_OUT, D), AB_OUT ** -0.5),
        "na_rpb": nrm(ks[11], (n_even, NA_HEADS, 2 * KH_MAX - 1, 2 * KW - 1), 0.2),
        "fn_w": nrm(ks[12], (n_even, FN_GROUPS, FN_GROUP_DIM, FN_GROUP_DIM), FN_GROUP_DIM ** -0.5),
        "cv_w_in": nrm(ks[13], (n_odd, D, 3 * D), D ** -0.5),
        "cv_w": nrm(ks[14], (n_odd, CONV_K, D), CONV_K ** -0.5),
        "cv_w_out": nrm(ks[15], (n_odd, D, D), D ** -0.5),
        "peer_w_q": nrm(ks[16], (DEPTH, D, PEER_HEADS * PEER_DK), D ** -0.5),
        "peer_keys": nrm(ks[17], (DEPTH, PEER_HEADS, 2, PEER_NKEYS, PEER_DK_HALF), PEER_DK_HALF ** -0.5),
        "peer_down": nrm(ks[18], (DEPTH, PEER_EXPERTS, D), D ** -0.5),
        "peer_up": nrm(ks[19], (DEPTH, PEER_EXPERTS, D), PEER_HEADS ** -0.5),
    }


def reference(x, c, ctx, c_ctx, ada_w, ada_b, norm1_g, norm2_g, final_g,
              ab_w_in, ab_w_out, na_rpb, fn_w, cv_w_in, cv_w, cv_w_out,
              peer_w_q, peer_keys, peer_down, peer_up):
    for i in range(DEPTH):
        even = i % 2 == 0
        upd_ctx = any(j % 2 == 0 for j in range(i + 1, DEPTH))
        sh1, sc1, g1, sh2, sc2, g2 = adaln_chunks(c, ada_w[i], ada_b[i])
        h = modulate(rmsnorm(x, norm1_g[i]), sh1, sc1)
        if even or upd_ctx:
            csh1, csc1, cg1, csh2, csc2, cg2 = adaln_chunks(c_ctx, ada_w[i], ada_b[i])
            hc = modulate(rmsnorm(ctx, norm1_g[i]), csh1, csc1)
        if even:
            e = i // 2
            out, out_c = ab_mixer(h, hc, ab_w_in[e], ab_w_out[e], na_rpb[e], fn_w[e], upd_ctx)
        else:
            o = i // 2
            out = conv_mixer(h, cv_w_in[o], cv_w[o], cv_w_out[o])
            out_c = conv_mixer(hc, cv_w_in[o], cv_w[o], cv_w_out[o]) if upd_ctx else None
        x = x + g1 * out
        x = x + g2 * peer(modulate(rmsnorm(x, norm2_g[i]), sh2, sc2),
                          peer_w_q[i], peer_keys[i], peer_down[i], peer_up[i])
        if upd_ctx:
            ctx = ctx + cg1 * out_c
            ctx = ctx + cg2 * peer(modulate(rmsnorm(ctx, norm2_g[i]), csh2, csc2),
                                   peer_w_q[i], peer_keys[i], peer_down[i], peer_up[i])
    return rmsnorm(x, final_g)
```

```cpp
#include <hip/hip_runtime.h>
#include <cstdio>
#include <cstdint>

#ifndef MK_N_LAUNCHES
#define MK_N_LAUNCHES 1
#endif

#ifndef PROBE_PHASE
#define PROBE_PHASE (-1)
#endif
#ifndef PROBE_SUB
#define PROBE_SUB 0
#endif
#define NREP(k) ((PROBE_PHASE == (k)) ? 2 : 1)
#define LAS __attribute__((address_space(3)))
typedef unsigned short bf16;
typedef short bf16x8 __attribute__((ext_vector_type(8)));
typedef float f32x4 __attribute__((ext_vector_type(4)));
typedef unsigned u32x4 __attribute__((ext_vector_type(4)));
typedef unsigned u32x2 __attribute__((ext_vector_type(2)));
typedef __bf16 bf16v2 __attribute__((ext_vector_type(2)));

namespace pg8 {
#define PG8_LAS __attribute__((address_space(3)))
typedef unsigned short bf16_t;
constexpr int BM = 256, BK = 64, HALF = 128, HTB = HALF * BK * 2, STAGE_BYTES = 8 * HTB, NXCD = 8, WGM = 8;

__host__ __device__ __forceinline__ int lds_byte(int r, int c) { const int st = (r >> 4) * 2 + (c >> 5), rr = r & 15, cc = c & 31, ob = rr * 64 + cc * 2; return st * 1024 + (ob ^ (((ob >> 9) & 1) << 5)); }
__host__ __device__ __forceinline__ void stage_rc(int b, int& R, int& C) { const int st = b / 1024, sb = b % 1024, swz = sb ^ (((sb >> 9) & 1) << 5); R = (st >> 1) * 16 + swz / 64; C = (st & 1) * 32 + (swz % 64) / 2; }
__host__ __device__ __forceinline__ int perm32(int rho) { const int n = rho >> 4, i = rho & 15; return 8 * (i >> 2) + 4 * n + (i & 3); }

struct Unit { int pm, pn; };
struct Gemm { const bf16_t* A; const bf16_t* Bt; int M, N, K; };

struct StaticOrder {
    int nM, nN, nwg, G, c;
    __host__ __device__ void init(int M, int N, int G_, int c_) { nM = M / BM; nN = N / BM; nwg = nM * nN; G = G_; c = c_; }
    __host__ __device__ bool next(int i, Unit& u) const {
        const long L = (long)i * G + c; if (L >= nwg) return false;
        int wgid = (int)L; { const int q = nwg / NXCD, r = nwg % NXCD, xcd = wgid % NXCD, off = wgid / NXCD; wgid = (xcd < r ? xcd * (q + 1) : r * (q + 1) + (xcd - r) * q) + off; }
        const int nig = WGM * nN, gid = wgid / nig, fm = gid * WGM, gsz = (nM - fm) < WGM ? (nM - fm) : WGM;
        u.pm = fm + ((wgid % nig) % gsz); u.pn = (wgid % nig) / gsz; return true;
    }
    __device__ __forceinline__ void a_ready(const Unit&) const {}
    __device__ __forceinline__ void done(const Unit&) const {}
};

__device__ __forceinline__ unsigned cvt_pk_bf16(float lo, float hi) { unsigned r; asm volatile("v_cvt_pk_bf16_f32 %0, %1, %2" : "=v"(r) : "v"(lo), "v"(hi)); return r; }


struct EpiBf16 {
    static constexpr bool PERM = true, AFTER_DRAIN = false;
    bf16_t* O; int ldc; int nscale; float scale0;
    __device__ __forceinline__ void operator()(const f32x4 (&acc)[2][2][4][2], const Unit& u, int wr, int wc, int fr, int fq) const {
        const int row0 = u.pm * BM + wr * 64 + fr; const int col0 = u.pn * BM + wc * 32 + 8 * fq;
        const float sc = (u.pn < nscale) ? scale0 : 1.f;
#pragma unroll
        for (int ai = 0; ai < 2; ++ai)
#pragma unroll
            for (int m = 0; m < 4; ++m) { bf16_t* rowp = O + (size_t)(row0 + ai * HALF + m * 16) * ldc + col0;
#pragma unroll
                for (int bj = 0; bj < 2; ++bj) { f32x4 v0 = acc[ai][bj][m][0] * sc, v1 = acc[ai][bj][m][1] * sc;
                    u32x4 w; w.x = cvt_pk_bf16(v0[0], v0[1]); w.y = cvt_pk_bf16(v0[2], v0[3]); w.z = cvt_pk_bf16(v1[0], v1[1]); w.w = cvt_pk_bf16(v1[2], v1[3]);
                    *(u32x4*)(rowp + bj * HALF) = w; } }
    }
};
struct EpiCv {
    static constexpr bool PERM = true, AFTER_DRAIN = false;
    bf16_t* O;
    __device__ __forceinline__ void operator()(const f32x4 (&acc)[2][2][4][2], const Unit& u, int wr, int wc, int fr, int fq) const {
        const int row0 = u.pm * BM + wr * 64 + fr;
        if (u.pn < 4) {
            const int col0 = u.pn * BM + wc * 32 + 8 * fq;
#pragma unroll
            for (int ai = 0; ai < 2; ++ai)
#pragma unroll
                for (int m = 0; m < 4; ++m) { bf16_t* rowp = O + (size_t)(row0 + ai * HALF + m * 16) * 2048 + col0;
#pragma unroll
                    for (int bj = 0; bj < 2; ++bj) { const f32x4 v0 = acc[ai][bj][m][0], v1 = acc[ai][bj][m][1];
                        u32x4 w; w.x = cvt_pk_bf16(v0[0], v0[1]); w.y = cvt_pk_bf16(v0[2], v0[3]); w.z = cvt_pk_bf16(v1[0], v1[1]); w.w = cvt_pk_bf16(v1[2], v1[3]);
                        *(u32x4*)(rowp + bj * HALF) = w; } }
        } else {
            const int col0 = 1024 + (u.pn - 4) * HALF + wc * 32 + 8 * fq;
#pragma unroll
            for (int ai = 0; ai < 2; ++ai)
#pragma unroll
                for (int m = 0; m < 4; ++m) { const f32x4 v0 = acc[ai][0][m][0] * acc[ai][1][m][0], v1 = acc[ai][0][m][1] * acc[ai][1][m][1];
                    u32x4 w; w.x = cvt_pk_bf16(v0[0], v0[1]); w.y = cvt_pk_bf16(v0[2], v0[3]); w.z = cvt_pk_bf16(v1[0], v1[1]); w.w = cvt_pk_bf16(v1[2], v1[3]);
                    *(u32x4*)(O + (size_t)(row0 + ai * HALF + m * 16) * 2048 + col0) = w; }
        }
    }
};
struct EpiVF {
    static constexpr bool PERM = true, AFTER_DRAIN = false;
    bf16_t* VT; bf16_t* VTC; bf16_t* FT;
    __device__ __forceinline__ void operator()(const f32x4 (&acc)[2][2][4][2], const Unit& u, int wr, int wc, int fr, int fq) const {
        const int row0 = u.pm * BM + wr * 64 + fr; const int tok0 = u.pn * BM;
        const bool isf = u.pm >= 2, isctx = tok0 >= 32768;
        if (isf && isctx) return;
        bf16_t* base; int pitch, cbase;
        if (!isctx) { const int b = tok0 >> 11; pitch = 2048; cbase = (tok0 & 2047) + wc * 32 + 8 * fq; base = (isf ? FT : VT) + (size_t)b * 512 * 2048; }
        else { const int tc = tok0 - 32768; const int b = tc >> 8; pitch = 256; cbase = wc * 32 + 8 * fq; base = VTC + (size_t)b * 512 * 256; }
        const int rsub = isf ? 512 : 0;
#pragma unroll
        for (int ai = 0; ai < 2; ++ai)
#pragma unroll
            for (int m = 0; m < 4; ++m) { bf16_t* rowp = base + (size_t)(row0 + ai * HALF + m * 16 - rsub) * pitch + cbase;
#pragma unroll
                for (int bj = 0; bj < 2; ++bj) { const f32x4 v0 = acc[ai][bj][m][0], v1 = acc[ai][bj][m][1];
                    u32x4 w; w.x = cvt_pk_bf16(v0[0], v0[1]); w.y = cvt_pk_bf16(v0[2], v0[3]); w.z = cvt_pk_bf16(v1[0], v1[1]); w.w = cvt_pk_bf16(v1[2], v1[3]);
                    *(u32x4*)(rowp + bj * HALF) = w; } }
    }
};
struct EpiDft {
    static constexpr bool PERM = true, AFTER_DRAIN = false;
    bf16_t* A2;
    __device__ __forceinline__ void operator()(const f32x4 (&acc)[2][2][4][2], const Unit& u, int wr, int wc, int fr, int fq) const {
        const int kp0 = u.pm * BM + wr * 64 + fr; const int part = kp0 >> 10;
        const int bc0 = u.pn * BM; const int b = bc0 >> 9; const int ch0 = (bc0 & 511) + wc * 32 + 8 * fq;
        bf16_t* base = A2 + (size_t)b * 2048 * 1536 + 512 + part * 512 + ch0;
        const float sg = part ? -1.f : 1.f;
#pragma unroll
        for (int ai = 0; ai < 2; ++ai)
#pragma unroll
            for (int m = 0; m < 4; ++m) { const int k = (kp0 & 1023) + ai * HALF + m * 16; bf16_t* rowp = base + (size_t)k * 1536; bf16_t* mirp = base + (size_t)(2048 - k) * 1536;
#pragma unroll
                for (int bj = 0; bj < 2; ++bj) { const f32x4 v0 = acc[ai][bj][m][0], v1 = acc[ai][bj][m][1];
                    u32x4 w; w.x = cvt_pk_bf16(v0[0], v0[1]); w.y = cvt_pk_bf16(v0[2], v0[3]); w.z = cvt_pk_bf16(v1[0], v1[1]); w.w = cvt_pk_bf16(v1[2], v1[3]);
                    *(u32x4*)(rowp + bj * HALF) = w;
                    if (k > 0) { const f32x4 n0 = v0 * sg, n1 = v1 * sg; u32x4 x; x.x = cvt_pk_bf16(n0[0], n0[1]); x.y = cvt_pk_bf16(n0[2], n0[3]); x.z = cvt_pk_bf16(n1[0], n1[1]); x.w = cvt_pk_bf16(n1[2], n1[3]);
                        *(u32x4*)(mirp + bj * HALF) = x; } } }
    }
};
struct EpiRes {
    static constexpr bool PERM = false, AFTER_DRAIN = false;
    const float* base; float* out; const float* gate; int gpitch; float gsc;
    __device__ __forceinline__ void operator()(const f32x4 (&acc)[2][2][4][2], const Unit& u, int wr, int wc, int fr, int fq) const {
        const int row0 = u.pm * BM + wr * 64 + fr, col0 = u.pn * BM + wc * 32 + 4 * fq;
        const float* gp = gate + (size_t)((u.pm * BM) >> 11) * gpitch + col0;
        f32x4 gv[2][2];
#pragma unroll
        for (int bj = 0; bj < 2; ++bj)
#pragma unroll
            for (int n = 0; n < 2; ++n) gv[bj][n] = *(const f32x4*)(gp + bj * HALF + n * 16);
#pragma unroll
        for (int ai = 0; ai < 2; ++ai)
#pragma unroll
            for (int m = 0; m < 4; ++m) { const size_t off = (size_t)(row0 + ai * HALF + m * 16) * 1024 + col0;
#pragma unroll
                for (int bj = 0; bj < 2; ++bj)
#pragma unroll
                    for (int n = 0; n < 2; ++n) { const f32x4 bs = *(const f32x4*)(base + off + bj * HALF + n * 16);
                        *(f32x4*)(out + off + bj * HALF + n * 16) = bs + gv[bj][n] * acc[ai][bj][m][n] * gsc; }
                asm volatile("" ::: "memory"); }
    }
};

typedef int i32x4_t __attribute__((ext_vector_type(4)));
struct EpiQ8 {
    static constexpr bool PERM = true, AFTER_DRAIN = false, I8 = true;
    bf16_t* O; const float* hs; const float* wsc;
    __device__ __forceinline__ void operator()(const f32x4 (&acc)[2][2][4][2], const Unit& u, int wr, int wc, int fr, int fq) const {
        const int row0 = u.pm * BM + wr * 64 + fr, col0 = u.pn * BM + wc * 32 + 8 * fq;
        f32x4 cs[2][2];
#pragma unroll
        for (int bj = 0; bj < 2; ++bj)
#pragma unroll
            for (int n = 0; n < 2; ++n) cs[bj][n] = *(const f32x4*)(wsc + col0 + bj * HALF + n * 4) * (1.0f / 127.0f);
#pragma unroll
        for (int ai = 0; ai < 2; ++ai)
#pragma unroll
            for (int m = 0; m < 4; ++m) { const int row = row0 + ai * HALF + m * 16; const float rs = hs[2 * (size_t)row];
                bf16_t* rowp = O + (size_t)row * 2048 + col0;
#pragma unroll
                for (int bj = 0; bj < 2; ++bj) { const i32x4_t a0 = __builtin_bit_cast(i32x4_t, acc[ai][bj][m][0]), a1 = __builtin_bit_cast(i32x4_t, acc[ai][bj][m][1]);
                    f32x4 v0, v1;
#pragma unroll
                    for (int z = 0; z < 4; ++z) { v0[z] = (float)a0[z] * rs * cs[bj][0][z]; v1[z] = (float)a1[z] * rs * cs[bj][1][z]; }
                    u32x4 w; w.x = cvt_pk_bf16(v0[0], v0[1]); w.y = cvt_pk_bf16(v0[2], v0[3]); w.z = cvt_pk_bf16(v1[0], v1[1]); w.w = cvt_pk_bf16(v1[2], v1[3]);
                    *(u32x4*)(rowp + bj * HALF) = w; } }
    }
};

template <class E, class = void> struct epi_is_i8 { static constexpr bool value = false; };
template <class E> struct epi_is_i8<E, decltype((void)E::I8)> { static constexpr bool value = E::I8; };
template <class Epi, class Sched, bool ALIGN_EPI = false, bool SP2 = false>
__device__ __forceinline__ void gemm_phase(PG8_LAS unsigned char* lds, const Gemm g, const Sched& S, const Epi& E) {
    const int tid = threadIdx.x, wid = __builtin_amdgcn_readfirstlane(tid >> 6), lane = tid & 63, wr = wid >> 2, wc = wid & 3, fr = lane & 15, fq = lane >> 4;
    const int K = g.K, nt = K / BK;
    unsigned voffA[2], voffB[2];
#pragma unroll
    for (int i = 0; i < 2; ++i) { int R, C; stage_rc(tid * 16 + i * 8192, R, C); const int Rb = Epi::PERM ? ((R & ~31) + perm32(R & 31)) : R;
        voffA[i] = (unsigned)(R * K + C) * 2u; voffB[i] = (unsigned)(Rb * K + C) * 2u; }
    const size_t kstep = (size_t)(BK * 2);
    const size_t hstep = (size_t)HALF * K * 2;
    const size_t tstep = 2 * hstep;
    const unsigned ldsw = (unsigned)wid * 1024u;
    const int aoff = lds_byte(wr * 64 + fr, fq * 8), boff = lds_byte(wc * 32 + fr, fq * 8);
#define PG8_SA(b, h) (((b) * 2 + (h)) * HTB)
#define PG8_SB(b, h) ((4 + (b) * 2 + (h)) * HTB)
#define PG8_STAGE(bufoff, gbase, voff) do { _Pragma("unroll") for (int _i = 0; _i < 2; ++_i) \
        __builtin_amdgcn_global_load_lds((const unsigned*)((const char*)(gbase) + (voff)[_i]), (PG8_LAS unsigned*)(lds + (bufoff) + ldsw + _i * 8192), 16, 0, 0); } while (0)
#define PG8_LDA(dst, b, h) do { _Pragma("unroll") for (int m = 0; m < 4; ++m) _Pragma("unroll") for (int k = 0; k < 2; ++k) dst[m][k] = *(const PG8_LAS bf16x8*)(lds + PG8_SA(b, h) + aoff + m * 2048 + k * 1024); } while (0)
#define PG8_LDB(dst, b, h) do { _Pragma("unroll") for (int n = 0; n < 2; ++n) _Pragma("unroll") for (int k = 0; k < 2; ++k) dst[n][k] = *(const PG8_LAS bf16x8*)(lds + PG8_SB(b, h) + boff + n * 2048 + k * 1024); } while (0)
#define PG8_MMA(ai, bj, At, Bt) do { __builtin_amdgcn_s_setprio(1); _Pragma("unroll") for (int m = 0; m < 4; ++m) _Pragma("unroll") for (int n = 0; n < 2; ++n) _Pragma("unroll") for (int k = 0; k < 2; ++k) { \
        if constexpr (epi_is_i8<Epi>::value) acc[ai][bj][m][n] = __builtin_bit_cast(f32x4, __builtin_amdgcn_mfma_i32_16x16x64_i8(__builtin_bit_cast(i32x4_t, Bt[n][k]), __builtin_bit_cast(i32x4_t, At[m][k]), __builtin_bit_cast(i32x4_t, acc[ai][bj][m][n]), 0, 0, 0)); \
        else acc[ai][bj][m][n] = __builtin_amdgcn_mfma_f32_16x16x32_bf16(Bt[n][k], At[m][k], acc[ai][bj][m][n], 0, 0, 0); } __builtin_amdgcn_s_setprio(0); } while (0)
#define PG8_WAIT_V(n) asm volatile("s_waitcnt vmcnt(" #n ")" ::: "memory")
#define PG8_WAIT_L(n) asm volatile("s_waitcnt lgkmcnt(" #n ")" ::: "memory")
#define PG8_BAR __builtin_amdgcn_s_barrier()
#define PG8_SCHED __builtin_amdgcn_sched_barrier(0)
    Unit cur, nxt; int ui = 0;
    if (!S.next(0, cur)) return;
    f32x4 acc[2][2][4][2];
#pragma unroll
    for (int a = 0; a < 2; ++a)
#pragma unroll
        for (int b = 0; b < 2; ++b)
#pragma unroll
            for (int m = 0; m < 4; ++m)
#pragma unroll
                for (int n = 0; n < 2; ++n) acc[a][b][m][n] = (f32x4){0.f, 0.f, 0.f, 0.f};
    bf16x8 At[4][2], B0[2][2], B1[2][2];
    const char* cA = (const char*)g.A + (size_t)cur.pm * tstep; const char* cB = (const char*)g.Bt + (size_t)cur.pn * tstep;
    S.a_ready(cur);
    if constexpr (SP2) {
        PG8_STAGE(PG8_SB(0, 0), cB, voffB); PG8_STAGE(PG8_SB(0, 1), cB + hstep, voffB); PG8_STAGE(PG8_SA(0, 0), cA, voffA); PG8_STAGE(PG8_SA(0, 1), cA + hstep, voffA);
        if (wr == 1) PG8_BAR;
        PG8_WAIT_V(2); PG8_BAR;
        PG8_STAGE(PG8_SB(1, 0), cB + kstep, voffB); PG8_STAGE(PG8_SA(1, 0), cA + kstep, voffA); PG8_STAGE(PG8_SB(1, 1), cB + hstep + kstep, voffB);
        PG8_WAIT_V(6); PG8_BAR;
    } else {
        PG8_STAGE(PG8_SB(0, 0), cB, voffB); PG8_STAGE(PG8_SA(0, 0), cA, voffA); PG8_STAGE(PG8_SB(0, 1), cB + hstep, voffB); PG8_STAGE(PG8_SA(0, 1), cA + hstep, voffA);
        if (wr == 1) PG8_BAR;
        PG8_WAIT_V(4); PG8_BAR;
        PG8_STAGE(PG8_SB(1, 0), cB + kstep, voffB); PG8_STAGE(PG8_SA(1, 0), cA + kstep, voffA); PG8_STAGE(PG8_SB(1, 1), cB + hstep + kstep, voffB);
        PG8_WAIT_V(6); PG8_BAR;
    }
    for (;;) {
        const bool has_next = S.next(ui + 1, nxt);
        const char* nA = has_next ? (const char*)g.A + (size_t)nxt.pm * tstep : cA; const char* nB = has_next ? (const char*)g.Bt + (size_t)nxt.pn * tstep : cB;
        for (int t = 0; t < nt; t += 2) {
            const bool last = (t == nt - 2);
            const char* a1 = cA + (size_t)(t + 1) * kstep;
            const char* a2 = last ? nA : cA + (size_t)(t + 2) * kstep; const char* b2 = last ? nB : cB + (size_t)(t + 2) * kstep;
            const char* a3 = a2 + kstep; const char* b3 = b2 + kstep;
            if (last && has_next) S.a_ready(nxt);
            if constexpr (SP2) {
            PG8_LDB(B0, 0, 0); PG8_LDB(B1, 0, 1); PG8_SCHED; PG8_LDA(At, 0, 0); PG8_STAGE(PG8_SA(1, 1), a1 + hstep, voffA);
            PG8_WAIT_V(8); PG8_WAIT_L(0); PG8_BAR; PG8_MMA(0, 0, At, B0); PG8_MMA(0, 1, At, B1); PG8_BAR; PG8_SCHED;
            PG8_LDA(At, 0, 1); PG8_STAGE(PG8_SB(0, 0), b2, voffB); PG8_STAGE(PG8_SB(0, 1), b2 + hstep, voffB); PG8_STAGE(PG8_SA(0, 0), a2, voffA);
            PG8_WAIT_V(8); PG8_WAIT_L(0); PG8_BAR; PG8_MMA(1, 0, At, B0); PG8_MMA(1, 1, At, B1); PG8_BAR; PG8_SCHED;
            PG8_LDB(B0, 1, 0); PG8_LDB(B1, 1, 1); PG8_SCHED; PG8_LDA(At, 1, 0); PG8_STAGE(PG8_SA(0, 1), a2 + hstep, voffA);
            PG8_WAIT_V(8); PG8_WAIT_L(0); PG8_BAR; PG8_MMA(0, 0, At, B0); PG8_MMA(0, 1, At, B1); PG8_BAR; PG8_SCHED;
            PG8_LDA(At, 1, 1); PG8_STAGE(PG8_SB(1, 0), b3, voffB); PG8_STAGE(PG8_SB(1, 1), b3 + hstep, voffB); PG8_STAGE(PG8_SA(1, 0), a3, voffA);
            PG8_WAIT_V(8); PG8_WAIT_L(0); PG8_BAR; PG8_MMA(1, 0, At, B0); PG8_MMA(1, 1, At, B1); PG8_BAR; PG8_SCHED;
            } else {
            PG8_LDB(B0, 0, 0); PG8_SCHED; PG8_LDA(At, 0, 0); PG8_STAGE(PG8_SA(1, 1), a1 + hstep, voffA);
            PG8_WAIT_L(8); PG8_BAR; PG8_WAIT_L(0); PG8_MMA(0, 0, At, B0); PG8_BAR; PG8_SCHED;
            PG8_LDB(B1, 0, 1); PG8_STAGE(PG8_SB(0, 0), b2, voffB);
            PG8_BAR; PG8_WAIT_L(0); PG8_MMA(0, 1, At, B1); PG8_BAR;
            PG8_LDA(At, 0, 1); PG8_STAGE(PG8_SA(0, 0), a2, voffA);
            PG8_BAR; PG8_WAIT_L(0); PG8_MMA(1, 0, At, B0); PG8_BAR; PG8_SCHED;
            PG8_STAGE(PG8_SB(0, 1), b2 + hstep, voffB);
            PG8_WAIT_V(6); PG8_BAR; PG8_MMA(1, 1, At, B1); PG8_BAR;
            PG8_LDB(B0, 1, 0); PG8_SCHED; PG8_LDA(At, 1, 0); PG8_STAGE(PG8_SA(0, 1), a2 + hstep, voffA);
            PG8_WAIT_L(8); PG8_BAR; PG8_WAIT_L(0); PG8_MMA(0, 0, At, B0); PG8_BAR; PG8_SCHED;
            PG8_LDB(B1, 1, 1); PG8_STAGE(PG8_SB(1, 0), b3, voffB);
            PG8_BAR; PG8_WAIT_L(0); PG8_MMA(0, 1, At, B1); PG8_BAR;
            PG8_LDA(At, 1, 1); PG8_STAGE(PG8_SA(1, 0), a3, voffA);
            PG8_BAR; PG8_WAIT_L(0); PG8_MMA(1, 0, At, B0); PG8_BAR; PG8_SCHED;
            PG8_STAGE(PG8_SB(1, 1), b3 + hstep, voffB);
            PG8_WAIT_V(6); PG8_BAR; PG8_MMA(1, 1, At, B1); PG8_BAR;
            }
        }
        if constexpr (ALIGN_EPI) { if (wr == 0) PG8_BAR; }
        if constexpr (!Epi::AFTER_DRAIN) { E(acc, cur, wr, wc, fr, fq); S.done(cur); }
        if (!has_next) break;
#pragma unroll
        for (int a = 0; a < 2; ++a)
#pragma unroll
            for (int b = 0; b < 2; ++b)
#pragma unroll
                for (int m = 0; m < 4; ++m)
#pragma unroll
                    for (int n = 0; n < 2; ++n) acc[a][b][m][n] = (f32x4){0.f, 0.f, 0.f, 0.f};
        cur = nxt; cA = nA; cB = nB; ++ui;
        if constexpr (ALIGN_EPI) { if (wr == 1) PG8_BAR; }
    }
    PG8_WAIT_V(0);
    if constexpr (!ALIGN_EPI) { if (wr == 0) PG8_BAR; }
    PG8_BAR;
#undef PG8_SA
#undef PG8_SB
#undef PG8_STAGE
#undef PG8_LDA
#undef PG8_LDB
#undef PG8_MMA
#undef PG8_WAIT_V
#undef PG8_WAIT_L
#undef PG8_BAR
#undef PG8_SCHED
}
}

constexpr int NWAVES = 8;
constexpr int NB = 16, SEQ = 2048, D = 1024, NTOK = NB * SEQ, NCTX = NB * 256, NTT = NTOK + NCTX;
constexpr int N_PHASES = 16;
constexpr int N_LAUNCHES = MK_N_LAUNCHES;
static_assert(N_LAUNCHES == 1 || N_LAUNCHES == N_PHASES, "one launch, or one launch per phase");

constexpr size_t MiB = 1u << 20;
constexpr size_t WS_CTL = 0, CTL_ZERO_BYTES = 64 * 1024;
constexpr size_t WS_MOD = 1 * MiB;
constexpr size_t WS_WIN_T = 2 * MiB;
constexpr size_t WS_WOUT_T = 6 * MiB;
constexpr size_t WS_CVIN_T = 9 * MiB;
constexpr size_t WS_CVOUT_T = 15 * MiB;
constexpr size_t WS_WQ_T = 17 * MiB;
constexpr size_t WS_KEYS = 25 * MiB;
constexpr size_t WS_DFT = 28 * MiB;
constexpr size_t WS_TAB = 48 * MiB;
constexpr size_t WS_TSC = 96 * MiB;
constexpr size_t WS_HQ = 112 * MiB;
constexpr size_t WS_HS = 144 * MiB;
constexpr size_t WS_H = 176 * MiB;
constexpr size_t WS_R = 248 * MiB;
constexpr size_t WS_QK = WS_R;
constexpr size_t WS_VT = WS_R + 72 * MiB;
constexpr size_t WS_VTC = WS_R + 104 * MiB;
constexpr size_t WS_FT = WS_R + 108 * MiB;
constexpr size_t WS_A2 = WS_R + 140 * MiB;
constexpr size_t WS_PQ = WS_R;
constexpr size_t WS_SELE = WS_R + 128 * MiB;
constexpr size_t WS_SELG = WS_R + 144 * MiB;
constexpr size_t WS_HQ8 = WS_R + 160 * MiB;
constexpr size_t WS_BCV = WS_R;
constexpr size_t WS_SET = WS_R + 240 * MiB;
constexpr size_t WS_END = 512 * MiB;
static_assert(WS_A2 + (size_t)NTOK * 1536 * 2 <= WS_END, "ws map");
constexpr int CW_BAR = 4096;
constexpr int CW_COLMAX = 8192;

constexpr int RING_OFF = 0, RING_BYTES = 131072;
constexpr int LDSCTL_OFF = RING_BYTES, MISC_OFF = LDSCTL_OFF + 320;
constexpr int LDS_BYTES = 163840;

#define LDS_WAIT() asm volatile("s_waitcnt lgkmcnt(0)" ::: "memory")

__device__ __forceinline__ unsigned cvt_pk(float lo, float hi) { return pg8::cvt_pk_bf16(lo, hi); }
__device__ __forceinline__ float bf_lo(unsigned u) { return __uint_as_float(u << 16); }
__device__ __forceinline__ float bf_hi(unsigned u) { return __uint_as_float(u & 0xffff0000u); }

#define XB_TMO      128
#define XB_XCNT(j)  (256  + 64 * (j))
#define XB_XSUB(j)  (1280 + 64 * (j))
#define XB_XGEN(j)  (2304 + 64 * (j))
#define XB_TOP      3328
#define XB_TOPGEN   3392
#define XCD_BAR_WORDS 3456
#define XB_SPIN_CAP (1u << 22)
__device__ __forceinline__ unsigned xb_ld(unsigned* p)              { return __hip_atomic_load(p, __ATOMIC_RELAXED, __HIP_MEMORY_SCOPE_AGENT); }
__device__ __forceinline__ unsigned xb_add(unsigned* p, unsigned v) { return __hip_atomic_fetch_add(p, v, __ATOMIC_RELAXED, __HIP_MEMORY_SCOPE_AGENT); }
__device__ __forceinline__ unsigned xb_xcc_id() { return (unsigned)__builtin_amdgcn_s_getreg((3 << 11) | 20) & 0xFu; }
#define XB_SPIN(cond, bar) do { unsigned _sp = 0; while (cond) { __builtin_amdgcn_s_sleep(1); \
    if ((++_sp & 255u) == 0u) { if (xb_ld(&(bar)[XB_TMO])) break; if (_sp > XB_SPIN_CAP) { atomicAdd(&(bar)[XB_TMO], 1u); break; } } } } while (0)
struct XcdBarrier { unsigned* bar; unsigned x; volatile LAS unsigned* st; };
__device__ __forceinline__ XcdBarrier xcd_barrier_post(unsigned* bar, volatile LAS unsigned* st) {
    XcdBarrier b; b.bar = bar; b.x = xb_xcc_id(); b.st = st;
    if (threadIdx.x == 0) (void)xb_add(&bar[XB_XCNT(b.x)], 1u);
    return b;
}
__device__ __forceinline__ void xcd_barrier_complete(unsigned* bar, unsigned x, unsigned& nloc, unsigned& nx) {
    const unsigned G = gridDim.x * gridDim.y * gridDim.z;
    unsigned sum, cnt, mine, sp = 0u;
    for (;;) {
        sum = 0u; cnt = 0u; mine = 0u;
#pragma unroll
        for (unsigned j = 0; j < 16; ++j) { const unsigned c = xb_ld(&bar[XB_XCNT(j)]); sum += c; cnt += (c > 0u) ? 1u : 0u; mine = (j == x) ? c : mine; }
        if (sum == G) break;
        __builtin_amdgcn_s_sleep(1);
        if ((++sp & 255u) == 0u) { if (xb_ld(&bar[XB_TMO])) break; if (sp > XB_SPIN_CAP) { atomicAdd(&bar[XB_TMO], 1u); break; } }
    }
    nloc = mine > 0u ? mine : 1u; nx = cnt > 0u ? cnt : 1u;
}
__device__ __forceinline__ void xcd_barrier(const XcdBarrier& b) {
    asm volatile("s_waitcnt vmcnt(0)" ::: "memory");
    __syncthreads();
    if (threadIdx.x == 0) {
        unsigned* bar = b.bar;
        __builtin_amdgcn_s_waitcnt(0);
        unsigned nloc = b.st[0], nx = b.st[1];
        if (nloc == 0u) { xcd_barrier_complete(bar, b.x, nloc, nx); b.st[0] = nloc; b.st[1] = nx; }
        const unsigned old = xb_add(&bar[XB_XSUB(b.x)], 1u);
        const unsigned gen = old / nloc;
        if (old + 1u == (gen + 1u) * nloc) {
            __builtin_amdgcn_fence(__ATOMIC_RELEASE, "agent");
            asm volatile("s_waitcnt vmcnt(0)" ::: "memory");
            const unsigned og = xb_add(&bar[XB_TOP], 1u);
            const unsigned tg = og / nx;
            if (og + 1u == (tg + 1u) * nx) xb_add(&bar[XB_TOPGEN], 1u);
            else XB_SPIN(xb_ld(&bar[XB_TOPGEN]) == tg, bar);
            __builtin_amdgcn_fence(__ATOMIC_ACQUIRE, "agent");
            xb_add(&bar[XB_XGEN(b.x)], 1u);
            asm volatile("s_waitcnt vmcnt(0)" ::: "memory");
        } else {
            XB_SPIN(xb_ld(&bar[XB_XGEN(b.x)]) == gen, bar);
            __builtin_amdgcn_fence(__ATOMIC_ACQUIRE, "agent");
            asm volatile("s_waitcnt vmcnt(0)" ::: "memory");
        }
    }
    __syncthreads();
}

__device__ __forceinline__ float wave_sum(float v) {
#pragma unroll
    for (int o = 1; o < 64; o <<= 1) v += __shfl_xor(v, o);
    return v;
}

__device__ __forceinline__ void p0_transpose_item(const float* W, int N, bf16* WT, int ldt, LAS float* scr, int item, int lane, bool cvmap = false) {
    const int nblk = N / 32, kb = item / nblk, nb = item % nblk, k0 = 64 * kb, n0 = 32 * nb;
    int n0m = n0; if (cvmap && n0 >= 1024) { const int isv = n0 >= 2048, d = n0 - (isv ? 2048 : 1024); n0m = 1024 + 256 * (d >> 7) + 128 * isv + (d & 127); }
#pragma unroll 8
    for (int i = 0; i < 32; ++i) { const int kk = 2 * i + (lane >> 5); scr[kk * 33 + (lane & 31)] = W[(size_t)(k0 + kk) * N + n0 + (lane & 31)]; }
    LDS_WAIT(); asm volatile("" ::: "memory");
    const int c = lane & 7;
#pragma unroll
    for (int j = 0; j < 4; ++j) { const int n = (lane >> 3) + 8 * j; const LAS float* s = scr + (8 * c) * 33 + n;
        u32x4 o; o.x = cvt_pk(s[0 * 33], s[1 * 33]); o.y = cvt_pk(s[2 * 33], s[3 * 33]); o.z = cvt_pk(s[4 * 33], s[5 * 33]); o.w = cvt_pk(s[6 * 33], s[7 * 33]);
        *(u32x4*)(WT + (size_t)(n0m + n) * ldt + k0 + 8 * c) = o; }
    LDS_WAIT(); asm volatile("" ::: "memory");
}

__device__ __forceinline__ void adaln_item(const float* c, const float* cctx, const float* ada_w, const float* ada_b, float* mods, LAS float* lds, int u) {
    const int i = u / 96, n0 = (u % 96) * 64;
    LAS float* sc = lds;
    LAS float* red = lds + 17 * 1024;
    const int tid = threadIdx.x, lane = tid & 63, w = tid >> 6, kq = lane >> 4, cg = lane & 15;
    for (int e = tid; e < 17 * 1024; e += 512) { const float v = e < 16 * 1024 ? c[e] : cctx[e - 16 * 1024]; sc[e] = v / (1.f + __expf(-v)); }
    __syncthreads();
    f32x4 acc[17];
#pragma unroll
    for (int r = 0; r < 17; ++r) acc[r] = (f32x4){0.f, 0.f, 0.f, 0.f};
    const int kb = w * 128 + kq * 32;
    const float* wp = ada_w + (size_t)i * 1024 * 6144 + (size_t)kb * 6144 + n0 + cg * 4;
#pragma unroll 1
    for (int k0 = 0; k0 < 32; k0 += 8) {
        f32x4 wv[8];
#pragma unroll
        for (int j = 0; j < 8; ++j) wv[j] = *(const f32x4*)(wp + (size_t)(k0 + j) * 6144);
#pragma unroll
        for (int r = 0; r < 17; ++r) {
            const f32x4 s0 = *(const LAS f32x4*)(sc + r * 1024 + kb + k0), s1 = *(const LAS f32x4*)(sc + r * 1024 + kb + k0 + 4);
            acc[r] += wv[0] * s0.x; acc[r] += wv[1] * s0.y; acc[r] += wv[2] * s0.z; acc[r] += wv[3] * s0.w;
            acc[r] += wv[4] * s1.x; acc[r] += wv[5] * s1.y; acc[r] += wv[6] * s1.z; acc[r] += wv[7] * s1.w;
        }
    }
#pragma unroll
    for (int r = 0; r < 17; ++r)
#pragma unroll
        for (int j = 0; j < 4; ++j) { float v = acc[r][j]; v += __shfl_xor(v, 16); v += __shfl_xor(v, 32); acc[r][j] = v; }
    if (kq == 0) {
#pragma unroll
        for (int r = 0; r < 17; ++r) *(LAS f32x4*)(red + (w * 17 + r) * 64 + cg * 4) = acc[r];
    }
    __syncthreads();
    for (int e = tid; e < 17 * 64; e += 512) { const int r = e >> 6, l = e & 63; float s = ada_b[i * 6144 + n0 + l];
#pragma unroll
        for (int g2 = 0; g2 < 8; ++g2) s += red[(g2 * 17 + r) * 64 + l];
        mods[(size_t)(i * 17 + r) * 6144 + n0 + l] = s; }
    __syncthreads();
}

__device__ __forceinline__ void wprime_item(const float* fn_w, const float* w_out, bf16* WOUT_T, LAS float* lds, int item) {
    const int g = item >> 4, n0 = (item & 15) * 64;
    LAS float* U = lds;
    LAS float* ctab = lds + 4096;
    const int tid = threadIdx.x, np = tid & 63, lg = __builtin_amdgcn_readfirstlane(tid >> 6);
    if (tid < 64) ctab[tid] = cospif((float)tid * (1.f / 32.f));
    {
        float wv[64];
#pragma unroll
        for (int e = 0; e < 64; ++e) wv[e] = w_out[(size_t)(512 + 64 * g + e) * 1024 + n0 + np];
#pragma unroll 1
        for (int l = lg * 8; l < lg * 8 + 8; ++l) { float s = 0.f; const float* fr = fn_w + (g * 64 + l) * 64;
#pragma unroll
            for (int e = 0; e < 64; ++e) s += fr[e] * wv[e];
            U[l * 64 + np] = s; }
    }
    __syncthreads();
    const float sN = 0.0027621358640099515f;
    const int n4 = tid & 15, rg = tid >> 4;
    f32x4 acc[4];
#pragma unroll
    for (int q = 0; q < 4; ++q) acc[q] = (f32x4){0.f, 0.f, 0.f, 0.f};
#pragma unroll 4
    for (int l = 0; l < 64; ++l) { const f32x4 uv = *(const LAS f32x4*)(U + l * 64 + n4 * 4);
#pragma unroll
        for (int q = 0; q < 4; ++q) { const int row = rg * 4 + q, part = row >> 6, cch = row & 63, m = (l * cch) & 63; acc[q] += uv * ctab[part ? ((m - 16) & 63) : m]; } }
#pragma unroll
    for (int q = 0; q < 4; ++q) { const int row = rg * 4 + q, part = row >> 6, cch = row & 63; const float sg = part ? -sN : sN;
#pragma unroll
        for (int j = 0; j < 4; ++j) WOUT_T[(size_t)(n0 + n4 * 4 + j) * 1536 + 512 + part * 512 + g * 64 + cch] = (bf16)(cvt_pk(acc[q][j] * sg, 0.f) & 0xffffu); }
    __syncthreads();
}

struct Args { const float* in[20]; float* out; unsigned char* ws; int ph_lo, ph_hi, li, pad; };

constexpr int CW_TABQ = 64;
__device__ __forceinline__ void phase_prep(const Args& a, LAS unsigned char* lds, int G, int wg, int rep, int part) {
#define PSUB(k) (rep == 0 || PROBE_SUB == 0 || PROBE_SUB == (k))
    const int tid = threadIdx.x, lane = tid & 63, wave = __builtin_amdgcn_readfirstlane(tid >> 6);
    unsigned char* ws = a.ws;
    if (PSUB(1) && part == 0) for (int u = wg; u < 192; u += G) adaln_item(a.in[1], a.in[3], a.in[4], a.in[5], (float*)(ws + WS_MOD), (LAS float*)lds, u);
    if (PSUB(1) && part == 0) for (int u = G - 1 - wg; u < 128; u += G) wprime_item(a.in[12], a.in[10], (bf16*)(ws + WS_WOUT_T), (LAS float*)lds, u);
    if (PSUB(2)) {
        LAS float* scr = (LAS float*)(lds + wave * 16384);
        const int gw = ((wg + G / 2) % G) * NWAVES + wave, NGW = G * NWAVES;
        constexpr int I_WIN = 16 * 64, I_WO = 8 * 32, I_CVI = 16 * 96, I_CVO = 16 * 32, I_WQ = 16 * 64;
        constexpr int NIT = I_WIN + I_WO + I_CVI + I_CVO + 2 * I_WQ;
        for (int it = gw; it < NIT; it += NGW) {
            if ((part == 0) != (it >= I_WIN + I_WO + I_CVI + I_CVO)) continue;
            int r = it;
            if (r < I_WIN) { p0_transpose_item(a.in[9], 2048, (bf16*)(ws + WS_WIN_T), 1024, scr, r, lane); continue; } r -= I_WIN;
            if (r < I_WO) { p0_transpose_item(a.in[10], 1024, (bf16*)(ws + WS_WOUT_T), 1536, scr, r, lane); continue; } r -= I_WO;
            if (r < I_CVI) { p0_transpose_item(a.in[13], 3072, (bf16*)(ws + WS_CVIN_T), 1024, scr, r, lane, true); continue; } r -= I_CVI;
            if (r < I_CVO) { p0_transpose_item(a.in[15], 1024, (bf16*)(ws + WS_CVOUT_T), 1024, scr, r, lane); continue; } r -= I_CVO;
            {
              const int L = r >= I_WQ ? 1 : 0, it2 = r - L * I_WQ, kb = it2 / 64, nb = it2 % 64;
              const float* wp = a.in[16] + ((size_t)L * 1024 + kb * 64 + (lane >> 5) * 32) * 2048 + nb * 32 + (lane & 31); float am = 0.f;
#pragma unroll 8
              for (int k = 0; k < 32; ++k) am = fmaxf(am, fabsf(wp[(size_t)k * 2048]));
              am = fmaxf(am, __shfl_xor(am, 32));
              if (lane < 32) atomicMax((unsigned*)(ws + WS_CTL) + CW_COLMAX + L * 2048 + nb * 32 + lane, __float_as_uint(am)); }
        }
    }
    __syncthreads();
    if (PSUB(3) && part == 1) {
        LAS float* tab = (LAS float*)lds;
        for (int m = tid; m < 2048; m += 512) tab[m] = cospif((float)m * (1.f / 1024.f));
        __syncthreads();
        bf16* DFT = (bf16*)(ws + WS_DFT);
        for (int item = wg * 512 + tid; item < 2048 * 256; item += G * 512) {
            const int kp = item >> 8, n0 = (item & 255) * 8, k = kp & 1023, sh = (kp >> 10) ? 512 : 0;
            float v[8];
#pragma unroll
            for (int j = 0; j < 8; ++j) v[j] = tab[(k * (n0 + j) - sh) & 2047];
            u32x4 o; o.x = cvt_pk(v[0], v[1]); o.y = cvt_pk(v[2], v[3]); o.z = cvt_pk(v[4], v[5]); o.w = cvt_pk(v[6], v[7]);
            *(u32x4*)(DFT + (size_t)kp * 2048 + n0) = o;
        }
    }
    if (PSUB(4) && part == 1) {
        const size_t gt = (size_t)wg * 512 + tid, NT = (size_t)G * 512;
        const f32x4* s = (const f32x4*)a.in[17]; u32x2* d = (u32x2*)(ws + WS_KEYS);
        for (size_t i = gt; i < (size_t)2 * 8 * 2 * 128 * 128 / 4; i += NT) { const f32x4 x = s[i]; u32x2 o; o.x = cvt_pk(x[0], x[1]); o.y = cvt_pk(x[2], x[3]); d[i] = o; }
    }
#undef PSUB
}

__device__ __forceinline__ void norm_row(const float* xrow, const float* g, const float* sh, const float* sc, bf16* orow, unsigned char* hq, unsigned char* hq8, float* hs, int lane) {
    const f32x4* xr = (const f32x4*)xrow + lane;
    f32x4 v[4]; float s = 0.f;
#pragma unroll
    for (int j = 0; j < 4; ++j) { v[j] = xr[64 * j]; s += (v[j].x * v[j].x + v[j].y * v[j].y) + (v[j].z * v[j].z + v[j].w * v[j].w); }
    const float r = 1.0f / sqrtf(wave_sum(s) * (1.f / 1024.f) + 1e-6f);
    u32x2* o8 = (u32x2*)orow + lane;
#pragma unroll
    for (int j = 0; j < 4; ++j) {
        const f32x4 gg = ((const f32x4*)g)[lane + 64 * j], a = ((const f32x4*)sh)[lane + 64 * j], b = ((const f32x4*)sc)[lane + 64 * j];
        const f32x4 y = (v[j] * r * gg) * (b + 1.0f) + a; v[j] = y;
        u32x2 w; w.x = cvt_pk(y.x, y.y); w.y = cvt_pk(y.z, y.w); o8[64 * j] = w; }
    if (hq) {
        float am = 0.f;
#pragma unroll
        for (int j = 0; j < 4; ++j) am = fmaxf(am, fmaxf(fmaxf(fabsf(v[j].x), fabsf(v[j].y)), fmaxf(fabsf(v[j].z), fabsf(v[j].w))));
#pragma unroll
        for (int o = 1; o < 64; o <<= 1) am = fmaxf(am, __shfl_xor(am, o));
        const float inv = am > 0.f ? 119.0f / am : 0.f; float qs = 0.f;
#pragma unroll
        for (int j = 0; j < 4; ++j) { unsigned whi = 0u, wlo = 0u, w8 = 0u;
#pragma unroll
            for (int z = 0; z < 4; ++z) { const int q8 = (int)rintf(v[j][z] * inv); const int hi = (q8 + 8) >> 4, lo = q8 - 16 * hi; qs += (float)q8;
                whi |= ((unsigned)hi & 15u) << (4 * z); wlo |= ((unsigned)lo & 15u) << (4 * z); w8 |= ((unsigned)q8 & 255u) << (8 * z); }
            ((unsigned short*)hq)[lane + 64 * j] = (unsigned short)whi; ((unsigned short*)(hq + 512))[lane + 64 * j] = (unsigned short)wlo; ((unsigned*)hq8)[lane + 64 * j] = w8; }
        qs = wave_sum(qs);
        if (lane == 0) { hs[0] = am * (1.0f / 119.0f); hs[1] = qs; }
    }
}
__device__ __forceinline__ void phase_norm(const float* xsrc, const float* ctx, const float* gvec, const float* modsL, int c0, bf16* H, unsigned char* HQ, unsigned char* HQ8, float* HS, int G, int wg) {
    const int lane = threadIdx.x & 63, wave = __builtin_amdgcn_readfirstlane(threadIdx.x >> 6);
    const int gw = wg * NWAVES + wave, NGW = G * NWAVES;
    const int nrows = ctx ? NTT : NTOK;
    for (int m = gw; m < nrows; m += NGW) {
        const float* xr; int mr;
        if (m < NTOK) { xr = xsrc + (size_t)m * D; mr = m >> 11; } else { xr = ctx + (size_t)(m - NTOK) * D; mr = 16; }
        const float* mp = modsL + (size_t)mr * 6144 + c0 * 1024;
        norm_row(xr, gvec, mp, mp + 1024, H + (size_t)m * D, HQ ? HQ + (size_t)m * 1024 : nullptr, HQ8 + (size_t)m * 1024, HS + 2 * (size_t)m, lane);
    }
}

__device__ __forceinline__ void wq8_transpose_item(const float* W, const float* colmax, unsigned char* WT8, LAS float* scr, int item, int lane) {
    const int kb = item / 64, nb = item % 64, k0 = 64 * kb, n0 = 32 * nb;
#pragma unroll 8
    for (int i = 0; i < 32; ++i) { const int kk = 2 * i + (lane >> 5); scr[kk * 33 + (lane & 31)] = W[(size_t)(k0 + kk) * 2048 + n0 + (lane & 31)]; }
    LDS_WAIT(); asm volatile("" ::: "memory");
    const int c = lane & 7;
#pragma unroll
    for (int j = 0; j < 4; ++j) { const int n = (lane >> 3) + 8 * j; const LAS float* sp = scr + (8 * c) * 33 + n;
        const float cm = colmax[n0 + n], inv = cm > 0.f ? 127.0f / cm : 0.f;
        unsigned w0 = 0u, w1 = 0u;
#pragma unroll
        for (int z = 0; z < 4; ++z) { w0 |= ((unsigned)(int)rintf(sp[z * 33] * inv) & 255u) << (8 * z); w1 |= ((unsigned)(int)rintf(sp[(4 + z) * 33] * inv) & 255u) << (8 * z); }
        u32x2 o; o.x = w0; o.y = w1;
        *(u32x2*)(WT8 + (size_t)(n0 + n) * 1024 + k0 + 8 * c) = o; }
    LDS_WAIT(); asm volatile("" ::: "memory");
}
__device__ __forceinline__ void phase_wq8(const float* wq, const float* colmax, unsigned char* WQ8, LAS unsigned char* lds, int G, int wg) {
    const int lane = threadIdx.x & 63, wave = __builtin_amdgcn_readfirstlane(threadIdx.x >> 6);
    LAS float* scr = (LAS float*)(lds + wave * 16384);
    for (int it = wg * NWAVES + wave; it < 2 * 1024; it += G * NWAVES) { const int L = it >> 10;
        wq8_transpose_item(wq + (size_t)L * 1024 * 2048, colmax + L * 2048, WQ8 + (size_t)L * 2048 * 1024, scr, it & 1023, lane); }
}

typedef float f32x16 __attribute__((ext_vector_type(16)));
struct AttnRaw { u32x4 k[4]; u32x4 v[4]; };
constexpr int ATT_KPITCH = 144, ATT_VPITCH = 72, ATT_WAVE_LDS = 32 * ATT_KPITCH + 64 * ATT_VPITCH;
__device__ __forceinline__ void na_load_raw(AttnRaw& f, const bf16* QK, const bf16* VT, const bf16* VTC, int b, int h, int t, int nrows, int sr0, int c32, int lane) {
    const bf16* kp; const bf16* vp; size_t vpitch;
    if (t < nrows) { const int kr = sr0 + t;
        kp = QK + ((size_t)b * 2048 + kr * 64 + c32 + (lane >> 3)) * 1024 + 512 + h * 64 + (lane & 7) * 8;
        vp = VT + (size_t)(b * 512 + h * 64 + (lane >> 2)) * 2048 + kr * 64 + c32 + (lane & 3) * 8; vpitch = 2048; }
    else { const int u = t - nrows;
        kp = QK + ((size_t)NTOK + b * 256 + 32 * u + (lane >> 3)) * 1024 + 512 + h * 64 + (lane & 7) * 8;
        vp = VTC + (size_t)(b * 512 + h * 64 + (lane >> 2)) * 256 + 32 * u + (lane & 3) * 8; vpitch = 256; }
#pragma unroll
    for (int q = 0; q < 4; ++q) { f.k[q] = *(const u32x4*)(kp + (size_t)q * 8 * 1024); f.v[q] = *(const u32x4*)(vp + (size_t)q * 16 * vpitch); }
}
__device__ __forceinline__ void na_stage(const AttnRaw& f, LAS unsigned char* kl, LAS unsigned char* vl, int lane) {
#pragma unroll
    for (int q = 0; q < 4; ++q) {
        *(LAS u32x4*)(kl + (8 * q + (lane >> 3)) * ATT_KPITCH + (lane & 7) * 16) = f.k[q];
        LAS unsigned char* vd = vl + (16 * q + (lane >> 2)) * ATT_VPITCH + (lane & 3) * 16;
        u32x2 lo, hi2; lo.x = f.v[q].x; lo.y = f.v[q].y; hi2.x = f.v[q].z; hi2.y = f.v[q].w;
        *(LAS u32x2*)vd = lo; *(LAS u32x2*)(vd + 8) = hi2;
    }
}
__device__ __forceinline__ void na_attn32_wave(const bf16* QK, const bf16* VT, const bf16* VTC, const LAS float* rpl, LAS unsigned char* wl, bf16* A2, int b, int h, int r0, int qb, int lane) {
    const int j = lane & 31, hi = lane >> 5;
    const int c0 = qb * 16;
    const int c32 = qb == 0 ? 0 : (qb == 1 ? 8 : (qb == 2 ? 24 : 32));
    const int qrow = r0 + (j >> 4), cq = c0 + (j & 15);
    const int srq = min(max(qrow - 4, 0), 24), cs = min(max(cq - 8, 0), 48);
    const int sr0 = min(max(r0 - 4, 0), 24), sr1 = min(max(r0 - 3, 0), 24);
    const int nrows = sr1 + 8 - sr0, ntiles = nrows + 8;
    const size_t tq = (size_t)b * 2048 + qrow * 64 + cq;
    LAS unsigned char* kl = wl; LAS unsigned char* vl = wl + 32 * ATT_KPITCH;
    bf16x8 qf[4];
#pragma unroll
    for (int ks = 0; ks < 4; ++ks) qf[ks] = *(const bf16x8*)(QK + tq * 1024 + h * 64 + 16 * ks + 8 * hi);
    f32x16 o0, o1;
#pragma unroll
    for (int v = 0; v < 16; ++v) { o0[v] = 0.f; o1[v] = 0.f; }
    float m_run = -1e30f, l_run = 0.f;
    AttnRaw raw;
    na_load_raw(raw, QK, VT, VTC, b, h, 0, nrows, sr0, c32, lane);
#pragma unroll 2
    for (int t = 0; t < ntiles; ++t) {
        na_stage(raw, kl, vl, lane);
        if (t + 1 < ntiles) na_load_raw(raw, QK, VT, VTC, b, h, t + 1, nrows, sr0, c32, lane);
        f32x16 sv;
#pragma unroll
        for (int v = 0; v < 16; ++v) sv[v] = 0.f;
#pragma unroll
        for (int ks = 0; ks < 4; ++ks) { const bf16x8 kf = *(const LAS bf16x8*)(kl + j * ATT_KPITCH + (2 * ks + hi) * 16);
            sv = __builtin_amdgcn_mfma_f32_32x32x16_bf16(kf, qf[ks], sv, 0, 0, 0); }
        if (t < nrows) {
            const int kr = sr0 + t;
            const bool rok = (kr >= srq) && (kr < srq + 8);
            const LAS float* rrow = rpl + min(max(kr - qrow + 7, 0), 14) * 31;
#pragma unroll
            for (int v = 0; v < 16; ++v) { const int kc = c32 + 8 * (v >> 2) + 4 * hi + (v & 3); const bool ok = rok && (kc >= cs) && (kc < cs + 16);
                const float bias = rrow[min(max(kc - cq + 15, 0), 30)];
                sv[v] = ok ? sv[v] + bias : -INFINITY; }
        }
        float mx = sv[0];
#pragma unroll
        for (int v = 1; v < 16; ++v) mx = fmaxf(mx, sv[v]);
        mx = fmaxf(mx, __shfl_xor(mx, 32));
        const float m_new = fmaxf(m_run, mx);
        const float alpha = __expf(m_run - m_new);
        float ps = 0.f;
#pragma unroll
        for (int v = 0; v < 16; ++v) { const float p = __expf(sv[v] - m_new); sv[v] = p; ps += p; }
        l_run = l_run * alpha + ps; m_run = m_new;
#pragma unroll
        for (int v = 0; v < 16; ++v) { o0[v] *= alpha; o1[v] *= alpha; }
#pragma unroll
        for (int st = 0; st < 2; ++st) {
            u32x4 pw; pw.x = cvt_pk(sv[8 * st], sv[8 * st + 1]); pw.y = cvt_pk(sv[8 * st + 2], sv[8 * st + 3]); pw.z = cvt_pk(sv[8 * st + 4], sv[8 * st + 5]); pw.w = cvt_pk(sv[8 * st + 6], sv[8 * st + 7]);
            const bf16x8 pf = __builtin_bit_cast(bf16x8, pw);
#pragma unroll
            for (int dt = 0; dt < 2; ++dt) {
                const LAS unsigned char* vr = vl + (32 * dt + j) * ATT_VPITCH + 32 * st + 8 * hi;
                const u32x2 lo = *(const LAS u32x2*)vr, h2 = *(const LAS u32x2*)(vr + 16);
                u32x4 vw; vw.x = lo.x; vw.y = lo.y; vw.z = h2.x; vw.w = h2.y;
                if (dt == 0) o0 = __builtin_amdgcn_mfma_f32_32x32x16_bf16(__builtin_bit_cast(bf16x8, vw), pf, o0, 0, 0, 0);
                else o1 = __builtin_amdgcn_mfma_f32_32x32x16_bf16(__builtin_bit_cast(bf16x8, vw), pf, o1, 0, 0, 0);
            }
        }
    }
    l_run += __shfl_xor(l_run, 32);
    const float inv = 1.0f / l_run;
    bf16* orow = A2 + tq * 1536 + h * 64 + 4 * hi;
#pragma unroll
    for (int g = 0; g < 4; ++g) {
        u32x2 w; w.x = cvt_pk(o0[4 * g] * inv, o0[4 * g + 1] * inv); w.y = cvt_pk(o0[4 * g + 2] * inv, o0[4 * g + 3] * inv); *(u32x2*)(orow + 8 * g) = w;
        w.x = cvt_pk(o1[4 * g] * inv, o1[4 * g + 1] * inv); w.y = cvt_pk(o1[4 * g + 2] * inv, o1[4 * g + 3] * inv); *(u32x2*)(orow + 32 + 8 * g) = w;
    }
}

__device__ __forceinline__ int f2key(float f) { const int b = (int)__float_as_uint(f); return b ^ ((b >> 31) & 0x7fffffff); }
__device__ __forceinline__ float key2f(int k) { return __uint_as_float((unsigned)(k ^ ((k >> 31) & 0x7fffffff))); }
__device__ __forceinline__ void ce_desc(int& a, int& b) { const int t = max(a, b); b = min(a, b); a = t; }
template <int N> __device__ __forceinline__ void bitonic_sort_desc(int (&v)[N]) {
#pragma unroll
    for (int k = 2; k <= N; k <<= 1) {
#pragma unroll
        for (int j = k >> 1; j > 0; j >>= 1) {
#pragma unroll
            for (int i = 0; i < N; ++i) { const int l = i ^ j; if (l > i) { if ((i & k) == 0) ce_desc(v[i], v[l]); else ce_desc(v[l], v[i]); } }
        }
    }
}
template <int N> __device__ __forceinline__ void bitonic_merge_desc(int (&v)[N]) {
#pragma unroll
    for (int j = N >> 1; j > 0; j >>= 1) {
#pragma unroll
        for (int i = 0; i < N; ++i) { const int l = i ^ j; if (l > i) ce_desc(v[i], v[l]); }
    }
}
constexpr int TOPK_LDS_PER_WAVE = 16 * 52 * 4;
constexpr int TOPK_KROW = 136;
__device__ __forceinline__ void peer_topk_wave(const bf16x8 (&qfa)[2][4], const LAS bf16* KL, int* sel_e, float* sel_g, int t0, int h, int lane, LAS int* scr) {
    const int fr = lane & 15, fq = lane >> 4;
    int top[2][16];
#pragma unroll
    for (int p = 0; p < 2; ++p) {
        int lo[16], hi[16];
#pragma unroll
        for (int t = 0; t < 8; ++t) {
            f32x4 av = (f32x4){0.f, 0.f, 0.f, 0.f};
#pragma unroll
            for (int ks = 0; ks < 4; ++ks) { const bf16x8 kf = *(const LAS bf16x8*)(KL + (p * 128 + t * 16 + fr) * TOPK_KROW + ks * 32 + fq * 8);
                av = __builtin_amdgcn_mfma_f32_16x16x32_bf16(kf, qfa[p][ks], av, 0, 0, 0); }
#pragma unroll
            for (int j = 0; j < 4; ++j) { const int n = 16 * t + 4 * fq + j; const int key = (f2key(av[j]) & ~127) | n;
                if (t < 4) lo[4 * t + j] = key; else hi[4 * (t - 4) + j] = key; }
        }
        bitonic_sort_desc<16>(lo); bitonic_sort_desc<16>(hi);
#pragma unroll
        for (int i = 0; i < 16; ++i) lo[i] = max(lo[i], hi[15 - i]);
        bitonic_merge_desc<16>(lo);
#pragma unroll
        for (int x = 16; x <= 32; x <<= 1) {
#pragma unroll
            for (int i = 0; i < 16; ++i) hi[i] = __shfl_xor(lo[15 - i], x);
#pragma unroll
            for (int i = 0; i < 16; ++i) lo[i] = max(lo[i], hi[i]);
            bitonic_merge_desc<16>(lo);
        }
#pragma unroll
        for (int i = 0; i < 16; ++i) top[p][i] = lo[i];
    }
    const bool b0 = (fq & 1) != 0, b1 = (fq & 2) != 0;
    const int gbase = b1 ? (b0 ? 42 : 29) : (b0 ? 16 : 0);
    LAS int* tb = scr + fr * 52;
    int g0[16];
    {
        constexpr signed char TI[4][16] = {{0,0,0,0,0,0,0,0,0,0,0,0,0,0,0,0}, {1,1,1,1,1,1,1,1,2,2,2,2,2,-1,-1,-1}, {3,3,3,3,4,4,4,5,5,6,6,7,7,-1,-1,-1}, {8,9,10,11,12,13,14,15,-1,-1,-1,-1,-1,-1,-1,-1}};
        constexpr signed char TJ[4][16] = {{0,1,2,3,4,5,6,7,8,9,10,11,12,13,14,15}, {0,1,2,3,4,5,6,7,0,1,2,3,4,-1,-1,-1}, {0,1,2,3,0,1,2,0,1,0,1,0,1,-1,-1,-1}, {0,0,0,0,0,0,0,0,-1,-1,-1,-1,-1,-1,-1,-1}};
#pragma unroll
        for (int sl = 0; sl < 16; ++sl) {
            const int ka0 = top[0][TI[0][sl]], ka1 = top[0][TI[1][sl] < 0 ? 0 : TI[1][sl]], ka2 = top[0][TI[2][sl] < 0 ? 0 : TI[2][sl]], ka3 = top[0][TI[3][sl] < 0 ? 0 : TI[3][sl]];
            const int kb0 = top[1][TJ[0][sl]], kb1 = top[1][TJ[1][sl] < 0 ? 0 : TJ[1][sl]], kb2 = top[1][TJ[2][sl] < 0 ? 0 : TJ[2][sl]], kb3 = top[1][TJ[3][sl] < 0 ? 0 : TJ[3][sl]];
            const int ka = b1 ? (b0 ? ka3 : ka2) : (b0 ? ka1 : ka0), kb = b1 ? (b0 ? kb3 : kb2) : (b0 ? kb1 : kb0);
            const bool pad = b1 ? (b0 ? (TI[3][sl] < 0) : (TI[2][sl] < 0)) : (b0 ? (TI[1][sl] < 0) : false);
            const int key = (f2key(key2f(ka) + key2f(kb)) & ~63) | (49 - gbase - sl);
            g0[sl] = pad ? (int)0x80000000 : key;
            tb[pad ? 51 : gbase + sl] = (ka & 127) * 128 + (kb & 127);
        }
    }
    bitonic_sort_desc<16>(g0);
#pragma unroll
    for (int x = 16; x <= 32; x <<= 1) {
        int hi2[16];
#pragma unroll
        for (int i = 0; i < 16; ++i) hi2[i] = __shfl_xor(g0[15 - i], x);
#pragma unroll
        for (int i = 0; i < 16; ++i) g0[i] = max(g0[i], hi2[i]);
        bitonic_merge_desc<16>(g0);
    }
    int kmax = g0[0];
#pragma unroll
    for (int i = 1; i < 16; ++i) kmax = max(kmax, g0[i]);
    const float mx = key2f(kmax);
    float wv[16]; float sum = 0.f;
#pragma unroll
    for (int i = 0; i < 16; ++i) { wv[i] = __expf(key2f(g0[i]) - mx); sum += wv[i]; }
    const float inv = 1.0f / sum;
    LDS_WAIT(); asm volatile("" ::: "memory");
    int we[16];
#pragma unroll
    for (int i = 0; i < 16; ++i) we[i] = tb[49 - (g0[i] & 63)];
    if (fq == 0) {
        int* ep = sel_e + ((size_t)(t0 + fr) * 8 + h) * 16; float* gp = sel_g + ((size_t)(t0 + fr) * 8 + h) * 16;
#pragma unroll
        for (int rd = 0; rd < 16; ++rd) { ep[rd] = we[rd]; gp[rd] = wv[rd] * inv; }
    }
    LDS_WAIT(); asm volatile("" ::: "memory");
}

__device__ __forceinline__ void phase_topk(LAS unsigned char* lds, const bf16* Q, const bf16* KEYS, int* sel_e, float* sel_g, const float* tdown, const float* tup, unsigned char* tab4, float* tsc, int G, int wg) {
    const int tid = threadIdx.x, lane = tid & 63, wave = __builtin_amdgcn_readfirstlane(tid >> 6), fr = lane & 15, fq = lane >> 4;
    LAS bf16* KL = (LAS bf16*)lds;
    LAS int* scr = (LAS int*)(lds + 2 * 128 * TOPK_KROW * 2 + wave * TOPK_LDS_PER_WAVE);
    const int nh = (G % 8 == 0) ? 1 : 8;
#pragma unroll 1
    for (int hh = 0; hh < nh; ++hh) {
        const int h = (nh == 1) ? (wg & 7) : hh;
        const int nwh = (nh == 1) ? (G >> 3) : G, wi = (nh == 1) ? (wg >> 3) : wg;
        __syncthreads();
        for (int p = tid; p < 4096; p += 512) { const int row = p >> 4, c16 = p & 15;
            *(LAS u32x4*)(KL + row * TOPK_KROW + c16 * 8) = *(const u32x4*)(KEYS + (size_t)(h * 256 + row) * 128 + c16 * 8); }
        __syncthreads();
        int b = wave * nwh + wi;
        bf16x8 qn[2][4];
        if (b < 2048) {
#pragma unroll
            for (int p = 0; p < 2; ++p)
#pragma unroll
                for (int ks = 0; ks < 4; ++ks) qn[p][ks] = *(const bf16x8*)(Q + (size_t)(b * 16 + fr) * 2048 + h * 256 + p * 128 + ks * 32 + fq * 8);
        }
        const int gw = wg * NWAVES + wave, NGW = G * NWAVES;
        int trow = (hh == 0) ? gw : 32768;
#define TOPK_ROW_PTR(R) ((const f32x4*)((((R) < 16384) ? tdown : tup) + (size_t)((R) & 16383) * 1024) + lane * 4)
#define TOPK_ROW_STORE(R, X) do { u32x2 pk; float scv; \
            if ((R) < 16384) {     \
                float ss = 0.f, am = 0.f; \
                _Pragma("unroll") for (int q = 0; q < 4; ++q) { ss += (X[q][0] * X[q][0] + X[q][1] * X[q][1]) + (X[q][2] * X[q][2] + X[q][3] * X[q][3]); \
                    am = fmaxf(am, fmaxf(fmaxf(fabsf(X[q][0]), fabsf(X[q][1])), fmaxf(fabsf(X[q][2]), fabsf(X[q][3])))); } \
                ss = wave_sum(ss); _Pragma("unroll") for (int o = 1; o < 64; o <<= 1) am = fmaxf(am, __shfl_xor(am, o)); \
                scv = fmaxf(0.35f * sqrtf(ss * (1.0f / 1024.0f)), am * (1.0f / 16.0f)); const float inv = scv > 0.f ? 1.0f / scv : 0.f; \
                unsigned w0 = 0u, w1 = 0u; \
                _Pragma("unroll") for (int q = 0; q < 4; ++q) _Pragma("unroll") for (int z = 0; z < 4; ++z) { \
                    const int cd = min(max((int)floorf(X[q][z] * inv), -8), 7); const unsigned nb = (unsigned)cd & 15u; \
                    if (q < 2) w0 |= nb << (4 * (4 * q + z)); else w1 |= nb << (4 * (4 * (q - 2) + z)); } \
                pk.x = w0; pk.y = w1; \
            } else {               \
                float am = 0.f; \
                _Pragma("unroll") for (int q = 0; q < 4; ++q) am = fmaxf(am, fmaxf(fmaxf(fabsf(X[q][0]), fabsf(X[q][1])), fmaxf(fabsf(X[q][2]), fabsf(X[q][3])))); \
                _Pragma("unroll") for (int o = 1; o < 64; o <<= 1) am = fmaxf(am, __shfl_xor(am, o)); \
                const float inv = am > 0.f ? 6.0f / am : 0.f; unsigned p0 = 0u, p1 = 0u; \
                p0 = __builtin_amdgcn_cvt_scalef32_pk_fp4_f32(p0, X[0][0] * inv, X[0][1] * inv, 1.0f, 0); p0 = __builtin_amdgcn_cvt_scalef32_pk_fp4_f32(p0, X[0][2] * inv, X[0][3] * inv, 1.0f, 1); \
                p0 = __builtin_amdgcn_cvt_scalef32_pk_fp4_f32(p0, X[1][0] * inv, X[1][1] * inv, 1.0f, 2); p0 = __builtin_amdgcn_cvt_scalef32_pk_fp4_f32(p0, X[1][2] * inv, X[1][3] * inv, 1.0f, 3); \
                p1 = __builtin_amdgcn_cvt_scalef32_pk_fp4_f32(p1, X[2][0] * inv, X[2][1] * inv, 1.0f, 0); p1 = __builtin_amdgcn_cvt_scalef32_pk_fp4_f32(p1, X[2][2] * inv, X[2][3] * inv, 1.0f, 1); \
                p1 = __builtin_amdgcn_cvt_scalef32_pk_fp4_f32(p1, X[3][0] * inv, X[3][1] * inv, 1.0f, 2); p1 = __builtin_amdgcn_cvt_scalef32_pk_fp4_f32(p1, X[3][2] * inv, X[3][3] * inv, 1.0f, 3); \
                pk.x = p0; pk.y = p1; scv = am * (1.0f / 6.0f); } \
            *((u32x2*)(tab4 + (((R) < 16384) ? (size_t)0 : (size_t)8 * MiB) + (size_t)(lane >> 4) * (2 * MiB) + (size_t)((R) & 16383) * 128) + (lane & 15)) = pk; \
            if (lane == 0) tsc[R] = scv; } while (0)
#pragma unroll 1
        for (; b < 2048; b += 8 * nwh) {
            f32x4 tx0[4], tx1[4]; const int ra = trow, rb = trow + NGW; const bool t0 = ra < 32768, t1 = rb < 32768;
            if (t0) { const f32x4* sp = TOPK_ROW_PTR(ra);
#pragma unroll
                for (int q = 0; q < 4; ++q) tx0[q] = sp[q]; }
            if (t1) { const f32x4* sp = TOPK_ROW_PTR(rb);
#pragma unroll
                for (int q = 0; q < 4; ++q) tx1[q] = sp[q]; }
            bf16x8 qc[2][4];
#pragma unroll
            for (int p = 0; p < 2; ++p)
#pragma unroll
                for (int ks = 0; ks < 4; ++ks) qc[p][ks] = qn[p][ks];
            const int bn = b + 8 * nwh;
            if (bn < 2048) {
#pragma unroll
                for (int p = 0; p < 2; ++p)
#pragma unroll
                    for (int ks = 0; ks < 4; ++ks) qn[p][ks] = *(const bf16x8*)(Q + (size_t)(bn * 16 + fr) * 2048 + h * 256 + p * 128 + ks * 32 + fq * 8);
            }
            peer_topk_wave(qc, KL, sel_e, sel_g, b * 16, h, lane, scr);
            if (t0) TOPK_ROW_STORE(ra, tx0);
            if (t1) TOPK_ROW_STORE(rb, tx1);
            trow += 2 * NGW;
        }
#pragma unroll 1
        for (; trow < 32768; trow += NGW) { f32x4 tx0[4]; const f32x4* sp = TOPK_ROW_PTR(trow);
#pragma unroll
            for (int q = 0; q < 4; ++q) tx0[q] = sp[q];
            TOPK_ROW_STORE(trow, tx0); }
#undef TOPK_ROW_PTR
#undef TOPK_ROW_STORE
    }
}

typedef float f32x2 __attribute__((ext_vector_type(2)));
template <int CTRL> __device__ __forceinline__ float dppf(float v) { return __uint_as_float((unsigned)__builtin_amdgcn_update_dpp(0, (int)__float_as_uint(v), CTRL, 0xf, 0xf, true)); }
typedef int i32x8 __attribute__((ext_vector_type(8)));
constexpr int GA_SE_OFF = 0, GA_AW_OFF = 32768;
constexpr int GA_IMG_OFF = 0, GA_IMG_WAVE = 16384;
constexpr int GA_WA_OFF = 131072 + 1024, GA_WS_OFF = GA_WA_OFF + 24576;
static_assert(GA_IMG_OFF + 8 * GA_IMG_WAVE <= LDSCTL_OFF && GA_WS_OFF + 512 <= LDS_BYTES, "gather LDS map");
typedef __amdgpu_buffer_rsrc_t brsrc_t;
__device__ __forceinline__ brsrc_t ga_rsrc(const unsigned char* tab) { return __builtin_amdgcn_make_buffer_rsrc((void*)tab, 0, 8 << 20, 0x00020000); }
__device__ __forceinline__ void ga_issue8(u32x4 (&rw)[8], brsrc_t tab, const LAS unsigned short* sep, unsigned so) {
#pragma unroll
    for (int i = 0; i < 8; ++i) { const unsigned e = sep[8 * i]; rw[i] = __builtin_amdgcn_raw_buffer_load_b128(tab, (int)((e << 7) + so), 0, 0); }
}
__device__ __forceinline__ void ga_down8(u32x4 (&rw)[8], const u32x4 hhi, const u32x4 hlo, LAS float* awp, bool c0, brsrc_t tab, const LAS unsigned short* sepn, unsigned son) {
    float d[8];
#pragma unroll
    for (int i = 0; i < 8; ++i) { int ahi = 0, alo = 0;
        const unsigned en = sepn[8 * i];
#pragma unroll
        for (int q = 0; q < 4; ++q) { ahi = __builtin_amdgcn_sdot8((int)rw[i][q], (int)hhi[q], ahi, false); alo = __builtin_amdgcn_sdot8((int)rw[i][q], (int)hlo[q], alo, false); }
        d[i] = (float)(ahi * 16 + alo);
        rw[i] = __builtin_amdgcn_raw_buffer_load_b128(tab, (int)((en << 7) + son), 0, 0);
        __builtin_amdgcn_sched_barrier(0); }
#pragma unroll
    for (int i = 0; i < 8; ++i) d[i] += dppf<0xB1>(d[i]);
#pragma unroll
    for (int i = 0; i < 8; ++i) d[i] += dppf<0x4E>(d[i]);
#pragma unroll
    for (int i = 0; i < 8; ++i) d[i] += dppf<0x141>(d[i]);
    if (c0) { float o[8];
#pragma unroll
        for (int i = 0; i < 8; ++i) o[i] = awp[8 * i];
#pragma unroll
        for (int i = 0; i < 8; ++i) awp[8 * i] = o[i] + d[i]; }
}
template <bool FINAL>
__device__ __forceinline__ void ga_norm16(float* xout, bf16* H, const float* ng, const float* modsN, const size_t t0, const int lane) {
    f32x4 gsc[4], gsh[4];
#pragma unroll
    for (int j = 0; j < 4; ++j) { const f32x4 gg = ((const f32x4*)ng)[lane + 64 * j];
        if (FINAL) { gsc[j] = gg; gsh[j] = (f32x4){0.f, 0.f, 0.f, 0.f}; }
        else { const float* mp = modsN + (size_t)(t0 >> 11) * 6144; const f32x4 a = ((const f32x4*)mp)[lane + 64 * j], b = ((const f32x4*)(mp + 1024))[lane + 64 * j]; gsc[j] = gg * (b + 1.0f); gsh[j] = a; } }
#pragma unroll 1
    for (int tg = 0; tg < 16; tg += 4) {
        f32x4 xv[4][4];
#pragma unroll
        for (int q = 0; q < 4; ++q)
#pragma unroll
            for (int j = 0; j < 4; ++j) xv[q][j] = ((const f32x4*)(xout + (t0 + tg + q) * 1024))[lane + 64 * j];
        float ss[4];
#pragma unroll
        for (int q = 0; q < 4; ++q) { ss[q] = 0.f;
#pragma unroll
            for (int j = 0; j < 4; ++j) ss[q] += (xv[q][j].x * xv[q][j].x + xv[q][j].y * xv[q][j].y) + (xv[q][j].z * xv[q][j].z + xv[q][j].w * xv[q][j].w); }
#pragma unroll
        for (int o = 1; o < 64; o <<= 1)
#pragma unroll
            for (int q = 0; q < 4; ++q) ss[q] += __shfl_xor(ss[q], o);
#pragma unroll
        for (int q = 0; q < 4; ++q) { const float rn = 1.0f / sqrtf(ss[q] * (1.f / 1024.f) + 1e-6f); const size_t t = t0 + tg + q;
            if (FINAL) {
#pragma unroll
                for (int j = 0; j < 4; ++j) ((f32x4*)(xout + t * 1024))[lane + 64 * j] = xv[q][j] * rn * gsc[j];
            } else { u32x2* o8 = (u32x2*)(H + t * 1024) + lane;
#pragma unroll
                for (int j = 0; j < 4; ++j) { const f32x4 y = (xv[q][j] * rn) * gsc[j] + gsh[j]; u32x2 w; w.x = cvt_pk(y.x, y.y); w.y = cvt_pk(y.z, y.w); o8[64 * j] = w; } } }
    }
}
template <bool FINAL>
__device__ __forceinline__ void phase_gather(LAS unsigned char* lds, bf16* H, const unsigned char* HQ, const float* HS, const int* sel_e, const float* sel_g, const unsigned char* down4, const unsigned char* up4, const float* sdown, const float* sup,
                                             const float* modsL, float* xout, const float* ng, const float* modsN, int G, int wg, int mode) {
    const bool dummy = (mode & 1) != 0;
    const int tid = threadIdx.x, lane = tid & 63, wave = __builtin_amdgcn_readfirstlane(tid >> 6);
    const int r = lane >> 3, c = lane & 7;
    LAS unsigned short* SE = (LAS unsigned short*)(lds + GA_SE_OFF);
    LAS float* AW = (LAS float*)(lds + GA_AW_OFF);
#pragma unroll 1
    for (int blk = wg; blk < NTOK / 128; blk += G) {
        const int tb = blk * 128;
        for (int i = tid; i < 128 * 128 / 4; i += 512) { typedef int i32x4 __attribute__((ext_vector_type(4))); const i32x4 e = ((const i32x4*)(sel_e + (size_t)tb * 128))[i];
            u32x2 w; w.x = (unsigned)e.x | ((unsigned)e.y << 16); w.y = (unsigned)e.z | ((unsigned)e.w << 16); ((LAS u32x2*)SE)[i] = w;
            ((LAS f32x4*)AW)[i] = (f32x4){0.f, 0.f, 0.f, 0.f}; }
        __syncthreads();
        const LAS unsigned short* sew = SE + wave * 2048 + r;
        LAS float* aww = AW + wave * 2048 + r;
        unsigned char* const setw = (unsigned char*)sel_e + (WS_SET - WS_SELE) + ((size_t)tb + wave * 16) * 256 + r * 16;
#pragma unroll
        for (int p = c; p < 32; p += 8) { const LAS unsigned short* sp = sew + (p >> 1) * 128 + 64 * (p & 1);
            u32x4 w; w.x = (unsigned)sp[0] | ((unsigned)sp[8] << 16); w.y = (unsigned)sp[16] | ((unsigned)sp[24] << 16); w.z = (unsigned)sp[32] | ((unsigned)sp[40] << 16); w.w = (unsigned)sp[48] | ((unsigned)sp[56] << 16);
            *(u32x4*)(setw + p * 128) = w; }
        if (!(mode & 4)) {
            u32x4 r0[8], r1[8]; u32x4 hn0, hn1;
            const brsrc_t rsd = ga_rsrc(down4);
            const unsigned char* hqw = HQ + ((size_t)tb + wave * 16) * 1024 + c * 16;
            ga_issue8(r0, rsd, sew, (unsigned)(c * 16)); ga_issue8(r1, rsd, sew + 64, (unsigned)(c * 16));
            hn0 = *(const u32x4*)hqw; hn1 = *(const u32x4*)(hqw + 512);
            asm volatile("" :: "v"(hn0), "v"(hn1));
#pragma unroll 1
            for (int it = 0; it < 64; ++it) {
                const u32x4 hhi = hn0, hlo = hn1;
                const int i1 = (it + 1) & 63; const unsigned so1 = ((unsigned)(i1 >> 4) << 21) + (unsigned)(c * 16);
                { const unsigned char* hx = hqw + (size_t)(i1 & 15) * 1024 + (i1 >> 4) * 128; hn0 = *(const u32x4*)hx; hn1 = *(const u32x4*)(hx + 512); }
                __builtin_amdgcn_sched_barrier(0);
                ga_down8(r0, hhi, hlo, aww + (it & 15) * 128, c == 0, rsd, sew + (i1 & 15) * 128, so1);
                ga_down8(r1, hhi, hlo, aww + (it & 15) * 128 + 64, c == 0, rsd, sew + (i1 & 15) * 128 + 64, so1);
                asm volatile("" :: "v"(hn0), "v"(hn1));
            }
        }
        float wr[32];
#pragma unroll 16
        for (int j = 0; j < 32; ++j) { const int idx = wave * 2048 + j * 64 + lane; const unsigned e = SE[idx]; const float* hsp = HS + 2 * ((size_t)tb + (idx >> 7)); const float x = (AW[idx] + 0.5f * hsp[1]) * (sdown[e] * hsp[0]);
            const float g = sel_g[(size_t)tb * 128 + idx]; wr[j] = dummy ? 0.f : ((mode & 2) ? -g : g) * 0.5f * x * (1.0f + erff(x * 0.70710678118654752f)) * sup[e]; }
        __syncthreads();
        {
            LAS unsigned char* WA = lds + GA_WA_OFF + wave * 3072; LAS float* WS = (LAS float*)(lds + GA_WS_OFF) + wave * 16;
#pragma unroll
            for (int tk = 0; tk < 16; ++tk) {
                float m = fmaxf(fabsf(wr[2 * tk]), fabsf(wr[2 * tk + 1]));
#pragma unroll
                for (int o = 1; o < 64; o <<= 1) m = fmaxf(m, __shfl_xor(m, o));
                const float inv = m > 0.f ? 6.0f / m : 0.f;
                if (lane == 0) WS[tk] = m * (1.0f / 6.0f);
#pragma unroll
                for (int hf = 0; hf < 2; ++hf) {
                    const float y = wr[2 * tk + hf] * inv;
                    const unsigned p1 = __builtin_amdgcn_cvt_scalef32_pk_fp4_f32(0u, y, 0.f, 1.0f, 0) & 15u; const float v1 = __builtin_amdgcn_cvt_scalef32_pk_f32_fp4(p1, 1.0f, 0)[0];
                    const float r1 = (y - v1) * 4.0f;
                    const unsigned p2 = __builtin_amdgcn_cvt_scalef32_pk_fp4_f32(0u, r1, 0.f, 1.0f, 0) & 15u; const float v2 = __builtin_amdgcn_cvt_scalef32_pk_f32_fp4(p2, 1.0f, 0)[0];
                    const float r2 = (r1 - v2) * 4.0f;
                    const unsigned p3 = __builtin_amdgcn_cvt_scalef32_pk_fp4_f32(0u, r2, 0.f, 1.0f, 0) & 15u;
                    const unsigned mine = p1 | (p2 << 8) | (p3 << 16);
                    const unsigned other = (unsigned)__builtin_amdgcn_update_dpp(0, (int)mine, 0xB1, 0xf, 0xf, true);
                    const unsigned both = mine | (other << 4);
                    if ((lane & 1) == 0) { LAS unsigned char* wp = WA + tk * 192 + hf * 96 + (lane >> 1);
                        wp[0] = (unsigned char)both; wp[32] = (unsigned char)(both >> 8); wp[64] = (unsigned char)(both >> 16); }
                }
            }
        }
        if (!(mode & 8)) {
            LAS unsigned char* img = lds + GA_IMG_OFF + wave * GA_IMG_WAVE;
            const int ir = 4 * (lane >> 5) + ((lane >> 3) & 1), rr = lane & 7;
            const unsigned rdo = (unsigned)(1024 * ir + 128 * rr + 8 * ((lane >> 4) & 1) + 16 * ((rr >> 1) | ((ir & 1) << 2)));
            const LAS unsigned char* WA = lds + GA_WA_OFF + wave * 3072 + (lane >> 5) * 16 + (lane & 31) * 32;
            const LAS float* WS = (const LAS float*)(lds + GA_WS_OFF) + wave * 16;
            const bool arow = (lane & 31) < 3;
            const brsrc_t rsu = ga_rsrc(up4);
            const unsigned ce16 = 16u * (unsigned)(c ^ (r >> 1));
            const unsigned char* const setr = setw;
#define GA_DMA8(se, buf, so) do { _Pragma("unroll") for (int i = 0; i < 8; ++i) { const unsigned en = ((i & 1) ? ((se)[i >> 1] >> 16) : ((se)[i >> 1] & 0xffffu)); \
                __builtin_amdgcn_raw_ptr_buffer_load_lds(rsu, (__attribute__((address_space(3))) void*)(img + (buf) * 8192 + i * 1024), 16, (int)((en << 7) + ((so) ^ (64u * (i & 1)))), 0, 0, 0); } } while (0)
#define GA_WAITV(n) asm volatile("s_waitcnt vmcnt(" #n ")" ::: "memory")
            const unsigned rda = (unsigned)(__UINTPTR_TYPE__)img + rdo, waa = (unsigned)(__UINTPTR_TYPE__)WA;
            float wsv; { const unsigned a = (unsigned)(__UINTPTR_TYPE__)(WS + (lane & 15)); asm volatile("ds_read_b32 %0, %1\n\ts_waitcnt lgkmcnt(0)" : "=v"(wsv) : "v"(a) : "memory"); }
            u32x4 seA = *(const u32x4*)setr, seB = *(const u32x4*)(setr + 128);
            { const u32x4 seC = *(const u32x4*)(setr + 256);
                GA_DMA8(seA, 0, ce16); GA_DMA8(seB, 1, ce16); seA = seC; }
            float acc8[8], x0[4], g0[4];
#pragma unroll 1
            for (int it = 0; it < 64; ++it) {
                const size_t t = (size_t)tb + wave * 16 + (it & 15); const int col = (it >> 4) * 256 + 128 * (lane >> 5) + (lane & 31);
                float* xp = xout + t * 1024 + col;
#pragma unroll
                for (int hf = 0; hf < 2; ++hf) {
                    if (hf == 0) { if (it == 0) GA_WAITV(8); else GA_WAITV(12); } else GA_WAITV(8);
                    __builtin_amdgcn_sched_barrier(0);
                    typedef int i32x2_t __attribute__((ext_vector_type(2)));
                    i32x2_t b0[8], b1[8]; u32x4 wa;
                    { const unsigned a = waa + (unsigned)((it & 15) * 192 + hf * 96); asm volatile("ds_read_b128 %0, %1" : "=v"(wa) : "v"(a) : "memory"); }
#pragma unroll
                    for (int cb = 0; cb < 8; ++cb) { const unsigned a = (rda ^ (unsigned)(16 * cb)) + (unsigned)(hf * 8192);
                        asm volatile("ds_read_b64_tr_b4 %0, %1" : "=v"(b0[cb]) : "v"(a) : "memory");
                        asm volatile("ds_read_b64_tr_b4 %0, %1 offset:2048" : "=v"(b1[cb]) : "v"(a) : "memory"); }
                    asm volatile("s_waitcnt lgkmcnt(0)" : "+v"(b0[0]), "+v"(b0[1]), "+v"(b0[2]), "+v"(b0[3]), "+v"(b0[4]), "+v"(b0[5]), "+v"(b0[6]), "+v"(b0[7]) :: "memory");
                    asm volatile("" : "+v"(b1[0]), "+v"(b1[1]), "+v"(b1[2]), "+v"(b1[3]), "+v"(b1[4]), "+v"(b1[5]), "+v"(b1[6]), "+v"(b1[7]) :: "memory");
                    asm volatile("" : "+v"(wa) :: "memory");
                    __builtin_amdgcn_sched_barrier(0);
                    const int itn = (it + 1) & 63; const unsigned son = ((unsigned)(itn >> 4) << 21) + ce16;
                    if (hf == 0) { const float* gp = modsL + (size_t)(t >> 11) * 6144 + 5 * 1024 + col;
#pragma unroll
                        for (int j = 0; j < 4; ++j) { x0[j] = xp[32 * j]; g0[j] = gp[32 * j]; }
                        seB = *(const u32x4*)(setr + (size_t)(itn & 15) * 256 + 128);
                        __builtin_amdgcn_sched_barrier(0);
                        GA_DMA8(seA, 0, son);
                    } else {
                        seA = *(const u32x4*)(setr + (size_t)((it + 2) & 15) * 256);
                        __builtin_amdgcn_sched_barrier(0);
                        GA_DMA8(seB, 1, son);
                    }
                    __builtin_amdgcn_sched_barrier(0);
                    i32x8 av; av[0] = arow ? (int)wa[0] : 0; av[1] = arow ? (int)wa[1] : 0; av[2] = arow ? (int)wa[2] : 0; av[3] = arow ? (int)wa[3] : 0; av[4] = 0; av[5] = 0; av[6] = 0; av[7] = 0;
#pragma unroll
                    for (int cb = 0; cb < 8; ++cb) {
                        i32x8 bv; bv[0] = b0[cb][0]; bv[1] = b0[cb][1]; bv[2] = b1[cb][0]; bv[3] = b1[cb][1]; bv[4] = 0; bv[5] = 0; bv[6] = 0; bv[7] = 0;
                        f32x16 dz;
#pragma unroll
                        for (int v = 0; v < 16; ++v) dz[v] = 0.f;
                        dz = __builtin_amdgcn_mfma_scale_f32_32x32x64_f8f6f4(av, bv, dz, 4, 4, 0, 0x7f7f7f7f, 0, 0x7f7f7f7f);
                        const float sdz = dz[0] + 0.25f * dz[1] + 0.0625f * dz[2];
                        acc8[cb] = hf ? acc8[cb] + sdz : sdz;
                    }
                    asm volatile("" : "+v"(acc8[0]), "+v"(acc8[1]), "+v"(acc8[2]), "+v"(acc8[3]), "+v"(acc8[4]), "+v"(acc8[5]), "+v"(acc8[6]), "+v"(acc8[7]));
                    if (hf == 1) { const float sw = __builtin_bit_cast(float, __builtin_amdgcn_readlane(__builtin_bit_cast(int, wsv), it & 15));
#pragma unroll
                        for (int j = 0; j < 4; ++j) { const u32x2 p = __builtin_amdgcn_permlane32_swap(__float_as_uint(acc8[j]), __float_as_uint(acc8[j + 4]), false, false);
                            xp[32 * j] = x0[j] + g0[j] * (sw * __uint_as_float(p.x)); } }
                    __builtin_amdgcn_sched_barrier(0);
                }
            }
            GA_WAITV(0);
        }
        if (!(mode & 16)) ga_norm16<FINAL>(xout, H, ng, modsN, (size_t)tb + wave * 16, lane);
        __syncthreads();
    }
}

__device__ __forceinline__ void phase_conv(const bf16* BGU, const float* cw, bf16* Z, int G, int wg) {
    for (int item = wg * 512 + threadIdx.x; item < NTOK * 128; item += G * 512) {
        const int t = item >> 7, d0 = (item & 127) * 8, n = t & 2047;
        const bf16* row = BGU + (size_t)t * 2048 + d0;
        const u32x4 bg = *(const u32x4*)row;
        float y[8];
#pragma unroll
        for (int i = 0; i < 8; ++i) y[i] = 0.f;
#pragma unroll
        for (int dn = -1; dn <= 1; ++dn) {
            if (n + dn < 0 || n + dn >= 2048) continue;
            const u32x4 uu = *(const u32x4*)(row + (ptrdiff_t)dn * 2048 + 1024);
            const f32x4 w0 = *(const f32x4*)(cw + (dn + 1) * 1024 + d0), w1 = *(const f32x4*)(cw + (dn + 1) * 1024 + d0 + 4);
#pragma unroll
            for (int q = 0; q < 4; ++q) { const float wl = (q < 2) ? w0[2 * q] : w1[2 * q - 4], wh = (q < 2) ? w0[2 * q + 1] : w1[2 * q - 3];
                y[2 * q] += wl * bf_lo(uu[q]); y[2 * q + 1] += wh * bf_hi(uu[q]); }
        }
        u32x4 o;
#pragma unroll
        for (int q = 0; q < 4; ++q) o[q] = cvt_pk(bf_lo(bg[q]) * y[2 * q], bf_hi(bg[q]) * y[2 * q + 1]);
        *(u32x4*)(Z + (size_t)t * 1024 + d0) = o;
    }
}

__global__ void __launch_bounds__(NWAVES * 64, 2) fwd(Args args) {
    extern __shared__ __attribute__((aligned(16))) unsigned char lds_raw[];
    LAS unsigned char* lds = (LAS unsigned char*)lds_raw;
    const int tid = threadIdx.x, lane = tid & 63, wave = __builtin_amdgcn_readfirstlane(tid >> 6);
    const int G = gridDim.x, wg = blockIdx.x;
    const int gw = wg * NWAVES + wave, NGW = G * NWAVES;
    unsigned char* ws = args.ws;
    unsigned* ctl = (unsigned*)(ws + WS_CTL);
    for (int u = tid; u < (LDS_BYTES - LDSCTL_OFF) / 4; u += NWAVES * 64) ((LAS unsigned*)(lds + LDSCTL_OFF))[u] = 0u;
    __syncthreads();
    XcdBarrier bar; bar.bar = ctl + CW_BAR; bar.x = 0; bar.st = nullptr;
    if (N_LAUNCHES == 1) bar = xcd_barrier_post(ctl + CW_BAR, (volatile LAS unsigned*)(lds + MISC_OFF) + 8);
#define GRID_BAR() do { if (N_LAUNCHES == 1) xcd_barrier(bar); } while (0)
    const int lo = args.ph_lo, hi = args.ph_hi;
#ifndef PHASE_MASK
#define PHASE_MASK 0xffff
#endif
#define IN(k) (((PHASE_MASK >> (k)) & 1) && lo <= (k) && (k) < hi)
#define BOTH(k) (IN(k) && IN((k) + 1))
    const float* mods = (const float*)(ws + WS_MOD);
    float* xout = args.out;
    bf16* H = (bf16*)(ws + WS_H);

    if (IN(0)) { for (int rep = 0; rep < NREP(0); ++rep) { phase_prep(args, lds, G, wg, rep, 0); __syncthreads(); } if (BOTH(0)) GRID_BAR(); }
    if (IN(1)) { phase_prep(args, lds, G, wg, 0, 1); __syncthreads();
                 for (int rep = 0; rep < NREP(1); ++rep) phase_norm(args.in[0], args.in[2], args.in[6], mods, 0, H, nullptr, nullptr, nullptr, G, wg);
                 phase_wq8(args.in[16], (const float*)((const unsigned*)(ws + WS_CTL) + CW_COLMAX), ws + WS_WQ_T, lds, G, wg); if (BOTH(1)) GRID_BAR(); }
    if (IN(2)) {
        for (int rep = 0; rep < NREP(2); ++rep) {
        { pg8::Gemm g{H, (const bf16*)(ws + WS_WIN_T), NTT, 1024, 1024}; pg8::StaticOrder S; S.init(NTT, 1024, G, wg);
          pg8::EpiBf16 E{(bf16*)(ws + WS_QK), 1024, 2, 0.125f};
          pg8::gemm_phase<pg8::EpiBf16, pg8::StaticOrder, true, true>(lds + RING_OFF, g, S, E); }
        { pg8::Gemm g{(const bf16*)(ws + WS_WIN_T) + (size_t)1024 * 1024, H, 1024, NTT, 1024}; pg8::StaticOrder S; S.init(1024, NTT, G, wg);
          pg8::EpiVF E{(bf16*)(ws + WS_VT), (bf16*)(ws + WS_VTC), (bf16*)(ws + WS_FT)};
          pg8::gemm_phase<pg8::EpiVF, pg8::StaticOrder, true, true>(lds + RING_OFF, g, S, E); }
        }
        if (BOTH(2)) GRID_BAR();
    }
    if (IN(3)) {
        { LAS float* rpl = (LAS float*)(lds + NWAVES * ATT_WAVE_LDS); for (int e = tid; e < 8 * 15 * 31; e += NWAVES * 64) rpl[e] = args.in[11][e]; __syncthreads();
          for (int rep = 0; rep < ((PROBE_PHASE == 3 && PROBE_SUB != 2) ? 2 : 1); ++rep)
          for (int u0 = wg; u0 < 1024; u0 += G) {
              int u = u0; if (G == 256) { const int xcd = wg & 7, idx = wg >> 3, round = u0 >> 8; u = ((xcd * 16 + round * 4 + (idx >> 3)) << 3) | (idx & 7); }
              const int b = u >> 6, h = (u >> 3) & 7, rq = u & 7;
              na_attn32_wave((const bf16*)(ws + WS_QK), (const bf16*)(ws + WS_VT), (const bf16*)(ws + WS_VTC), rpl + h * 465, lds + wave * ATT_WAVE_LDS, (bf16*)(ws + WS_A2), b, h, 4 * rq + 2 * (wave >> 2), wave & 3, lane);
          } }
        __syncthreads();
        for (int task = gw; task < 16 * 512; task += NGW) {
            const bf16* fp = (const bf16*)(ws + WS_FT) + (size_t)task * 2048 + lane * 32; float sacc = 0.f;
#pragma unroll
            for (int q = 0; q < 4; ++q) { const u32x4 v = *(const u32x4*)(fp + 8 * q);
#pragma unroll
                for (int z = 0; z < 4; ++z) sacc += bf_lo(v[z]) - bf_hi(v[z]); }
            sacc = wave_sum(sacc);
            if (lane == 0) { bf16* op = (bf16*)(ws + WS_A2) + ((size_t)(task >> 9) * 2048 + 1024) * 1536 + 512 + (task & 511); op[0] = (bf16)(cvt_pk(sacc, 0.f) & 0xffffu); op[512] = 0; }
        }
        { pg8::Gemm g{(const bf16*)(ws + WS_DFT), (const bf16*)(ws + WS_FT), 2048, 8192, 2048}; pg8::StaticOrder S; S.init(2048, 8192, G, wg);
          pg8::EpiDft E{(bf16*)(ws + WS_A2)};
          pg8::gemm_phase<pg8::EpiDft, pg8::StaticOrder, true, true>(lds + RING_OFF, g, S, E);
          if (PROBE_PHASE == 3 && PROBE_SUB != 1) pg8::gemm_phase<pg8::EpiDft, pg8::StaticOrder, true, true>(lds + RING_OFF, g, S, E); }
        if (BOTH(3)) GRID_BAR();
    }
    if (IN(4)) {
        pg8::Gemm g{(const bf16*)(ws + WS_A2), (const bf16*)(ws + WS_WOUT_T), NTOK, 1024, 1536}; pg8::StaticOrder S; S.init(NTOK, 1024, G, wg);
        pg8::EpiRes E{args.in[0], xout, mods + 2 * 1024, 6144, 1.f};
        pg8::gemm_phase<pg8::EpiRes, pg8::StaticOrder, true, true>(lds + RING_OFF, g, S, E); if (PROBE_PHASE == 4) pg8::gemm_phase<pg8::EpiRes, pg8::StaticOrder, true, true>(lds + RING_OFF, g, S, E);
        if (BOTH(4)) GRID_BAR();
    }
#define PEER_LAYER(L, pb) do { \
        const float* modsL = mods + (size_t)(L) * 17 * 6144; \
        if (IN(pb)) { for (int rep = 0; rep < NREP(pb); ++rep) phase_norm(xout, nullptr, args.in[7] + (L) * 1024, modsL, 3, H, ws + WS_HQ, ws + WS_HQ8, (float*)(ws + WS_HS), G, wg); if (BOTH(pb)) GRID_BAR(); } \
        if (IN((pb) + 1)) { \
              \
            pg8::Gemm g{(const bf16*)(ws + WS_HQ8), (const bf16*)(ws + WS_WQ_T) + (size_t)(L) * 2048 * 512, NTOK, 2048, 512}; pg8::StaticOrder S; S.init(NTOK, 2048, G, wg); \
            pg8::EpiQ8 E{(bf16*)(ws + WS_PQ), (const float*)(ws + WS_HS), (const float*)((const unsigned*)(ws + WS_CTL) + CW_COLMAX) + (L) * 2048}; \
            pg8::gemm_phase<pg8::EpiQ8, pg8::StaticOrder, true, true>(lds + RING_OFF, g, S, E); if (PROBE_PHASE == (pb) + 1) pg8::gemm_phase<pg8::EpiQ8, pg8::StaticOrder, true, true>(lds + RING_OFF, g, S, E); \
            if (BOTH((pb) + 1)) GRID_BAR(); \
        } \
        if (IN((pb) + 2)) { \
            const bf16* KEYS = (const bf16*)(ws + WS_KEYS) + (size_t)(L) * 8 * 2 * 128 * 128; \
            for (int rep = 0; rep < NREP((pb) + 2); ++rep) phase_topk(lds, (const bf16*)(ws + WS_PQ), KEYS, (int*)(ws + WS_SELE), (float*)(ws + WS_SELG), args.in[18] + (size_t)(L) * 16384 * 1024, args.in[19] + (size_t)(L) * 16384 * 1024, ws + WS_TAB + (size_t)(2 * (L)) * 8 * MiB, (float*)(ws + WS_TSC) + (2 * (L)) * 16384, G, wg); \
            if (BOTH((pb) + 2)) GRID_BAR(); \
        } \
        if (IN((pb) + 3)) { \
            const unsigned char* down8 = ws + WS_TAB + (size_t)(2 * (L)) * 8 * MiB; const unsigned char* up8 = ws + WS_TAB + (size_t)(2 * (L) + 1) * 8 * MiB; \
            const float* sdn = (const float*)(ws + WS_TSC) + (2 * (L)) * 16384; const float* sup = sdn + 16384; \
            for (int grep_ = 0; grep_ < ((PROBE_PHASE == (pb) + 3 && PROBE_SUB >= 3) ? 3 : 1); ++grep_) { const int GMODE = (PROBE_PHASE != (pb) + 3 || PROBE_SUB < 3) ? 0 : (PROBE_SUB == 3) ? ((grep_ == 1) ? 2 : 0) : (PROBE_SUB == 4) ? (((grep_ == 1) ? 2 : 0) | (grep_ < 2 ? 16 : 0)) : (grep_ < 2 ? 12 : 0); \
            if ((L) == 0) phase_gather<false>(lds, H, ws + WS_HQ, (const float*)(ws + WS_HS), (const int*)(ws + WS_SELE), (const float*)(ws + WS_SELG), down8, up8, sdn, sup, modsL, xout, args.in[6] + 1024, mods + (size_t)17 * 6144, G, wg, GMODE); \
            else phase_gather<true>(lds, H, ws + WS_HQ, (const float*)(ws + WS_HS), (const int*)(ws + WS_SELE), (const float*)(ws + WS_SELG), down8, up8, sdn, sup, modsL, xout, args.in[8], nullptr, G, wg, GMODE); } \
            if (PROBE_PHASE == (pb) + 3 && PROBE_SUB < 3) phase_gather<true>(lds, H, ws + WS_HQ, (const float*)(ws + WS_HS), (const int*)(ws + WS_SELE), (const float*)(ws + WS_SELG), down8, up8, sdn, sup, modsL, xout, args.in[8], nullptr, G, wg, 17 | (PROBE_SUB == 1 ? 8 : PROBE_SUB == 2 ? 4 : 0)); \
            if (BOTH((pb) + 3)) GRID_BAR(); \
        } } while (0)

    PEER_LAYER(0, 5);
    if (IN(9)) {
        pg8::Gemm g{H, (const bf16*)(ws + WS_CVIN_T), NTOK, 3072, 1024}; pg8::StaticOrder S; S.init(NTOK, 3072, G, wg);
        pg8::EpiCv E{(bf16*)(ws + WS_BCV)};
        pg8::gemm_phase<pg8::EpiCv, pg8::StaticOrder, true, true>(lds + RING_OFF, g, S, E); if (PROBE_PHASE == 9) pg8::gemm_phase<pg8::EpiCv, pg8::StaticOrder, true, true>(lds + RING_OFF, g, S, E);
        if (BOTH(9)) GRID_BAR();
    }
    if (IN(10)) { for (int rep = 0; rep < NREP(10); ++rep) phase_conv((const bf16*)(ws + WS_BCV), args.in[14], H, G, wg); if (BOTH(10)) GRID_BAR(); }
    if (IN(11)) {
        pg8::Gemm g{H, (const bf16*)(ws + WS_CVOUT_T), NTOK, 1024, 1024}; pg8::StaticOrder S; S.init(NTOK, 1024, G, wg);
        pg8::EpiRes E{xout, xout, mods + (size_t)17 * 6144 + 2 * 1024, 6144, 1.f};
        pg8::gemm_phase<pg8::EpiRes, pg8::StaticOrder, true, true>(lds + RING_OFF, g, S, E);
        if (PROBE_PHASE == 11) { pg8::EpiRes E0{xout, xout, mods + (size_t)17 * 6144 + 2 * 1024, 6144, __int_as_float(args.pad)}; pg8::gemm_phase<pg8::EpiRes, pg8::StaticOrder, true, true>(lds + RING_OFF, g, S, E0); }
        if (BOTH(11)) GRID_BAR();
    }
    PEER_LAYER(1, 12);
#undef PEER_LAYER
#undef IN
#undef BOTH
#undef GRID_BAR
}

extern "C" void kernel_launch(void* const* d_in, const int* in_sizes, int n_in, void* d_out, int out_size, void* d_ws, size_t ws_size, hipStream_t stream) {
    static int grid = 0;
    if (grid == 0) {
        if (n_in != 20 || out_size != NTOK * D || ws_size < WS_END) { fprintf(stderr, "kernel_launch: unexpected shapes (n_in %d, out %d, ws %zu); nothing launched\n", n_in, out_size, ws_size); grid = -1; return; }
        int dev = 0, cus = 0;
        if (hipGetDevice(&dev) != hipSuccess || hipDeviceGetAttribute(&cus, hipDeviceAttributeMultiprocessorCount, dev) != hipSuccess) { grid = -1; return; }
        if (hipFuncSetAttribute((const void*)fwd, hipFuncAttributeMaxDynamicSharedMemorySize, LDS_BYTES) != hipSuccess) { fprintf(stderr, "kernel_launch: hipFuncSetAttribute failed\n"); grid = -1; return; }
        int per_cu = 0;
        if (hipOccupancyMaxActiveBlocksPerMultiprocessor(&per_cu, (const void*)fwd, NWAVES * 64, LDS_BYTES) != hipSuccess || per_cu < 1) fprintf(stderr, "kernel_launch: occupancy query reports %d\n", per_cu);
        (void)hipGetLastError();
        grid = cus;
    }
    if (grid < 0) return;
    (void)hipMemsetAsync((char*)d_ws + WS_CTL, 0, CTL_ZERO_BYTES, stream);
    Args a{};
    for (int i = 0; i < 20; ++i) a.in[i] = (const float*)d_in[i];
    a.out = (float*)d_out; a.ws = (unsigned char*)d_ws;
    for (int li = 0; li < N_LAUNCHES; ++li) {
        a.ph_lo = (N_LAUNCHES == 1) ? 0 : li; a.ph_hi = (N_LAUNCHES == 1) ? N_PHASES : li + 1; a.li = li;
        hipLaunchKernelGGL(fwd, dim3(grid), dim3(NWAVES * 64), LDS_BYTES, stream, a);
    }
}
```

```cpp
#include <hip/hip_runtime.h>
#include <cstdio>
#include <cstdint>

#ifndef MK_N_LAUNCHES
#define MK_N_LAUNCHES 1
#endif

#ifndef PROBE_PHASE
#define PROBE_PHASE (-1)
#endif
#ifndef PROBE_SUB
#define PROBE_SUB 0
#endif
#define NREP(k) ((PROBE_PHASE == (k)) ? 2 : 1)
#define LAS __attribute__((address_space(3)))
typedef unsigned short bf16;
typedef short bf16x8 __attribute__((ext_vector_type(8)));
typedef float f32x4 __attribute__((ext_vector_type(4)));
typedef unsigned u32x4 __attribute__((ext_vector_type(4)));
typedef unsigned u32x2 __attribute__((ext_vector_type(2)));
typedef __bf16 bf16v2 __attribute__((ext_vector_type(2)));

namespace pg8 {
#define PG8_LAS __attribute__((address_space(3)))
typedef unsigned short bf16_t;
constexpr int BM = 256, BK = 64, HALF = 128, HTB = HALF * BK * 2, STAGE_BYTES = 8 * HTB, NXCD = 8, WGM = 8;

__host__ __device__ __forceinline__ int lds_byte(int r, int c) { const int st = (r >> 4) * 2 + (c >> 5), rr = r & 15, cc = c & 31, ob = rr * 64 + cc * 2; return st * 1024 + (ob ^ (((ob >> 9) & 1) << 5)); }
__host__ __device__ __forceinline__ void stage_rc(int b, int& R, int& C) { const int st = b / 1024, sb = b % 1024, swz = sb ^ (((sb >> 9) & 1) << 5); R = (st >> 1) * 16 + swz / 64; C = (st & 1) * 32 + (swz % 64) / 2; }
__host__ __device__ __forceinline__ int perm32(int rho) { const int n = rho >> 4, i = rho & 15; return 8 * (i >> 2) + 4 * n + (i & 3); }

struct Unit { int pm, pn; };
struct Gemm { const bf16_t* A; const bf16_t* Bt; int M, N, K; };

struct StaticOrder {
    int nM, nN, nwg, G, c;
    __host__ __device__ void init(int M, int N, int G_, int c_) { nM = M / BM; nN = N / BM; nwg = nM * nN; G = G_; c = c_; }
    __host__ __device__ bool next(int i, Unit& u) const {
        const long L = (long)i * G + c; if (L >= nwg) return false;
        int wgid = (int)L; { const int q = nwg / NXCD, r = nwg % NXCD, xcd = wgid % NXCD, off = wgid / NXCD; wgid = (xcd < r ? xcd * (q + 1) : r * (q + 1) + (xcd - r) * q) + off; }
        const int nig = WGM * nN, gid = wgid / nig, fm = gid * WGM, gsz = (nM - fm) < WGM ? (nM - fm) : WGM;
        u.pm = fm + ((wgid % nig) % gsz); u.pn = (wgid % nig) / gsz; return true;
    }
    __device__ __forceinline__ void a_ready(const Unit&) const {}
    __device__ __forceinline__ void done(const Unit&) const {}
};

__device__ __forceinline__ unsigned cvt_pk_bf16(float lo, float hi) { unsigned r; asm volatile("v_cvt_pk_bf16_f32 %0, %1, %2" : "=v"(r) : "v"(lo), "v"(hi)); return r; }


struct EpiBf16 {
    static constexpr bool PERM = true, AFTER_DRAIN = false;
    bf16_t* O; int ldc; int nscale; float scale0;
    __device__ __forceinline__ void operator()(const f32x4 (&acc)[2][2][4][2], const Unit& u, int wr, int wc, int fr, int fq) const {
        const int row0 = u.pm * BM + wr * 64 + fr; const int col0 = u.pn * BM + wc * 32 + 8 * fq;
        const float sc = (u.pn < nscale) ? scale0 : 1.f;
#pragma unroll
        for (int ai = 0; ai < 2; ++ai)
#pragma unroll
            for (int m = 0; m < 4; ++m) { bf16_t* rowp = O + (size_t)(row0 + ai * HALF + m * 16) * ldc + col0;
#pragma unroll
                for (int bj = 0; bj < 2; ++bj) { f32x4 v0 = acc[ai][bj][m][0] * sc, v1 = acc[ai][bj][m][1] * sc;
                    u32x4 w; w.x = cvt_pk_bf16(v0[0], v0[1]); w.y = cvt_pk_bf16(v0[2], v0[3]); w.z = cvt_pk_bf16(v1[0], v1[1]); w.w = cvt_pk_bf16(v1[2], v1[3]);
                    *(u32x4*)(rowp + bj * HALF) = w; } }
    }
};
struct EpiCv {
    static constexpr bool PERM = true, AFTER_DRAIN = false;
    bf16_t* O;
    __device__ __forceinline__ void operator()(const f32x4 (&acc)[2][2][4][2], const Unit& u, int wr, int wc, int fr, int fq) const {
        const int row0 = u.pm * BM + wr * 64 + fr;
        if (u.pn < 4) {
            const int col0 = u.pn * BM + wc * 32 + 8 * fq;
#pragma unroll
            for (int ai = 0; ai < 2; ++ai)
#pragma unroll
                for (int m = 0; m < 4; ++m) { bf16_t* rowp = O + (size_t)(row0 + ai * HALF + m * 16) * 2048 + col0;
#pragma unroll
                    for (int bj = 0; bj < 2; ++bj) { const f32x4 v0 = acc[ai][bj][m][0], v1 = acc[ai][bj][m][1];
                        u32x4 w; w.x = cvt_pk_bf16(v0[0], v0[1]); w.y = cvt_pk_bf16(v0[2], v0[3]); w.z = cvt_pk_bf16(v1[0], v1[1]); w.w = cvt_pk_bf16(v1[2], v1[3]);
                        *(u32x4*)(rowp + bj * HALF) = w; } }
        } else {
            const int col0 = 1024 + (u.pn - 4) * HALF + wc * 32 + 8 * fq;
#pragma unroll
            for (int ai = 0; ai < 2; ++ai)
#pragma unroll
                for (int m = 0; m < 4; ++m) { const f32x4 v0 = acc[ai][0][m][0] * acc[ai][1][m][0], v1 = acc[ai][0][m][1] * acc[ai][1][m][1];
                    u32x4 w; w.x = cvt_pk_bf16(v0[0], v0[1]); w.y = cvt_pk_bf16(v0[2], v0[3]); w.z = cvt_pk_bf16(v1[0], v1[1]); w.w = cvt_pk_bf16(v1[2], v1[3]);
                    *(u32x4*)(O + (size_t)(row0 + ai * HALF + m * 16) * 2048 + col0) = w; }
        }
    }
};
struct EpiVF {
    static constexpr bool PERM = true, AFTER_DRAIN = false;
    bf16_t* VT; bf16_t* VTC; bf16_t* FT;
    __device__ __forceinline__ void operator()(const f32x4 (&acc)[2][2][4][2], const Unit& u, int wr, int wc, int fr, int fq) const {
        const int row0 = u.pm * BM + wr * 64 + fr; const int tok0 = u.pn * BM;
        const bool isf = u.pm >= 2, isctx = tok0 >= 32768;
        if (isf && isctx) return;
        bf16_t* base; int pitch, cbase;
        if (!isctx) { const int b = tok0 >> 11; pitch = 2048; cbase = (tok0 & 2047) + wc * 32 + 8 * fq; base = (isf ? FT : VT) + (size_t)b * 512 * 2048; }
        else { const int tc = tok0 - 32768; const int b = tc >> 8; pitch = 256; cbase = wc * 32 + 8 * fq; base = VTC + (size_t)b * 512 * 256; }
        const int rsub = isf ? 512 : 0;
#pragma unroll
        for (int ai = 0; ai < 2; ++ai)
#pragma unroll
            for (int m = 0; m < 4; ++m) { bf16_t* rowp = base + (size_t)(row0 + ai * HALF + m * 16 - rsub) * pitch + cbase;
#pragma unroll
                for (int bj = 0; bj < 2; ++bj) { const f32x4 v0 = acc[ai][bj][m][0], v1 = acc[ai][bj][m][1];
                    u32x4 w; w.x = cvt_pk_bf16(v0[0], v0[1]); w.y = cvt_pk_bf16(v0[2], v0[3]); w.z = cvt_pk_bf16(v1[0], v1[1]); w.w = cvt_pk_bf16(v1[2], v1[3]);
                    *(u32x4*)(rowp + bj * HALF) = w; } }
    }
};
struct EpiDft {
    static constexpr bool PERM = true, AFTER_DRAIN = false;
    bf16_t* A2;
    __device__ __forceinline__ void operator()(const f32x4 (&acc)[2][2][4][2], const Unit& u, int wr, int wc, int fr, int fq) const {
        const int kp0 = u.pm * BM + wr * 64 + fr; const int part = kp0 >> 10;
        const int bc0 = u.pn * BM; const int b = bc0 >> 9; const int ch0 = (bc0 & 511) + wc * 32 + 8 * fq;
        bf16_t* base = A2 + (size_t)b * 2048 * 1536 + 512 + part * 512 + ch0;
        const float sg = part ? -1.f : 1.f;
#pragma unroll
        for (int ai = 0; ai < 2; ++ai)
#pragma unroll
            for (int m = 0; m < 4; ++m) { const int k = (kp0 & 1023) + ai * HALF + m * 16; bf16_t* rowp = base + (size_t)k * 1536; bf16_t* mirp = base + (size_t)(2048 - k) * 1536;
#pragma unroll
                for (int bj = 0; bj < 2; ++bj) { const f32x4 v0 = acc[ai][bj][m][0], v1 = acc[ai][bj][m][1];
                    u32x4 w; w.x = cvt_pk_bf16(v0[0], v0[1]); w.y = cvt_pk_bf16(v0[2], v0[3]); w.z = cvt_pk_bf16(v1[0], v1[1]); w.w = cvt_pk_bf16(v1[2], v1[3]);
                    *(u32x4*)(rowp + bj * HALF) = w;
                    if (k > 0) { const f32x4 n0 = v0 * sg, n1 = v1 * sg; u32x4 x; x.x = cvt_pk_bf16(n0[0], n0[1]); x.y = cvt_pk_bf16(n0[2], n0[3]); x.z = cvt_pk_bf16(n1[0], n1[1]); x.w = cvt_pk_bf16(n1[2], n1[3]);
                        *(u32x4*)(mirp + bj * HALF) = x; } } }
    }
};
struct EpiRes {
    static constexpr bool PERM = false, AFTER_DRAIN = false;
    const float* base; float* out; const float* gate; int gpitch; float gsc;
    __device__ __forceinline__ void operator()(const f32x4 (&acc)[2][2][4][2], const Unit& u, int wr, int wc, int fr, int fq) const {
        const int row0 = u.pm * BM + wr * 64 + fr, col0 = u.pn * BM + wc * 32 + 4 * fq;
        const float* gp = gate + (size_t)((u.pm * BM) >> 11) * gpitch + col0;
        f32x4 gv[2][2];
#pragma unroll
        for (int bj = 0; bj < 2; ++bj)
#pragma unroll
            for (int n = 0; n < 2; ++n) gv[bj][n] = *(const f32x4*)(gp + bj * HALF + n * 16);
#pragma unroll
        for (int ai = 0; ai < 2; ++ai)
#pragma unroll
            for (int m = 0; m < 4; ++m) { const size_t off = (size_t)(row0 + ai * HALF + m * 16) * 1024 + col0;
#pragma unroll
                for (int bj = 0; bj < 2; ++bj)
#pragma unroll
                    for (int n = 0; n < 2; ++n) { const f32x4 bs = *(const f32x4*)(base + off + bj * HALF + n * 16);
                        *(f32x4*)(out + off + bj * HALF + n * 16) = bs + gv[bj][n] * acc[ai][bj][m][n] * gsc; }
                asm volatile("" ::: "memory"); }
    }
};

typedef int i32x4_t __attribute__((ext_vector_type(4)));
struct EpiQ8 {
    static constexpr bool PERM = true, AFTER_DRAIN = false, I8 = true;
    bf16_t* O; const float* hs; const float* wsc;
    __device__ __forceinline__ void operator()(const f32x4 (&acc)[2][2][4][2], const Unit& u, int wr, int wc, int fr, int fq) const {
        const int row0 = u.pm * BM + wr * 64 + fr, col0 = u.pn * BM + wc * 32 + 8 * fq;
        f32x4 cs[2][2];
#pragma unroll
        for (int bj = 0; bj < 2; ++bj)
#pragma unroll
            for (int n = 0; n < 2; ++n) cs[bj][n] = *(const f32x4*)(wsc + col0 + bj * HALF + n * 4) * (1.0f / 127.0f);
#pragma unroll
        for (int ai = 0; ai < 2; ++ai)
#pragma unroll
            for (int m = 0; m < 4; ++m) { const int row = row0 + ai * HALF + m * 16; const float rs = hs[2 * (size_t)row];
                bf16_t* rowp = O + (size_t)row * 2048 + col0;
#pragma unroll
                for (int bj = 0; bj < 2; ++bj) { const i32x4_t a0 = __builtin_bit_cast(i32x4_t, acc[ai][bj][m][0]), a1 = __builtin_bit_cast(i32x4_t, acc[ai][bj][m][1]);
                    f32x4 v0, v1;
#pragma unroll
                    for (int z = 0; z < 4; ++z) { v0[z] = (float)a0[z] * rs * cs[bj][0][z]; v1[z] = (float)a1[z] * rs * cs[bj][1][z]; }
                    u32x4 w; w.x = cvt_pk_bf16(v0[0], v0[1]); w.y = cvt_pk_bf16(v0[2], v0[3]); w.z = cvt_pk_bf16(v1[0], v1[1]); w.w = cvt_pk_bf16(v1[2], v1[3]);
                    *(u32x4*)(rowp + bj * HALF) = w; } }
    }
};

template <class E, class = void> struct epi_is_i8 { static constexpr bool value = false; };
template <class E> struct epi_is_i8<E, decltype((void)E::I8)> { static constexpr bool value = E::I8; };
template <class Epi, class Sched, bool ALIGN_EPI = false, bool SP2 = false>
__device__ __forceinline__ void gemm_phase(PG8_LAS unsigned char* lds, const Gemm g, const Sched& S, const Epi& E) {
    const int tid = threadIdx.x, wid = __builtin_amdgcn_readfirstlane(tid >> 6), lane = tid & 63, wr = wid >> 2, wc = wid & 3, fr = lane & 15, fq = lane >> 4;
    const int K = g.K, nt = K / BK;
    unsigned voffA[2], voffB[2];
#pragma unroll
    for (int i = 0; i < 2; ++i) { int R, C; stage_rc(tid * 16 + i * 8192, R, C); const int Rb = Epi::PERM ? ((R & ~31) + perm32(R & 31)) : R;
        voffA[i] = (unsigned)(R * K + C) * 2u; voffB[i] = (unsigned)(Rb * K + C) * 2u; }
    const size_t kstep = (size_t)(BK * 2);
    const size_t hstep = (size_t)HALF * K * 2;
    const size_t tstep = 2 * hstep;
    const unsigned ldsw = (unsigned)wid * 1024u;
    const int aoff = lds_byte(wr * 64 + fr, fq * 8), boff = lds_byte(wc * 32 + fr, fq * 8);
#define PG8_SA(b, h) (((b) * 2 + (h)) * HTB)
#define PG8_SB(b, h) ((4 + (b) * 2 + (h)) * HTB)
#define PG8_STAGE(bufoff, gbase, voff) do { _Pragma("unroll") for (int _i = 0; _i < 2; ++_i) \
        __builtin_amdgcn_global_load_lds((const unsigned*)((const char*)(gbase) + (voff)[_i]), (PG8_LAS unsigned*)(lds + (bufoff) + ldsw + _i * 8192), 16, 0, 0); } while (0)
#define PG8_LDA(dst, b, h) do { _Pragma("unroll") for (int m = 0; m < 4; ++m) _Pragma("unroll") for (int k = 0; k < 2; ++k) dst[m][k] = *(const PG8_LAS bf16x8*)(lds + PG8_SA(b, h) + aoff + m * 2048 + k * 1024); } while (0)
#define PG8_LDB(dst, b, h) do { _Pragma("unroll") for (int n = 0; n < 2; ++n) _Pragma("unroll") for (int k = 0; k < 2; ++k) dst[n][k] = *(const PG8_LAS bf16x8*)(lds + PG8_SB(b, h) + boff + n * 2048 + k * 1024); } while (0)
#define PG8_MMA(ai, bj, At, Bt) do { __builtin_amdgcn_s_setprio(1); _Pragma("unroll") for (int m = 0; m < 4; ++m) _Pragma("unroll") for (int n = 0; n < 2; ++n) _Pragma("unroll") for (int k = 0; k < 2; ++k) { \
        if constexpr (epi_is_i8<Epi>::value) acc[ai][bj][m][n] = __builtin_bit_cast(f32x4, __builtin_amdgcn_mfma_i32_16x16x64_i8(__builtin_bit_cast(i32x4_t, Bt[n][k]), __builtin_bit_cast(i32x4_t, At[m][k]), __builtin_bit_cast(i32x4_t, acc[ai][bj][m][n]), 0, 0, 0)); \
        else acc[ai][bj][m][n] = __builtin_amdgcn_mfma_f32_16x16x32_bf16(Bt[n][k], At[m][k], acc[ai][bj][m][n], 0, 0, 0); } __builtin_amdgcn_s_setprio(0); } while (0)
#define PG8_WAIT_V(n) asm volatile("s_waitcnt vmcnt(" #n ")" ::: "memory")
#define PG8_WAIT_L(n) asm volatile("s_waitcnt lgkmcnt(" #n ")" ::: "memory")
#define PG8_BAR __builtin_amdgcn_s_barrier()
#define PG8_SCHED __builtin_amdgcn_sched_barrier(0)
    Unit cur, nxt; int ui = 0;
    if (!S.next(0, cur)) return;
    f32x4 acc[2][2][4][2];
#pragma unroll
    for (int a = 0; a < 2; ++a)
#pragma unroll
        for (int b = 0; b < 2; ++b)
#pragma unroll
            for (int m = 0; m < 4; ++m)
#pragma unroll
                for (int n = 0; n < 2; ++n) acc[a][b][m][n] = (f32x4){0.f, 0.f, 0.f, 0.f};
    bf16x8 At[4][2], B0[2][2], B1[2][2];
    const char* cA = (const char*)g.A + (size_t)cur.pm * tstep; const char* cB = (const char*)g.Bt + (size_t)cur.pn * tstep;
    S.a_ready(cur);
    if constexpr (SP2) {
        PG8_STAGE(PG8_SB(0, 0), cB, voffB); PG8_STAGE(PG8_SB(0, 1), cB + hstep, voffB); PG8_STAGE(PG8_SA(0, 0), cA, voffA); PG8_STAGE(PG8_SA(0, 1), cA + hstep, voffA);
        if (wr == 1) PG8_BAR;
        PG8_WAIT_V(2); PG8_BAR;
        PG8_STAGE(PG8_SB(1, 0), cB + kstep, voffB); PG8_STAGE(PG8_SA(1, 0), cA + kstep, voffA); PG8_STAGE(PG8_SB(1, 1), cB + hstep + kstep, voffB);
        PG8_WAIT_V(6); PG8_BAR;
    } else {
        PG8_STAGE(PG8_SB(0, 0), cB, voffB); PG8_STAGE(PG8_SA(0, 0), cA, voffA); PG8_STAGE(PG8_SB(0, 1), cB + hstep, voffB); PG8_STAGE(PG8_SA(0, 1), cA + hstep, voffA);
        if (wr == 1) PG8_BAR;
        PG8_WAIT_V(4); PG8_BAR;
        PG8_STAGE(PG8_SB(1, 0), cB + kstep, voffB); PG8_STAGE(PG8_SA(1, 0), cA + kstep, voffA); PG8_STAGE(PG8_SB(1, 1), cB + hstep + kstep, voffB);
        PG8_WAIT_V(6); PG8_BAR;
    }
    for (;;) {
        const bool has_next = S.next(ui + 1, nxt);
        const char* nA = has_next ? (const char*)g.A + (size_t)nxt.pm * tstep : cA; const char* nB = has_next ? (const char*)g.Bt + (size_t)nxt.pn * tstep : cB;
        for (int t = 0; t < nt; t += 2) {
            const bool last = (t == nt - 2);
            const char* a1 = cA + (size_t)(t + 1) * kstep;
            const char* a2 = last ? nA : cA + (size_t)(t + 2) * kstep; const char* b2 = last ? nB : cB + (size_t)(t + 2) * kstep;
            const char* a3 = a2 + kstep; const char* b3 = b2 + kstep;
            if (last && has_next) S.a_ready(nxt);
            if constexpr (SP2) {
            PG8_LDB(B0, 0, 0); PG8_LDB(B1, 0, 1); PG8_SCHED; PG8_LDA(At, 0, 0); PG8_STAGE(PG8_SA(1, 1), a1 + hstep, voffA);
            PG8_WAIT_V(8); PG8_WAIT_L(0); PG8_BAR; PG8_MMA(0, 0, At, B0); PG8_MMA(0, 1, At, B1); PG8_BAR; PG8_SCHED;
            PG8_LDA(At, 0, 1); PG8_STAGE(PG8_SB(0, 0), b2, voffB); PG8_STAGE(PG8_SB(0, 1), b2 + hstep, voffB); PG8_STAGE(PG8_SA(0, 0), a2, voffA);
            PG8_WAIT_V(8); PG8_WAIT_L(0); PG8_BAR; PG8_MMA(1, 0, At, B0); PG8_MMA(1, 1, At, B1); PG8_BAR; PG8_SCHED;
            PG8_LDB(B0, 1, 0); PG8_LDB(B1, 1, 1); PG8_SCHED; PG8_LDA(At, 1, 0); PG8_STAGE(PG8_SA(0, 1), a2 + hstep, voffA);
            PG8_WAIT_V(8); PG8_WAIT_L(0); PG8_BAR; PG8_MMA(0, 0, At, B0); PG8_MMA(0, 1, At, B1); PG8_BAR; PG8_SCHED;
            PG8_LDA(At, 1, 1); PG8_STAGE(PG8_SB(1, 0), b3, voffB); PG8_STAGE(PG8_SB(1, 1), b3 + hstep, voffB); PG8_STAGE(PG8_SA(1, 0), a3, voffA);
            PG8_WAIT_V(8); PG8_WAIT_L(0); PG8_BAR; PG8_MMA(1, 0, At, B0); PG8_MMA(1, 1, At, B1); PG8_BAR; PG8_SCHED;
            } else {
            PG8_LDB(B0, 0, 0); PG8_SCHED; PG8_LDA(At, 0, 0); PG8_STAGE(PG8_SA(1, 1), a1 + hstep, voffA);
            PG8_WAIT_L(8); PG8_BAR; PG8_WAIT_L(0); PG8_MMA(0, 0, At, B0); PG8_BAR; PG8_SCHED;
            PG8_LDB(B1, 0, 1); PG8_STAGE(PG8_SB(0, 0), b2, voffB);
            PG8_BAR; PG8_WAIT_L(0); PG8_MMA(0, 1, At, B1); PG8_BAR;
            PG8_LDA(At, 0, 1); PG8_STAGE(PG8_SA(0, 0), a2, voffA);
            PG8_BAR; PG8_WAIT_L(0); PG8_MMA(1, 0, At, B0); PG8_BAR; PG8_SCHED;
            PG8_STAGE(PG8_SB(0, 1), b2 + hstep, voffB);
            PG8_WAIT_V(6); PG8_BAR; PG8_MMA(1, 1, At, B1); PG8_BAR;
            PG8_LDB(B0, 1, 0); PG8_SCHED; PG8_LDA(At, 1, 0); PG8_STAGE(PG8_SA(0, 1), a2 + hstep, voffA);
            PG8_WAIT_L(8); PG8_BAR; PG8_WAIT_L(0); PG8_MMA(0, 0, At, B0); PG8_BAR; PG8_SCHED;
            PG8_LDB(B1, 1, 1); PG8_STAGE(PG8_SB(1, 0), b3, voffB);
            PG8_BAR; PG8_WAIT_L(0); PG8_MMA(0, 1, At, B1); PG8_BAR;
            PG8_LDA(At, 1, 1); PG8_STAGE(PG8_SA(1, 0), a3, voffA);
            PG8_BAR; PG8_WAIT_L(0); PG8_MMA(1, 0, At, B0); PG8_BAR; PG8_SCHED;
            PG8_STAGE(PG8_SB(1, 1), b3 + hstep, voffB);
            PG8_WAIT_V(6); PG8_BAR; PG8_MMA(1, 1, At, B1); PG8_BAR;
            }
        }
        if constexpr (ALIGN_EPI) { if (wr == 0) PG8_BAR; }
        if constexpr (!Epi::AFTER_DRAIN) { E(acc, cur, wr, wc, fr, fq); S.done(cur); }
        if (!has_next) break;
#pragma unroll
        for (int a = 0; a < 2; ++a)
#pragma unroll
            for (int b = 0; b < 2; ++b)
#pragma unroll
                for (int m = 0; m < 4; ++m)
#pragma unroll
                    for (int n = 0; n < 2; ++n) acc[a][b][m][n] = (f32x4){0.f, 0.f, 0.f, 0.f};
        cur = nxt; cA = nA; cB = nB; ++ui;
        if constexpr (ALIGN_EPI) { if (wr == 1) PG8_BAR; }
    }
    PG8_WAIT_V(0);
    if constexpr (!ALIGN_EPI) { if (wr == 0) PG8_BAR; }
    PG8_BAR;
#undef PG8_SA
#undef PG8_SB
#undef PG8_STAGE
#undef PG8_LDA
#undef PG8_LDB
#undef PG8_MMA
#undef PG8_WAIT_V
#undef PG8_WAIT_L
#undef PG8_BAR
#undef PG8_SCHED
}
}

constexpr int NWAVES = 8;
constexpr int NB = 16, SEQ = 2048, D = 1024, NTOK = NB * SEQ, NCTX = NB * 256, NTT = NTOK + NCTX;
constexpr int N_PHASES = 16;
constexpr int N_LAUNCHES = MK_N_LAUNCHES;
static_assert(N_LAUNCHES == 1 || N_LAUNCHES == N_PHASES, "one launch, or one launch per phase");

constexpr size_t MiB = 1u << 20;
constexpr size_t WS_CTL = 0, CTL_ZERO_BYTES = 64 * 1024;
constexpr size_t WS_MOD = 1 * MiB;
constexpr size_t WS_WIN_T = 2 * MiB;
constexpr size_t WS_WOUT_T = 6 * MiB;
constexpr size_t WS_CVIN_T = 9 * MiB;
constexpr size_t WS_CVOUT_T = 15 * MiB;
constexpr size_t WS_WQ_T = 17 * MiB;
constexpr size_t WS_KEYS = 25 * MiB;
constexpr size_t WS_DFT = 28 * MiB;
constexpr size_t WS_TAB = 48 * MiB;
constexpr size_t WS_TSC = 96 * MiB;
constexpr size_t WS_HQ = 112 * MiB;
constexpr size_t WS_HS = 144 * MiB;
constexpr size_t WS_H = 176 * MiB;
constexpr size_t WS_R = 248 * MiB;
constexpr size_t WS_QK = WS_R;
constexpr size_t WS_VT = WS_R + 72 * MiB;
constexpr size_t WS_VTC = WS_R + 104 * MiB;
constexpr size_t WS_FT = WS_R + 108 * MiB;
constexpr size_t WS_A2 = WS_R + 140 * MiB;
constexpr size_t WS_PQ = WS_R;
constexpr size_t WS_SELE = WS_R + 128 * MiB;
constexpr size_t WS_SELG = WS_R + 144 * MiB;
constexpr size_t WS_HQ8 = WS_R + 160 * MiB;
constexpr size_t WS_BCV = WS_R;
constexpr size_t WS_SET = WS_R + 240 * MiB;
constexpr size_t WS_END = 512 * MiB;
static_assert(WS_A2 + (size_t)NTOK * 1536 * 2 <= WS_END, "ws map");
constexpr int CW_BAR = 4096;
constexpr int CW_COLMAX = 8192;

constexpr int RING_OFF = 0, RING_BYTES = 131072;
constexpr int LDSCTL_OFF = RING_BYTES, MISC_OFF = LDSCTL_OFF + 320;
constexpr int LDS_BYTES = 163840;

#define LDS_WAIT() asm volatile("s_waitcnt lgkmcnt(0)" ::: "memory")

__device__ __forceinline__ unsigned cvt_pk(float lo, float hi) { return pg8::cvt_pk_bf16(lo, hi); }
__device__ __forceinline__ float bf_lo(unsigned u) { return __uint_as_float(u << 16); }
__device__ __forceinline__ float bf_hi(unsigned u) { return __uint_as_float(u & 0xffff0000u); }

#define XB_TMO      128
#define XB_XCNT(j)  (256  + 64 * (j))
#define XB_XSUB(j)  (1280 + 64 * (j))
#define XB_XGEN(j)  (2304 + 64 * (j))
#define XB_TOP      3328
#define XB_TOPGEN   3392
#define XCD_BAR_WORDS 3456
#define XB_SPIN_CAP (1u << 22)
__device__ __forceinline__ unsigned xb_ld(unsigned* p)              { return __hip_atomic_load(p, __ATOMIC_RELAXED, __HIP_MEMORY_SCOPE_AGENT); }
__device__ __forceinline__ unsigned xb_add(unsigned* p, unsigned v) { return __hip_atomic_fetch_add(p, v, __ATOMIC_RELAXED, __HIP_MEMORY_SCOPE_AGENT); }
__device__ __forceinline__ unsigned xb_xcc_id() { return (unsigned)__builtin_amdgcn_s_getreg((3 << 11) | 20) & 0xFu; }
#define XB_SPIN(cond, bar) do { unsigned _sp = 0; while (cond) { __builtin_amdgcn_s_sleep(1); \
    if ((++_sp & 255u) == 0u) { if (xb_ld(&(bar)[XB_TMO])) break; if (_sp > XB_SPIN_CAP) { atomicAdd(&(bar)[XB_TMO], 1u); break; } } } } while (0)
struct XcdBarrier { unsigned* bar; unsigned x; volatile LAS unsigned* st; };
__device__ __forceinline__ XcdBarrier xcd_barrier_post(unsigned* bar, volatile LAS unsigned* st) {
    XcdBarrier b; b.bar = bar; b.x = xb_xcc_id(); b.st = st;
    if (threadIdx.x == 0) (void)xb_add(&bar[XB_XCNT(b.x)], 1u);
    return b;
}
__device__ __forceinline__ void xcd_barrier_complete(unsigned* bar, unsigned x, unsigned& nloc, unsigned& nx) {
    const unsigned G = gridDim.x * gridDim.y * gridDim.z;
    unsigned sum, cnt, mine, sp = 0u;
    for (;;) {
        sum = 0u; cnt = 0u; mine = 0u;
#pragma unroll
        for (unsigned j = 0; j < 16; ++j) { const unsigned c = xb_ld(&bar[XB_XCNT(j)]); sum += c; cnt += (c > 0u) ? 1u : 0u; mine = (j == x) ? c : mine; }
        if (sum == G) break;
        __builtin_amdgcn_s_sleep(1);
        if ((++sp & 255u) == 0u) { if (xb_ld(&bar[XB_TMO])) break; if (sp > XB_SPIN_CAP) { atomicAdd(&bar[XB_TMO], 1u); break; } }
    }
    nloc = mine > 0u ? mine : 1u; nx = cnt > 0u ? cnt : 1u;
}
__device__ __forceinline__ void xcd_barrier(const XcdBarrier& b) {
    asm volatile("s_waitcnt vmcnt(0)" ::: "memory");
    __syncthreads();
    if (threadIdx.x == 0) {
        unsigned* bar = b.bar;
        __builtin_amdgcn_s_waitcnt(0);
        unsigned nloc = b.st[0], nx = b.st[1];
        if (nloc == 0u) { xcd_barrier_complete(bar, b.x, nloc, nx); b.st[0] = nloc; b.st[1] = nx; }
        const unsigned old = xb_add(&bar[XB_XSUB(b.x)], 1u);
        const unsigned gen = old / nloc;
        if (old + 1u == (gen + 1u) * nloc) {
            __builtin_amdgcn_fence(__ATOMIC_RELEASE, "agent");
            asm volatile("s_waitcnt vmcnt(0)" ::: "memory");
            const unsigned og = xb_add(&bar[XB_TOP], 1u);
            const unsigned tg = og / nx;
            if (og + 1u == (tg + 1u) * nx) xb_add(&bar[XB_TOPGEN], 1u);
            else XB_SPIN(xb_ld(&bar[XB_TOPGEN]) == tg, bar);
            __builtin_amdgcn_fence(__ATOMIC_ACQUIRE, "agent");
            xb_add(&bar[XB_XGEN(b.x)], 1u);
            asm volatile("s_waitcnt vmcnt(0)" ::: "memory");
        } else {
            XB_SPIN(xb_ld(&bar[XB_XGEN(b.x)]) == gen, bar);
            __builtin_amdgcn_fence(__ATOMIC_ACQUIRE, "agent");
            asm volatile("s_waitcnt vmcnt(0)" ::: "memory");
        }
    }
    __syncthreads();
}

__device__ __forceinline__ float wave_sum(float v) {
#pragma unroll
    for (int o = 1; o < 64; o <<= 1) v += __shfl_xor(v, o);
    return v;
}

__device__ __forceinline__ void p0_transpose_item(const float* W, int N, bf16* WT, int ldt, LAS float* scr, int item, int lane, bool cvmap = false) {
    const int nblk = N / 32, kb = item / nblk, nb = item % nblk, k0 = 64 * kb, n0 = 32 * nb;
    int n0m = n0; if (cvmap && n0 >= 1024) { const int isv = n0 >= 2048, d = n0 - (isv ? 2048 : 1024); n0m = 1024 + 256 * (d >> 7) + 128 * isv + (d & 127); }
#pragma unroll 8
    for (int i = 0; i < 32; ++i) { const int kk = 2 * i + (lane >> 5); scr[kk * 33 + (lane & 31)] = W[(size_t)(k0 + kk) * N + n0 + (lane & 31)]; }
    LDS_WAIT(); asm volatile("" ::: "memory");
    const int c = lane & 7;
#pragma unroll
    for (int j = 0; j < 4; ++j) { const int n = (lane >> 3) + 8 * j; const LAS float* s = scr + (8 * c) * 33 + n;
        u32x4 o; o.x = cvt_pk(s[0 * 33], s[1 * 33]); o.y = cvt_pk(s[2 * 33], s[3 * 33]); o.z = cvt_pk(s[4 * 33], s[5 * 33]); o.w = cvt_pk(s[6 * 33], s[7 * 33]);
        *(u32x4*)(WT + (size_t)(n0m + n) * ldt + k0 + 8 * c) = o; }
    LDS_WAIT(); asm volatile("" ::: "memory");
}

__device__ __forceinline__ void adaln_item(const float* c, const float* cctx, const float* ada_w, const float* ada_b, float* mods, LAS float* lds, int u) {
    const int i = u / 96, n0 = (u % 96) * 64;
    LAS float* sc = lds;
    LAS float* red = lds + 17 * 1024;
    const int tid = threadIdx.x, lane = tid & 63, w = tid >> 6, kq = lane >> 4, cg = lane & 15;
    for (int e = tid; e < 17 * 1024; e += 512) { const float v = e < 16 * 1024 ? c[e] : cctx[e - 16 * 1024]; sc[e] = v / (1.f + __expf(-v)); }
    __syncthreads();
    f32x4 acc[17];
#pragma unroll
    for (int r = 0; r < 17; ++r) acc[r] = (f32x4){0.f, 0.f, 0.f, 0.f};
    const int kb = w * 128 + kq * 32;
    const float* wp = ada_w + (size_t)i * 1024 * 6144 + (size_t)kb * 6144 + n0 + cg * 4;
#pragma unroll 1
    for (int k0 = 0; k0 < 32; k0 += 8) {
        f32x4 wv[8];
#pragma unroll
        for (int j = 0; j < 8; ++j) wv[j] = *(const f32x4*)(wp + (size_t)(k0 + j) * 6144);
#pragma unroll
        for (int r = 0; r < 17; ++r) {
            const f32x4 s0 = *(const LAS f32x4*)(sc + r * 1024 + kb + k0), s1 = *(const LAS f32x4*)(sc + r * 1024 + kb + k0 + 4);
            acc[r] += wv[0] * s0.x; acc[r] += wv[1] * s0.y; acc[r] += wv[2] * s0.z; acc[r] += wv[3] * s0.w;
            acc[r] += wv[4] * s1.x; acc[r] += wv[5] * s1.y; acc[r] += wv[6] * s1.z; acc[r] += wv[7] * s1.w;
        }
    }
#pragma unroll
    for (int r = 0; r < 17; ++r)
#pragma unroll
        for (int j = 0; j < 4; ++j) { float v = acc[r][j]; v += __shfl_xor(v, 16); v += __shfl_xor(v, 32); acc[r][j] = v; }
    if (kq == 0) {
#pragma unroll
        for (int r = 0; r < 17; ++r) *(LAS f32x4*)(red + (w * 17 + r) * 64 + cg * 4) = acc[r];
    }
    __syncthreads();
    for (int e = tid; e < 17 * 64; e += 512) { const int r = e >> 6, l = e & 63; float s = ada_b[i * 6144 + n0 + l];
#pragma unroll
        for (int g2 = 0; g2 < 8; ++g2) s += red[(g2 * 17 + r) * 64 + l];
        mods[(size_t)(i * 17 + r) * 6144 + n0 + l] = s; }
    __syncthreads();
}

__device__ __forceinline__ void wprime_item(const float* fn_w, const float* w_out, bf16* WOUT_T, LAS float* lds, int item) {
    const int g = item >> 4, n0 = (item & 15) * 64;
    LAS float* U = lds;
    LAS float* ctab = lds + 4096;
    const int tid = threadIdx.x, np = tid & 63, lg = __builtin_amdgcn_readfirstlane(tid >> 6);
    if (tid < 64) ctab[tid] = cospif((float)tid * (1.f / 32.f));
    {
        float wv[64];
#pragma unroll
        for (int e = 0; e < 64; ++e) wv[e] = w_out[(size_t)(512 + 64 * g + e) * 1024 + n0 + np];
#pragma unroll 1
        for (int l = lg * 8; l < lg * 8 + 8; ++l) { float s = 0.f; const float* fr = fn_w + (g * 64 + l) * 64;
#pragma unroll
            for (int e = 0; e < 64; ++e) s += fr[e] * wv[e];
            U[l * 64 + np] = s; }
    }
    __syncthreads();
    const float sN = 0.0027621358640099515f;
    const int n4 = tid & 15, rg = tid >> 4;
    f32x4 acc[4];
#pragma unroll
    for (int q = 0; q < 4; ++q) acc[q] = (f32x4){0.f, 0.f, 0.f, 0.f};
#pragma unroll 4
    for (int l = 0; l < 64; ++l) { const f32x4 uv = *(const LAS f32x4*)(U + l * 64 + n4 * 4);
#pragma unroll
        for (int q = 0; q < 4; ++q) { const int row = rg * 4 + q, part = row >> 6, cch = row & 63, m = (l * cch) & 63; acc[q] += uv * ctab[part ? ((m - 16) & 63) : m]; } }
#pragma unroll
    for (int q = 0; q < 4; ++q) { const int row = rg * 4 + q, part = row >> 6, cch = row & 63; const float sg = part ? -sN : sN;
#pragma unroll
        for (int j = 0; j < 4; ++j) WOUT_T[(size_t)(n0 + n4 * 4 + j) * 1536 + 512 + part * 512 + g * 64 + cch] = (bf16)(cvt_pk(acc[q][j] * sg, 0.f) & 0xffffu); }
    __syncthreads();
}

struct Args { const float* in[20]; float* out; unsigned char* ws; int ph_lo, ph_hi, li, pad; };

constexpr int CW_TABQ = 64;
__device__ __forceinline__ void phase_prep(const Args& a, LAS unsigned char* lds, int G, int wg, int rep, int part) {
#define PSUB(k) (rep == 0 || PROBE_SUB == 0 || PROBE_SUB == (k))
    const int tid = threadIdx.x, lane = tid & 63, wave = __builtin_amdgcn_readfirstlane(tid >> 6);
    unsigned char* ws = a.ws;
    if (PSUB(1) && part == 0) for (int u = wg; u < 192; u += G) adaln_item(a.in[1], a.in[3], a.in[4], a.in[5], (float*)(ws + WS_MOD), (LAS float*)lds, u);
    if (PSUB(1) && part == 0) for (int u = G - 1 - wg; u < 128; u += G) wprime_item(a.in[12], a.in[10], (bf16*)(ws + WS_WOUT_T), (LAS float*)lds, u);
    if (PSUB(2)) {
        LAS float* scr = (LAS float*)(lds + wave * 16384);
        const int gw = ((wg + G / 2) % G) * NWAVES + wave, NGW = G * NWAVES;
        constexpr int I_WIN = 16 * 64, I_WO = 8 * 32, I_CVI = 16 * 96, I_CVO = 16 * 32, I_WQ = 16 * 64;
        constexpr int NIT = I_WIN + I_WO + I_CVI + I_CVO + 2 * I_WQ;
        for (int it = gw; it < NIT; it += NGW) {
            if ((part == 0) != (it >= I_WIN + I_WO + I_CVI + I_CVO)) continue;
            int r = it;
            if (r < I_WIN) { p0_transpose_item(a.in[9], 2048, (bf16*)(ws + WS_WIN_T), 1024, scr, r, lane); continue; } r -= I_WIN;
            if (r < I_WO) { p0_transpose_item(a.in[10], 1024, (bf16*)(ws + WS_WOUT_T), 1536, scr, r, lane); continue; } r -= I_WO;
            if (r < I_CVI) { p0_transpose_item(a.in[13], 3072, (bf16*)(ws + WS_CVIN_T), 1024, scr, r, lane, true); continue; } r -= I_CVI;
            if (r < I_CVO) { p0_transpose_item(a.in[15], 1024, (bf16*)(ws + WS_CVOUT_T), 1024, scr, r, lane); continue; } r -= I_CVO;
            {
              const int L = r >= I_WQ ? 1 : 0, it2 = r - L * I_WQ, kb = it2 / 64, nb = it2 % 64;
              const float* wp = a.in[16] + ((size_t)L * 1024 + kb * 64 + (lane >> 5) * 32) * 2048 + nb * 32 + (lane & 31); float am = 0.f;
#pragma unroll 8
              for (int k = 0; k < 32; ++k) am = fmaxf(am, fabsf(wp[(size_t)k * 2048]));
              am = fmaxf(am, __shfl_xor(am, 32));
              if (lane < 32) atomicMax((unsigned*)(ws + WS_CTL) + CW_COLMAX + L * 2048 + nb * 32 + lane, __float_as_uint(am)); }
        }
    }
    __syncthreads();
    if (PSUB(3) && part == 1) {
        LAS float* tab = (LAS float*)lds;
        for (int m = tid; m < 2048; m += 512) tab[m] = cospif((float)m * (1.f / 1024.f));
        __syncthreads();
        bf16* DFT = (bf16*)(ws + WS_DFT);
        for (int item = wg * 512 + tid; item < 2048 * 256; item += G * 512) {
            const int kp = item >> 8, n0 = (item & 255) * 8, k = kp & 1023, sh = (kp >> 10) ? 512 : 0;
            float v[8];
#pragma unroll
            for (int j = 0; j < 8; ++j) v[j] = tab[(k * (n0 + j) - sh) & 2047];
            u32x4 o; o.x = cvt_pk(v[0], v[1]); o.y = cvt_pk(v[2], v[3]); o.z = cvt_pk(v[4], v[5]); o.w = cvt_pk(v[6], v[7]);
            *(u32x4*)(DFT + (size_t)kp * 2048 + n0) = o;
        }
    }
    if (PSUB(4) && part == 1) {
        const size_t gt = (size_t)wg * 512 + tid, NT = (size_t)G * 512;
        const f32x4* s = (const f32x4*)a.in[17]; u32x2* d = (u32x2*)(ws + WS_KEYS);
        for (size_t i = gt; i < (size_t)2 * 8 * 2 * 128 * 128 / 4; i += NT) { const f32x4 x = s[i]; u32x2 o; o.x = cvt_pk(x[0], x[1]); o.y = cvt_pk(x[2], x[3]); d[i] = o; }
    }
#undef PSUB
}

__device__ __forceinline__ void norm_rows4(const float* xrow, const float* g, const float* sh, const float* sc, bf16* orow, unsigned char* hq, unsigned char* hq8, float* hs, int lane) {
    f32x4 v[4][4];
#pragma unroll
    for (int q = 0; q < 4; ++q)
#pragma unroll
        for (int j = 0; j < 4; ++j) v[q][j] = ((const f32x4*)(xrow + q * 1024))[lane + 64 * j];
    f32x4 gsc[4], gsh[4];
#pragma unroll
    for (int j = 0; j < 4; ++j) { const f32x4 gg = ((const f32x4*)g)[lane + 64 * j], a = ((const f32x4*)sh)[lane + 64 * j], b = ((const f32x4*)sc)[lane + 64 * j]; gsc[j] = gg * (b + 1.0f); gsh[j] = a; }
    float s[4];
#pragma unroll
    for (int q = 0; q < 4; ++q) { s[q] = 0.f;
#pragma unroll
        for (int j = 0; j < 4; ++j) s[q] += (v[q][j].x * v[q][j].x + v[q][j].y * v[q][j].y) + (v[q][j].z * v[q][j].z + v[q][j].w * v[q][j].w); }
#pragma unroll
    for (int o = 1; o < 64; o <<= 1)
#pragma unroll
        for (int q = 0; q < 4; ++q) s[q] += __shfl_xor(s[q], o);
    float am[4];
#pragma unroll
    for (int q = 0; q < 4; ++q) { const float r = 1.0f / sqrtf(s[q] * (1.f / 1024.f) + 1e-6f); am[q] = 0.f;
#pragma unroll
        for (int j = 0; j < 4; ++j) { const f32x4 y = (v[q][j] * r) * gsc[j] + gsh[j]; v[q][j] = y;
            am[q] = fmaxf(am[q], fmaxf(fmaxf(fabsf(y.x), fabsf(y.y)), fmaxf(fabsf(y.z), fabsf(y.w))));
            if (orow) { u32x2 w; w.x = cvt_pk(y.x, y.y); w.y = cvt_pk(y.z, y.w); ((u32x2*)(orow + q * 1024))[lane + 64 * j] = w; } } }
    if (hq) {
#pragma unroll
        for (int o = 1; o < 64; o <<= 1)
#pragma unroll
            for (int q = 0; q < 4; ++q) am[q] = fmaxf(am[q], __shfl_xor(am[q], o));
        float qs[4];
#pragma unroll
        for (int q = 0; q < 4; ++q) { const float inv = am[q] > 0.f ? 119.0f / am[q] : 0.f; qs[q] = 0.f;
            unsigned char* hqr = hq + q * 1024; unsigned char* h8r = hq8 + q * 1024;
#pragma unroll
            for (int j = 0; j < 4; ++j) { unsigned whi = 0u, wlo = 0u, w8 = 0u;
#pragma unroll
                for (int z = 0; z < 4; ++z) { const int q8 = (int)rintf(v[q][j][z] * inv); const int hi = (q8 + 8) >> 4, lo = q8 - 16 * hi; qs[q] += (float)q8;
                    whi |= ((unsigned)hi & 15u) << (4 * z); wlo |= ((unsigned)lo & 15u) << (4 * z); w8 |= ((unsigned)q8 & 255u) << (8 * z); }
                ((unsigned short*)hqr)[lane + 64 * j] = (unsigned short)whi; ((unsigned short*)(hqr + 512))[lane + 64 * j] = (unsigned short)wlo; ((unsigned*)h8r)[lane + 64 * j] = w8; } }
#pragma unroll
        for (int o = 1; o < 64; o <<= 1)
#pragma unroll
            for (int q = 0; q < 4; ++q) qs[q] += __shfl_xor(qs[q], o);
        if (lane == 0) {
#pragma unroll
            for (int q = 0; q < 4; ++q) { hs[2 * q] = am[q] * (1.0f / 119.0f); hs[2 * q + 1] = qs[q]; } }
    }
}
__device__ __forceinline__ void phase_norm(const float* xsrc, const float* ctx, const float* gvec, const float* modsL, int c0, bf16* H, unsigned char* HQ, unsigned char* HQ8, float* HS, int G, int wg) {
    const int lane = threadIdx.x & 63, wave = __builtin_amdgcn_readfirstlane(threadIdx.x >> 6);
    const int gw = wg * NWAVES + wave, NGW = G * NWAVES;
    const int nrows = ctx ? NTT : NTOK;
#pragma unroll 1
    for (int m = 4 * gw; m < nrows; m += 4 * NGW) {
        const float* xr; int mr;
        if (m < NTOK) { xr = xsrc + (size_t)m * D; mr = m >> 11; } else { xr = ctx + (size_t)(m - NTOK) * D; mr = 16; }
        const float* mp = modsL + (size_t)mr * 6144 + c0 * 1024;
        norm_rows4(xr, gvec, mp, mp + 1024, H ? H + (size_t)m * D : nullptr, HQ ? HQ + (size_t)m * 1024 : nullptr, HQ8 + (size_t)m * 1024, HS + 2 * (size_t)m, lane);
    }
}

__device__ __forceinline__ void wq8_transpose_item(const float* W, const float* colmax, unsigned char* WT8, LAS float* scr, int item, int lane) {
    const int kb = item / 64, nb = item % 64, k0 = 64 * kb, n0 = 32 * nb;
#pragma unroll 8
    for (int i = 0; i < 32; ++i) { const int kk = 2 * i + (lane >> 5); scr[kk * 33 + (lane & 31)] = W[(size_t)(k0 + kk) * 2048 + n0 + (lane & 31)]; }
    LDS_WAIT(); asm volatile("" ::: "memory");
    const int c = lane & 7;
#pragma unroll
    for (int j = 0; j < 4; ++j) { const int n = (lane >> 3) + 8 * j; const LAS float* sp = scr + (8 * c) * 33 + n;
        const float cm = colmax[n0 + n], inv = cm > 0.f ? 127.0f / cm : 0.f;
        unsigned w0 = 0u, w1 = 0u;
#pragma unroll
        for (int z = 0; z < 4; ++z) { w0 |= ((unsigned)(int)rintf(sp[z * 33] * inv) & 255u) << (8 * z); w1 |= ((unsigned)(int)rintf(sp[(4 + z) * 33] * inv) & 255u) << (8 * z); }
        u32x2 o; o.x = w0; o.y = w1;
        *(u32x2*)(WT8 + (size_t)(n0 + n) * 1024 + k0 + 8 * c) = o; }
    LDS_WAIT(); asm volatile("" ::: "memory");
}
__device__ __forceinline__ void phase_wq8(const float* wq, const float* colmax, unsigned char* WQ8, LAS unsigned char* lds, int G, int wg) {
    const int lane = threadIdx.x & 63, wave = __builtin_amdgcn_readfirstlane(threadIdx.x >> 6);
    LAS float* scr = (LAS float*)(lds + wave * 16384);
    for (int it = wg * NWAVES + wave; it < 2 * 1024; it += G * NWAVES) { const int L = it >> 10;
        wq8_transpose_item(wq + (size_t)L * 1024 * 2048, colmax + L * 2048, WQ8 + (size_t)L * 2048 * 1024, scr, it & 1023, lane); }
}

typedef float f32x16 __attribute__((ext_vector_type(16)));
struct AttnRaw { u32x4 k[4]; u32x4 v[4]; };
constexpr int ATT_KPITCH = 144, ATT_VPITCH = 72, ATT_WAVE_LDS = 32 * ATT_KPITCH + 64 * ATT_VPITCH;
__device__ __forceinline__ void na_load_raw(AttnRaw& f, const bf16* QK, const bf16* VT, const bf16* VTC, int b, int h, int t, int nrows, int sr0, int c32, int lane) {
    const bf16* kp; const bf16* vp; size_t vpitch;
    if (t < nrows) { const int kr = sr0 + t;
        kp = QK + ((size_t)b * 2048 + kr * 64 + c32 + (lane >> 3)) * 1024 + 512 + h * 64 + (lane & 7) * 8;
        vp = VT + (size_t)(b * 512 + h * 64 + (lane >> 2)) * 2048 + kr * 64 + c32 + (lane & 3) * 8; vpitch = 2048; }
    else { const int u = t - nrows;
        kp = QK + ((size_t)NTOK + b * 256 + 32 * u + (lane >> 3)) * 1024 + 512 + h * 64 + (lane & 7) * 8;
        vp = VTC + (size_t)(b * 512 + h * 64 + (lane >> 2)) * 256 + 32 * u + (lane & 3) * 8; vpitch = 256; }
#pragma unroll
    for (int q = 0; q < 4; ++q) { f.k[q] = *(const u32x4*)(kp + (size_t)q * 8 * 1024); f.v[q] = *(const u32x4*)(vp + (size_t)q * 16 * vpitch); }
}
__device__ __forceinline__ void na_stage(const AttnRaw& f, LAS unsigned char* kl, LAS unsigned char* vl, int lane) {
#pragma unroll
    for (int q = 0; q < 4; ++q) {
        *(LAS u32x4*)(kl + (8 * q + (lane >> 3)) * ATT_KPITCH + (lane & 7) * 16) = f.k[q];
        LAS unsigned char* vd = vl + (16 * q + (lane >> 2)) * ATT_VPITCH + (lane & 3) * 16;
        u32x2 lo, hi2; lo.x = f.v[q].x; lo.y = f.v[q].y; hi2.x = f.v[q].z; hi2.y = f.v[q].w;
        *(LAS u32x2*)vd = lo; *(LAS u32x2*)(vd + 8) = hi2;
    }
}
__device__ __forceinline__ void na_attn32_wave(const bf16* QK, const bf16* VT, const bf16* VTC, const LAS float* rpl, LAS unsigned char* wl, bf16* A2, int b, int h, int r0, int qb, int lane) {
    const int j = lane & 31, hi = lane >> 5;
    const int c0 = qb * 16;
    const int c32 = qb == 0 ? 0 : (qb == 1 ? 8 : (qb == 2 ? 24 : 32));
    const int qrow = r0 + (j >> 4), cq = c0 + (j & 15);
    const int srq = min(max(qrow - 4, 0), 24), cs = min(max(cq - 8, 0), 48);
    const int sr0 = min(max(r0 - 4, 0), 24), sr1 = min(max(r0 - 3, 0), 24);
    const int nrows = sr1 + 8 - sr0, ntiles = nrows + 8;
    const size_t tq = (size_t)b * 2048 + qrow * 64 + cq;
    LAS unsigned char* kl = wl; LAS unsigned char* vl = wl + 32 * ATT_KPITCH;
    bf16x8 qf[4];
#pragma unroll
    for (int ks = 0; ks < 4; ++ks) qf[ks] = *(const bf16x8*)(QK + tq * 1024 + h * 64 + 16 * ks + 8 * hi);
    f32x16 o0, o1;
#pragma unroll
    for (int v = 0; v < 16; ++v) { o0[v] = 0.f; o1[v] = 0.f; }
    float m_run = -1e30f, l_run = 0.f;
    AttnRaw raw;
    na_load_raw(raw, QK, VT, VTC, b, h, 0, nrows, sr0, c32, lane);
#pragma unroll 2
    for (int t = 0; t < ntiles; ++t) {
        na_stage(raw, kl, vl, lane);
        if (t + 1 < ntiles) na_load_raw(raw, QK, VT, VTC, b, h, t + 1, nrows, sr0, c32, lane);
        f32x16 sv;
#pragma unroll
        for (int v = 0; v < 16; ++v) sv[v] = 0.f;
#pragma unroll
        for (int ks = 0; ks < 4; ++ks) { const bf16x8 kf = *(const LAS bf16x8*)(kl + j * ATT_KPITCH + (2 * ks + hi) * 16);
            sv = __builtin_amdgcn_mfma_f32_32x32x16_bf16(kf, qf[ks], sv, 0, 0, 0); }
        if (t < nrows) {
            const int kr = sr0 + t;
            const bool rok = (kr >= srq) && (kr < srq + 8);
            const LAS float* rrow = rpl + min(max(kr - qrow + 7, 0), 14) * 31;
#pragma unroll
            for (int v = 0; v < 16; ++v) { const int kc = c32 + 8 * (v >> 2) + 4 * hi + (v & 3); const bool ok = rok && (kc >= cs) && (kc < cs + 16);
                const float bias = rrow[min(max(kc - cq + 15, 0), 30)];
                sv[v] = ok ? sv[v] + bias : -INFINITY; }
        }
        float mx = sv[0];
#pragma unroll
        for (int v = 1; v < 16; ++v) mx = fmaxf(mx, sv[v]);
        mx = fmaxf(mx, __shfl_xor(mx, 32));
        const float m_new = fmaxf(m_run, mx);
        const float alpha = __expf(m_run - m_new);
        float ps = 0.f;
#pragma unroll
        for (int v = 0; v < 16; ++v) { const float p = __expf(sv[v] - m_new); sv[v] = p; ps += p; }
        l_run = l_run * alpha + ps; m_run = m_new;
#pragma unroll
        for (int v = 0; v < 16; ++v) { o0[v] *= alpha; o1[v] *= alpha; }
#pragma unroll
        for (int st = 0; st < 2; ++st) {
            u32x4 pw; pw.x = cvt_pk(sv[8 * st], sv[8 * st + 1]); pw.y = cvt_pk(sv[8 * st + 2], sv[8 * st + 3]); pw.z = cvt_pk(sv[8 * st + 4], sv[8 * st + 5]); pw.w = cvt_pk(sv[8 * st + 6], sv[8 * st + 7]);
            const bf16x8 pf = __builtin_bit_cast(bf16x8, pw);
#pragma unroll
            for (int dt = 0; dt < 2; ++dt) {
                const LAS unsigned char* vr = vl + (32 * dt + j) * ATT_VPITCH + 32 * st + 8 * hi;
                const u32x2 lo = *(const LAS u32x2*)vr, h2 = *(const LAS u32x2*)(vr + 16);
                u32x4 vw; vw.x = lo.x; vw.y = lo.y; vw.z = h2.x; vw.w = h2.y;
                if (dt == 0) o0 = __builtin_amdgcn_mfma_f32_32x32x16_bf16(__builtin_bit_cast(bf16x8, vw), pf, o0, 0, 0, 0);
                else o1 = __builtin_amdgcn_mfma_f32_32x32x16_bf16(__builtin_bit_cast(bf16x8, vw), pf, o1, 0, 0, 0);
            }
        }
    }
    l_run += __shfl_xor(l_run, 32);
    const float inv = 1.0f / l_run;
    bf16* orow = A2 + tq * 1536 + h * 64 + 4 * hi;
#pragma unroll
    for (int g = 0; g < 4; ++g) {
        u32x2 w; w.x = cvt_pk(o0[4 * g] * inv, o0[4 * g + 1] * inv); w.y = cvt_pk(o0[4 * g + 2] * inv, o0[4 * g + 3] * inv); *(u32x2*)(orow + 8 * g) = w;
        w.x = cvt_pk(o1[4 * g] * inv, o1[4 * g + 1] * inv); w.y = cvt_pk(o1[4 * g + 2] * inv, o1[4 * g + 3] * inv); *(u32x2*)(orow + 32 + 8 * g) = w;
    }
}

__device__ __forceinline__ int f2key(float f) { const int b = (int)__float_as_uint(f); return b ^ ((b >> 31) & 0x7fffffff); }
__device__ __forceinline__ float key2f(int k) { return __uint_as_float((unsigned)(k ^ ((k >> 31) & 0x7fffffff))); }
__device__ __forceinline__ void ce_desc(int& a, int& b) { const int t = max(a, b); b = min(a, b); a = t; }
template <int N> __device__ __forceinline__ void bitonic_sort_desc(int (&v)[N]) {
#pragma unroll
    for (int k = 2; k <= N; k <<= 1) {
#pragma unroll
        for (int j = k >> 1; j > 0; j >>= 1) {
#pragma unroll
            for (int i = 0; i < N; ++i) { const int l = i ^ j; if (l > i) { if ((i & k) == 0) ce_desc(v[i], v[l]); else ce_desc(v[l], v[i]); } }
        }
    }
}
template <int N> __device__ __forceinline__ void bitonic_merge_desc(int (&v)[N]) {
#pragma unroll
    for (int j = N >> 1; j > 0; j >>= 1) {
#pragma unroll
        for (int i = 0; i < N; ++i) { const int l = i ^ j; if (l > i) ce_desc(v[i], v[l]); }
    }
}
constexpr int TOPK_LDS_PER_WAVE = 16 * 52 * 4;
constexpr int TOPK_KROW = 136;
__device__ __forceinline__ void peer_topk_wave(const bf16x8 (&qfa)[2][4], const LAS bf16* KL, int* sel_e, float* sel_g, int t0, int h, int lane, LAS int* scr) {
    const int fr = lane & 15, fq = lane >> 4;
    int top[2][16];
#pragma unroll
    for (int p = 0; p < 2; ++p) {
        int lo[16], hi[16];
#pragma unroll
        for (int t = 0; t < 8; ++t) {
            f32x4 av = (f32x4){0.f, 0.f, 0.f, 0.f};
#pragma unroll
            for (int ks = 0; ks < 4; ++ks) { const bf16x8 kf = *(const LAS bf16x8*)(KL + (p * 128 + t * 16 + fr) * TOPK_KROW + ks * 32 + fq * 8);
                av = __builtin_amdgcn_mfma_f32_16x16x32_bf16(kf, qfa[p][ks], av, 0, 0, 0); }
#pragma unroll
            for (int j = 0; j < 4; ++j) { const int n = 16 * t + 4 * fq + j; const int key = (f2key(av[j]) & ~127) | n;
                if (t < 4) lo[4 * t + j] = key; else hi[4 * (t - 4) + j] = key; }
        }
        bitonic_sort_desc<16>(lo); bitonic_sort_desc<16>(hi);
#pragma unroll
        for (int i = 0; i < 16; ++i) lo[i] = max(lo[i], hi[15 - i]);
        bitonic_merge_desc<16>(lo);
#pragma unroll
        for (int x = 16; x <= 32; x <<= 1) {
#pragma unroll
            for (int i = 0; i < 16; ++i) hi[i] = __shfl_xor(lo[15 - i], x);
#pragma unroll
            for (int i = 0; i < 16; ++i) lo[i] = max(lo[i], hi[i]);
            bitonic_merge_desc<16>(lo);
        }
#pragma unroll
        for (int i = 0; i < 16; ++i) top[p][i] = lo[i];
    }
    const bool b0 = (fq & 1) != 0, b1 = (fq & 2) != 0;
    const int gbase = b1 ? (b0 ? 42 : 29) : (b0 ? 16 : 0);
    LAS int* tb = scr + fr * 52;
    int g0[16];
    {
        constexpr signed char TI[4][16] = {{0,0,0,0,0,0,0,0,0,0,0,0,0,0,0,0}, {1,1,1,1,1,1,1,1,2,2,2,2,2,-1,-1,-1}, {3,3,3,3,4,4,4,5,5,6,6,7,7,-1,-1,-1}, {8,9,10,11,12,13,14,15,-1,-1,-1,-1,-1,-1,-1,-1}};
        constexpr signed char TJ[4][16] = {{0,1,2,3,4,5,6,7,8,9,10,11,12,13,14,15}, {0,1,2,3,4,5,6,7,0,1,2,3,4,-1,-1,-1}, {0,1,2,3,0,1,2,0,1,0,1,0,1,-1,-1,-1}, {0,0,0,0,0,0,0,0,-1,-1,-1,-1,-1,-1,-1,-1}};
#pragma unroll
        for (int sl = 0; sl < 16; ++sl) {
            const int ka0 = top[0][TI[0][sl]], ka1 = top[0][TI[1][sl] < 0 ? 0 : TI[1][sl]], ka2 = top[0][TI[2][sl] < 0 ? 0 : TI[2][sl]], ka3 = top[0][TI[3][sl] < 0 ? 0 : TI[3][sl]];
            const int kb0 = top[1][TJ[0][sl]], kb1 = top[1][TJ[1][sl] < 0 ? 0 : TJ[1][sl]], kb2 = top[1][TJ[2][sl] < 0 ? 0 : TJ[2][sl]], kb3 = top[1][TJ[3][sl] < 0 ? 0 : TJ[3][sl]];
            const int ka = b1 ? (b0 ? ka3 : ka2) : (b0 ? ka1 : ka0), kb = b1 ? (b0 ? kb3 : kb2) : (b0 ? kb1 : kb0);
            const bool pad = b1 ? (b0 ? (TI[3][sl] < 0) : (TI[2][sl] < 0)) : (b0 ? (TI[1][sl] < 0) : false);
            const int key = (f2key(key2f(ka) + key2f(kb)) & ~63) | (49 - gbase - sl);
            g0[sl] = pad ? (int)0x80000000 : key;
            tb[pad ? 51 : gbase + sl] = (ka & 127) * 128 + (kb & 127);
        }
    }
    bitonic_sort_desc<16>(g0);
#pragma unroll
    for (int x = 16; x <= 32; x <<= 1) {
        int hi2[16];
#pragma unroll
        for (int i = 0; i < 16; ++i) hi2[i] = __shfl_xor(g0[15 - i], x);
#pragma unroll
        for (int i = 0; i < 16; ++i) g0[i] = max(g0[i], hi2[i]);
        bitonic_merge_desc<16>(g0);
    }
    int kmax = g0[0];
#pragma unroll
    for (int i = 1; i < 16; ++i) kmax = max(kmax, g0[i]);
    const float mx = key2f(kmax);
    float wv[16]; float sum = 0.f;
#pragma unroll
    for (int i = 0; i < 16; ++i) { wv[i] = __expf(key2f(g0[i]) - mx); sum += wv[i]; }
    const float inv = 1.0f / sum;
    LDS_WAIT(); asm volatile("" ::: "memory");
    int we[16];
#pragma unroll
    for (int i = 0; i < 16; ++i) we[i] = tb[49 - (g0[i] & 63)];
    if (fq == 0) {
        int* ep = sel_e + ((size_t)(t0 + fr) * 8 + h) * 16; float* gp = sel_g + ((size_t)(t0 + fr) * 8 + h) * 16;
#pragma unroll
        for (int rd = 0; rd < 16; ++rd) { ep[rd] = we[rd]; gp[rd] = wv[rd] * inv; }
    }
    LDS_WAIT(); asm volatile("" ::: "memory");
}

__device__ __forceinline__ void phase_topk(LAS unsigned char* lds, const bf16* Q, const bf16* KEYS, int* sel_e, float* sel_g, const float* tdown, const float* tup, unsigned char* tab4, float* tsc, int G, int wg) {
    const int tid = threadIdx.x, lane = tid & 63, wave = __builtin_amdgcn_readfirstlane(tid >> 6), fr = lane & 15, fq = lane >> 4;
    LAS bf16* KL = (LAS bf16*)lds;
    LAS int* scr = (LAS int*)(lds + 2 * 128 * TOPK_KROW * 2 + wave * TOPK_LDS_PER_WAVE);
    const int nh = (G % 8 == 0) ? 1 : 8;
#pragma unroll 1
    for (int hh = 0; hh < nh; ++hh) {
        const int h = (nh == 1) ? (wg & 7) : hh;
        const int nwh = (nh == 1) ? (G >> 3) : G, wi = (nh == 1) ? (wg >> 3) : wg;
        __syncthreads();
        for (int p = tid; p < 4096; p += 512) { const int row = p >> 4, c16 = p & 15;
            *(LAS u32x4*)(KL + row * TOPK_KROW + c16 * 8) = *(const u32x4*)(KEYS + (size_t)(h * 256 + row) * 128 + c16 * 8); }
        __syncthreads();
        int b = wave * nwh + wi;
        bf16x8 qn[2][4];
        if (b < 2048) {
#pragma unroll
            for (int p = 0; p < 2; ++p)
#pragma unroll
                for (int ks = 0; ks < 4; ++ks) qn[p][ks] = *(const bf16x8*)(Q + (size_t)(b * 16 + fr) * 2048 + h * 256 + p * 128 + ks * 32 + fq * 8);
        }
        const int gw = wg * NWAVES + wave, NGW = G * NWAVES;
        int trow = (hh == 0) ? gw : 32768;
#define TOPK_ROW_PTR(R) ((const f32x4*)((((R) < 16384) ? tdown : tup) + (size_t)((R) & 16383) * 1024) + lane * 4)
#define TOPK_ROW_STORE(R, X) do { u32x2 pk; float scv; \
            if ((R) < 16384) {     \
                float ss = 0.f, am = 0.f; \
                _Pragma("unroll") for (int q = 0; q < 4; ++q) { ss += (X[q][0] * X[q][0] + X[q][1] * X[q][1]) + (X[q][2] * X[q][2] + X[q][3] * X[q][3]); \
                    am = fmaxf(am, fmaxf(fmaxf(fabsf(X[q][0]), fabsf(X[q][1])), fmaxf(fabsf(X[q][2]), fabsf(X[q][3])))); } \
                ss = wave_sum(ss); _Pragma("unroll") for (int o = 1; o < 64; o <<= 1) am = fmaxf(am, __shfl_xor(am, o)); \
                scv = fmaxf(0.35f * sqrtf(ss * (1.0f / 1024.0f)), am * (1.0f / 16.0f)); const float inv = scv > 0.f ? 1.0f / scv : 0.f; \
                unsigned w0 = 0u, w1 = 0u; \
                _Pragma("unroll") for (int q = 0; q < 4; ++q) _Pragma("unroll") for (int z = 0; z < 4; ++z) { \
                    const int cd = min(max((int)floorf(X[q][z] * inv), -8), 7); const unsigned nb = (unsigned)cd & 15u; \
                    if (q < 2) w0 |= nb << (4 * (4 * q + z)); else w1 |= nb << (4 * (4 * (q - 2) + z)); } \
                pk.x = w0; pk.y = w1; \
            } else {               \
                float am = 0.f; \
                _Pragma("unroll") for (int q = 0; q < 4; ++q) am = fmaxf(am, fmaxf(fmaxf(fabsf(X[q][0]), fabsf(X[q][1])), fmaxf(fabsf(X[q][2]), fabsf(X[q][3])))); \
                _Pragma("unroll") for (int o = 1; o < 64; o <<= 1) am = fmaxf(am, __shfl_xor(am, o)); \
                const float inv = am > 0.f ? 6.0f / am : 0.f; unsigned p0 = 0u, p1 = 0u; \
                p0 = __builtin_amdgcn_cvt_scalef32_pk_fp4_f32(p0, X[0][0] * inv, X[0][1] * inv, 1.0f, 0); p0 = __builtin_amdgcn_cvt_scalef32_pk_fp4_f32(p0, X[0][2] * inv, X[0][3] * inv, 1.0f, 1); \
                p0 = __builtin_amdgcn_cvt_scalef32_pk_fp4_f32(p0, X[1][0] * inv, X[1][1] * inv, 1.0f, 2); p0 = __builtin_amdgcn_cvt_scalef32_pk_fp4_f32(p0, X[1][2] * inv, X[1][3] * inv, 1.0f, 3); \
                p1 = __builtin_amdgcn_cvt_scalef32_pk_fp4_f32(p1, X[2][0] * inv, X[2][1] * inv, 1.0f, 0); p1 = __builtin_amdgcn_cvt_scalef32_pk_fp4_f32(p1, X[2][2] * inv, X[2][3] * inv, 1.0f, 1); \
                p1 = __builtin_amdgcn_cvt_scalef32_pk_fp4_f32(p1, X[3][0] * inv, X[3][1] * inv, 1.0f, 2); p1 = __builtin_amdgcn_cvt_scalef32_pk_fp4_f32(p1, X[3][2] * inv, X[3][3] * inv, 1.0f, 3); \
                pk.x = p0; pk.y = p1; scv = am * (1.0f / 6.0f); } \
            *((u32x2*)(tab4 + (((R) < 16384) ? (size_t)0 : (size_t)8 * MiB) + (size_t)(lane >> 4) * (2 * MiB) + (size_t)((R) & 16383) * 128) + (lane & 15)) = pk; \
            if (lane == 0) tsc[R] = scv; } while (0)
#pragma unroll 1
        for (; b < 2048; b += 8 * nwh) {
            f32x4 tx0[4], tx1[4]; const int ra = trow, rb = trow + NGW; const bool t0 = ra < 32768, t1 = rb < 32768;
            if (t0) { const f32x4* sp = TOPK_ROW_PTR(ra);
#pragma unroll
                for (int q = 0; q < 4; ++q) tx0[q] = sp[q]; }
            if (t1) { const f32x4* sp = TOPK_ROW_PTR(rb);
#pragma unroll
                for (int q = 0; q < 4; ++q) tx1[q] = sp[q]; }
            bf16x8 qc[2][4];
#pragma unroll
            for (int p = 0; p < 2; ++p)
#pragma unroll
                for (int ks = 0; ks < 4; ++ks) qc[p][ks] = qn[p][ks];
            const int bn = b + 8 * nwh;
            if (bn < 2048) {
#pragma unroll
                for (int p = 0; p < 2; ++p)
#pragma unroll
                    for (int ks = 0; ks < 4; ++ks) qn[p][ks] = *(const bf16x8*)(Q + (size_t)(bn * 16 + fr) * 2048 + h * 256 + p * 128 + ks * 32 + fq * 8);
            }
            peer_topk_wave(qc, KL, sel_e, sel_g, b * 16, h, lane, scr);
            if (t0) TOPK_ROW_STORE(ra, tx0);
            if (t1) TOPK_ROW_STORE(rb, tx1);
            trow += 2 * NGW;
        }
#pragma unroll 1
        for (; trow < 32768; trow += NGW) { f32x4 tx0[4]; const f32x4* sp = TOPK_ROW_PTR(trow);
#pragma unroll
            for (int q = 0; q < 4; ++q) tx0[q] = sp[q];
            TOPK_ROW_STORE(trow, tx0); }
#undef TOPK_ROW_PTR
#undef TOPK_ROW_STORE
    }
}

typedef float f32x2 __attribute__((ext_vector_type(2)));
template <int CTRL> __device__ __forceinline__ float dppf(float v) { return __uint_as_float((unsigned)__builtin_amdgcn_update_dpp(0, (int)__float_as_uint(v), CTRL, 0xf, 0xf, true)); }
typedef int i32x8 __attribute__((ext_vector_type(8)));
constexpr int GA_SE_OFF = 0, GA_AW_OFF = 32768;
constexpr int GA_IMG_OFF = 0, GA_IMG_WAVE = 16384;
constexpr int GA_WA_OFF = 131072 + 1024, GA_WS_OFF = GA_WA_OFF + 24576;
static_assert(GA_IMG_OFF + 8 * GA_IMG_WAVE <= LDSCTL_OFF && GA_WS_OFF + 512 <= LDS_BYTES, "gather LDS map");
typedef __amdgpu_buffer_rsrc_t brsrc_t;
__device__ __forceinline__ brsrc_t ga_rsrc(const unsigned char* tab) { return __builtin_amdgcn_make_buffer_rsrc((void*)tab, 0, 8 << 20, 0x00020000); }
__device__ __forceinline__ void ga_issue8(u32x4 (&rw)[8], brsrc_t tab, const LAS unsigned short* sep, unsigned so) {
#pragma unroll
    for (int i = 0; i < 8; ++i) { const unsigned e = sep[8 * i]; rw[i] = __builtin_amdgcn_raw_buffer_load_b128(tab, (int)((e << 7) + so), 0, 0); }
}
__device__ __forceinline__ void ga_down8(u32x4 (&rw)[8], const u32x4 hhi, const u32x4 hlo, LAS float* awp, bool c0, brsrc_t tab, const LAS unsigned short* sepn, unsigned son) {
    float d[8];
#pragma unroll
    for (int i = 0; i < 8; ++i) { int ahi = 0, alo = 0;
        const unsigned en = sepn[8 * i];
#pragma unroll
        for (int q = 0; q < 4; ++q) { ahi = __builtin_amdgcn_sdot8((int)rw[i][q], (int)hhi[q], ahi, false); alo = __builtin_amdgcn_sdot8((int)rw[i][q], (int)hlo[q], alo, false); }
        d[i] = (float)(ahi * 16 + alo);
        rw[i] = __builtin_amdgcn_raw_buffer_load_b128(tab, (int)((en << 7) + son), 0, 0);
        __builtin_amdgcn_sched_barrier(0); }
#pragma unroll
    for (int i = 0; i < 8; ++i) d[i] += dppf<0xB1>(d[i]);
#pragma unroll
    for (int i = 0; i < 8; ++i) d[i] += dppf<0x4E>(d[i]);
#pragma unroll
    for (int i = 0; i < 8; ++i) d[i] += dppf<0x141>(d[i]);
    if (c0) { float o[8];
#pragma unroll
        for (int i = 0; i < 8; ++i) o[i] = awp[8 * i];
#pragma unroll
        for (int i = 0; i < 8; ++i) awp[8 * i] = o[i] + d[i]; }
}
template <bool FINAL>
__device__ __forceinline__ void ga_norm16(float* xout, bf16* H, const float* ng, const float* modsN, const size_t t0, const int lane) {
    f32x4 gsc[4], gsh[4];
#pragma unroll
    for (int j = 0; j < 4; ++j) { const f32x4 gg = ((const f32x4*)ng)[lane + 64 * j];
        if (FINAL) { gsc[j] = gg; gsh[j] = (f32x4){0.f, 0.f, 0.f, 0.f}; }
        else { const float* mp = modsN + (size_t)(t0 >> 11) * 6144; const f32x4 a = ((const f32x4*)mp)[lane + 64 * j], b = ((const f32x4*)(mp + 1024))[lane + 64 * j]; gsc[j] = gg * (b + 1.0f); gsh[j] = a; } }
#pragma unroll 1
    for (int tg = 0; tg < 16; tg += 4) {
        f32x4 xv[4][4];
#pragma unroll
        for (int q = 0; q < 4; ++q)
#pragma unroll
            for (int j = 0; j < 4; ++j) xv[q][j] = ((const f32x4*)(xout + (t0 + tg + q) * 1024))[lane + 64 * j];
        float ss[4];
#pragma unroll
        for (int q = 0; q < 4; ++q) { ss[q] = 0.f;
#pragma unroll
            for (int j = 0; j < 4; ++j) ss[q] += (xv[q][j].x * xv[q][j].x + xv[q][j].y * xv[q][j].y) + (xv[q][j].z * xv[q][j].z + xv[q][j].w * xv[q][j].w); }
#pragma unroll
        for (int o = 1; o < 64; o <<= 1)
#pragma unroll
            for (int q = 0; q < 4; ++q) ss[q] += __shfl_xor(ss[q], o);
#pragma unroll
        for (int q = 0; q < 4; ++q) { const float rn = 1.0f / sqrtf(ss[q] * (1.f / 1024.f) + 1e-6f); const size_t t = t0 + tg + q;
            if (FINAL) {
#pragma unroll
                for (int j = 0; j < 4; ++j) ((f32x4*)(xout + t * 1024))[lane + 64 * j] = xv[q][j] * rn * gsc[j];
            } else { u32x2* o8 = (u32x2*)(H + t * 1024) + lane;
#pragma unroll
                for (int j = 0; j < 4; ++j) { const f32x4 y = (xv[q][j] * rn) * gsc[j] + gsh[j]; u32x2 w; w.x = cvt_pk(y.x, y.y); w.y = cvt_pk(y.z, y.w); o8[64 * j] = w; } } }
    }
}
template <bool FINAL>
__device__ __forceinline__ void phase_gather(LAS unsigned char* lds, bf16* H, const unsigned char* HQ, const float* HS, const int* sel_e, const float* sel_g, const unsigned char* down4, const unsigned char* up4, const float* sdown, const float* sup,
                                             const float* modsL, float* xout, const float* ng, const float* modsN, int G, int wg, int mode) {
    const bool dummy = (mode & 1) != 0;
    const int tid = threadIdx.x, lane = tid & 63, wave = __builtin_amdgcn_readfirstlane(tid >> 6);
    const int r = lane >> 3, c = lane & 7;
    LAS unsigned short* SE = (LAS unsigned short*)(lds + GA_SE_OFF);
    LAS float* AW = (LAS float*)(lds + GA_AW_OFF);
#pragma unroll 1
    for (int blk = wg; blk < NTOK / 128; blk += G) {
        const int tb = blk * 128;
        for (int i = tid; i < 128 * 128 / 4; i += 512) { typedef int i32x4 __attribute__((ext_vector_type(4))); const i32x4 e = ((const i32x4*)(sel_e + (size_t)tb * 128))[i];
            u32x2 w; w.x = (unsigned)e.x | ((unsigned)e.y << 16); w.y = (unsigned)e.z | ((unsigned)e.w << 16); ((LAS u32x2*)SE)[i] = w;
            ((LAS f32x4*)AW)[i] = (f32x4){0.f, 0.f, 0.f, 0.f}; }
        __syncthreads();
        const LAS unsigned short* sew = SE + wave * 2048 + r;
        LAS float* aww = AW + wave * 2048 + r;
        unsigned char* const setw = (unsigned char*)sel_e + (WS_SET - WS_SELE) + ((size_t)tb + wave * 16) * 256 + r * 16;
#pragma unroll
        for (int p = c; p < 32; p += 8) { const LAS unsigned short* sp = sew + (p >> 1) * 128 + 64 * (p & 1);
            u32x4 w; w.x = (unsigned)sp[0] | ((unsigned)sp[8] << 16); w.y = (unsigned)sp[16] | ((unsigned)sp[24] << 16); w.z = (unsigned)sp[32] | ((unsigned)sp[40] << 16); w.w = (unsigned)sp[48] | ((unsigned)sp[56] << 16);
            *(u32x4*)(setw + p * 128) = w; }
        if (!(mode & 4)) {
            u32x4 r0[8], r1[8]; u32x4 hn0, hn1;
            const brsrc_t rsd = ga_rsrc(down4);
            const unsigned char* hqw = HQ + ((size_t)tb + wave * 16) * 1024 + c * 16;
            ga_issue8(r0, rsd, sew, (unsigned)(c * 16)); ga_issue8(r1, rsd, sew + 64, (unsigned)(c * 16));
            hn0 = *(const u32x4*)hqw; hn1 = *(const u32x4*)(hqw + 512);
            asm volatile("" :: "v"(hn0), "v"(hn1));
#pragma unroll 1
            for (int it = 0; it < 64; ++it) {
                const u32x4 hhi = hn0, hlo = hn1;
                const int i1 = (it + 1) & 63; const unsigned so1 = ((unsigned)(i1 >> 4) << 21) + (unsigned)(c * 16);
                { const unsigned char* hx = hqw + (size_t)(i1 & 15) * 1024 + (i1 >> 4) * 128; hn0 = *(const u32x4*)hx; hn1 = *(const u32x4*)(hx + 512); }
                __builtin_amdgcn_sched_barrier(0);
                ga_down8(r0, hhi, hlo, aww + (it & 15) * 128, c == 0, rsd, sew + (i1 & 15) * 128, so1);
                ga_down8(r1, hhi, hlo, aww + (it & 15) * 128 + 64, c == 0, rsd, sew + (i1 & 15) * 128 + 64, so1);
                asm volatile("" :: "v"(hn0), "v"(hn1));
            }
        }
        float wr[32];
#pragma unroll 16
        for (int j = 0; j < 32; ++j) { const int idx = wave * 2048 + j * 64 + lane; const unsigned e = SE[idx]; const float* hsp = HS + 2 * ((size_t)tb + (idx >> 7)); const float x = (AW[idx] + 0.5f * hsp[1]) * (sdown[e] * hsp[0]);
            const float g = sel_g[(size_t)tb * 128 + idx]; wr[j] = dummy ? 0.f : ((mode & 2) ? -g : g) * 0.5f * x * (1.0f + erff(x * 0.70710678118654752f)) * sup[e]; }
        __syncthreads();
        {
            LAS unsigned char* WA = lds + GA_WA_OFF + wave * 3072; LAS float* WS = (LAS float*)(lds + GA_WS_OFF) + wave * 16;
#pragma unroll
            for (int tk = 0; tk < 16; ++tk) {
                float m = fmaxf(fabsf(wr[2 * tk]), fabsf(wr[2 * tk + 1]));
#pragma unroll
                for (int o = 1; o < 64; o <<= 1) m = fmaxf(m, __shfl_xor(m, o));
                const float inv = m > 0.f ? 6.0f / m : 0.f;
                if (lane == 0) WS[tk] = m * (1.0f / 6.0f);
#pragma unroll
                for (int hf = 0; hf < 2; ++hf) {
                    const float y = wr[2 * tk + hf] * inv;
                    const unsigned p1 = __builtin_amdgcn_cvt_scalef32_pk_fp4_f32(0u, y, 0.f, 1.0f, 0) & 15u; const float v1 = __builtin_amdgcn_cvt_scalef32_pk_f32_fp4(p1, 1.0f, 0)[0];
                    const float r1 = (y - v1) * 4.0f;
                    const unsigned p2 = __builtin_amdgcn_cvt_scalef32_pk_fp4_f32(0u, r1, 0.f, 1.0f, 0) & 15u; const float v2 = __builtin_amdgcn_cvt_scalef32_pk_f32_fp4(p2, 1.0f, 0)[0];
                    const float r2 = (r1 - v2) * 4.0f;
                    const unsigned p3 = __builtin_amdgcn_cvt_scalef32_pk_fp4_f32(0u, r2, 0.f, 1.0f, 0) & 15u;
                    const unsigned mine = p1 | (p2 << 8) | (p3 << 16);
                    const unsigned other = (unsigned)__builtin_amdgcn_update_dpp(0, (int)mine, 0xB1, 0xf, 0xf, true);
                    const unsigned both = mine | (other << 4);
                    if ((lane & 1) == 0) { LAS unsigned char* wp = WA + tk * 192 + hf * 96 + (lane >> 1);
                        wp[0] = (unsigned char)both; wp[32] = (unsigned char)(both >> 8); wp[64] = (unsigned char)(both >> 16); }
                }
            }
        }
        if (!(mode & 8)) {
            LAS unsigned char* img = lds + GA_IMG_OFF + wave * GA_IMG_WAVE;
            const int ir = 4 * (lane >> 5) + ((lane >> 3) & 1), rr = lane & 7;
            const unsigned rdo = (unsigned)(1024 * ir + 128 * rr + 8 * ((lane >> 4) & 1) + 16 * ((rr >> 1) | ((ir & 1) << 2)));
            const LAS unsigned char* WA = lds + GA_WA_OFF + wave * 3072 + (lane >> 5) * 16 + (lane & 31) * 32;
            const LAS float* WS = (const LAS float*)(lds + GA_WS_OFF) + wave * 16;
            const bool arow = (lane & 31) < 3;
            const brsrc_t rsu = ga_rsrc(up4);
            const unsigned ce16 = 16u * (unsigned)(c ^ (r >> 1));
            const unsigned char* const setr = setw;
#define GA_DMA8(se, buf, so) do { _Pragma("unroll") for (int i = 0; i < 8; ++i) { const unsigned en = ((i & 1) ? ((se)[i >> 1] >> 16) : ((se)[i >> 1] & 0xffffu)); \
                __builtin_amdgcn_raw_ptr_buffer_load_lds(rsu, (__attribute__((address_space(3))) void*)(img + (buf) * 8192 + i * 1024), 16, (int)((en << 7) + ((so) ^ (64u * (i & 1)))), 0, 0, 0); } } while (0)
#define GA_WAITV(n) asm volatile("s_waitcnt vmcnt(" #n ")" ::: "memory")
            const unsigned rda = (unsigned)(__UINTPTR_TYPE__)img + rdo, waa = (unsigned)(__UINTPTR_TYPE__)WA;
            float wsv; { const unsigned a = (unsigned)(__UINTPTR_TYPE__)(WS + (lane & 15)); asm volatile("ds_read_b32 %0, %1\n\ts_waitcnt lgkmcnt(0)" : "=v"(wsv) : "v"(a) : "memory"); }
            u32x4 seA = *(const u32x4*)setr, seB = *(const u32x4*)(setr + 128);
            { const u32x4 seC = *(const u32x4*)(setr + 256);
                GA_DMA8(seA, 0, ce16); GA_DMA8(seB, 1, ce16); seA = seC; }
            float acc8[8], x0[4], g0[4];
#pragma unroll 1
            for (int it = 0; it < 64; ++it) {
                const size_t t = (size_t)tb + wave * 16 + (it & 15); const int col = (it >> 4) * 256 + 128 * (lane >> 5) + (lane & 31);
                float* xp = xout + t * 1024 + col;
#pragma unroll
                for (int hf = 0; hf < 2; ++hf) {
                    if (hf == 0) { if (it == 0) GA_WAITV(8); else GA_WAITV(12); } else GA_WAITV(8);
                    __builtin_amdgcn_sched_barrier(0);
                    typedef int i32x2_t __attribute__((ext_vector_type(2)));
                    i32x2_t b0[8], b1[8]; u32x4 wa;
                    { const unsigned a = waa + (unsigned)((it & 15) * 192 + hf * 96); asm volatile("ds_read_b128 %0, %1" : "=v"(wa) : "v"(a) : "memory"); }
#pragma unroll
                    for (int cb = 0; cb < 8; ++cb) { const unsigned a = (rda ^ (unsigned)(16 * cb)) + (unsigned)(hf * 8192);
                        asm volatile("ds_read_b64_tr_b4 %0, %1" : "=v"(b0[cb]) : "v"(a) : "memory");
                        asm volatile("ds_read_b64_tr_b4 %0, %1 offset:2048" : "=v"(b1[cb]) : "v"(a) : "memory"); }
                    asm volatile("s_waitcnt lgkmcnt(0)" : "+v"(b0[0]), "+v"(b0[1]), "+v"(b0[2]), "+v"(b0[3]), "+v"(b0[4]), "+v"(b0[5]), "+v"(b0[6]), "+v"(b0[7]) :: "memory");
                    asm volatile("" : "+v"(b1[0]), "+v"(b1[1]), "+v"(b1[2]), "+v"(b1[3]), "+v"(b1[4]), "+v"(b1[5]), "+v"(b1[6]), "+v"(b1[7]) :: "memory");
                    asm volatile("" : "+v"(wa) :: "memory");
                    __builtin_amdgcn_sched_barrier(0);
                    const int itn = (it + 1) & 63; const unsigned son = ((unsigned)(itn >> 4) << 21) + ce16;
                    if (hf == 0) { const float* gp = modsL + (size_t)(t >> 11) * 6144 + 5 * 1024 + col;
#pragma unroll
                        for (int j = 0; j < 4; ++j) { x0[j] = xp[32 * j]; g0[j] = gp[32 * j]; }
                        seB = *(const u32x4*)(setr + (size_t)(itn & 15) * 256 + 128);
                        __builtin_amdgcn_sched_barrier(0);
                        GA_DMA8(seA, 0, son);
                    } else {
                        seA = *(const u32x4*)(setr + (size_t)((it + 2) & 15) * 256);
                        __builtin_amdgcn_sched_barrier(0);
                        GA_DMA8(seB, 1, son);
                    }
                    __builtin_amdgcn_sched_barrier(0);
                    i32x8 av; av[0] = arow ? (int)wa[0] : 0; av[1] = arow ? (int)wa[1] : 0; av[2] = arow ? (int)wa[2] : 0; av[3] = arow ? (int)wa[3] : 0; av[4] = 0; av[5] = 0; av[6] = 0; av[7] = 0;
#pragma unroll
                    for (int cb = 0; cb < 8; ++cb) {
                        i32x8 bv; bv[0] = b0[cb][0]; bv[1] = b0[cb][1]; bv[2] = b1[cb][0]; bv[3] = b1[cb][1]; bv[4] = 0; bv[5] = 0; bv[6] = 0; bv[7] = 0;
                        f32x16 dz;
#pragma unroll
                        for (int v = 0; v < 16; ++v) dz[v] = 0.f;
                        dz = __builtin_amdgcn_mfma_scale_f32_32x32x64_f8f6f4(av, bv, dz, 4, 4, 0, 0x7f7f7f7f, 0, 0x7f7f7f7f);
                        const float sdz = dz[0] + 0.25f * dz[1] + 0.0625f * dz[2];
                        acc8[cb] = hf ? acc8[cb] + sdz : sdz;
                    }
                    asm volatile("" : "+v"(acc8[0]), "+v"(acc8[1]), "+v"(acc8[2]), "+v"(acc8[3]), "+v"(acc8[4]), "+v"(acc8[5]), "+v"(acc8[6]), "+v"(acc8[7]));
                    if (hf == 1) { const float sw = __builtin_bit_cast(float, __builtin_amdgcn_readlane(__builtin_bit_cast(int, wsv), it & 15));
#pragma unroll
                        for (int j = 0; j < 4; ++j) { const u32x2 p = __builtin_amdgcn_permlane32_swap(__float_as_uint(acc8[j]), __float_as_uint(acc8[j + 4]), false, false);
                            xp[32 * j] = x0[j] + g0[j] * (sw * __uint_as_float(p.x)); } }
                    __builtin_amdgcn_sched_barrier(0);
                }
            }
            GA_WAITV(0);
        }
        if (!(mode & 16)) ga_norm16<FINAL>(xout, H, ng, modsN, (size_t)tb + wave * 16, lane);
        __syncthreads();
    }
}

__device__ __forceinline__ void phase_conv(const bf16* BGU, const float* cw, bf16* Z, int G, int wg) {
    for (int item = wg * 512 + threadIdx.x; item < NTOK * 128; item += G * 512) {
        const int t = item >> 7, d0 = (item & 127) * 8, n = t & 2047;
        const bf16* row = BGU + (size_t)t * 2048 + d0;
        const u32x4 bg = *(const u32x4*)row;
        float y[8];
#pragma unroll
        for (int i = 0; i < 8; ++i) y[i] = 0.f;
#pragma unroll
        for (int dn = -1; dn <= 1; ++dn) {
            if (n + dn < 0 || n + dn >= 2048) continue;
            const u32x4 uu = *(const u32x4*)(row + (ptrdiff_t)dn * 2048 + 1024);
            const f32x4 w0 = *(const f32x4*)(cw + (dn + 1) * 1024 + d0), w1 = *(const f32x4*)(cw + (dn + 1) * 1024 + d0 + 4);
#pragma unroll
            for (int q = 0; q < 4; ++q) { const float wl = (q < 2) ? w0[2 * q] : w1[2 * q - 4], wh = (q < 2) ? w0[2 * q + 1] : w1[2 * q - 3];
                y[2 * q] += wl * bf_lo(uu[q]); y[2 * q + 1] += wh * bf_hi(uu[q]); }
        }
        u32x4 o;
#pragma unroll
        for (int q = 0; q < 4; ++q) o[q] = cvt_pk(bf_lo(bg[q]) * y[2 * q], bf_hi(bg[q]) * y[2 * q + 1]);
        *(u32x4*)(Z + (size_t)t * 1024 + d0) = o;
    }
}

__global__ void __launch_bounds__(NWAVES * 64, 2) fwd(Args args) {
    extern __shared__ __attribute__((aligned(16))) unsigned char lds_raw[];
    LAS unsigned char* lds = (LAS unsigned char*)lds_raw;
    const int tid = threadIdx.x, lane = tid & 63, wave = __builtin_amdgcn_readfirstlane(tid >> 6);
    const int G = gridDim.x, wg = blockIdx.x;
    const int gw = wg * NWAVES + wave, NGW = G * NWAVES;
    unsigned char* ws = args.ws;
    unsigned* ctl = (unsigned*)(ws + WS_CTL);
    for (int u = tid; u < (LDS_BYTES - LDSCTL_OFF) / 4; u += NWAVES * 64) ((LAS unsigned*)(lds + LDSCTL_OFF))[u] = 0u;
    __syncthreads();
    XcdBarrier bar; bar.bar = ctl + CW_BAR; bar.x = 0; bar.st = nullptr;
    if (N_LAUNCHES == 1) bar = xcd_barrier_post(ctl + CW_BAR, (volatile LAS unsigned*)(lds + MISC_OFF) + 8);
#define GRID_BAR() do { if (N_LAUNCHES == 1) xcd_barrier(bar); } while (0)
    const int lo = args.ph_lo, hi = args.ph_hi;
#ifndef PHASE_MASK
#define PHASE_MASK 0xffff
#endif
#define IN(k) (((PHASE_MASK >> (k)) & 1) && lo <= (k) && (k) < hi)
#define BOTH(k) (IN(k) && IN((k) + 1))
    const float* mods = (const float*)(ws + WS_MOD);
    float* xout = args.out;
    bf16* H = (bf16*)(ws + WS_H);

    if (IN(0)) { for (int rep = 0; rep < NREP(0); ++rep) { phase_prep(args, lds, G, wg, rep, 0); __syncthreads(); } if (BOTH(0)) GRID_BAR(); }
    if (IN(1)) { phase_prep(args, lds, G, wg, 0, 1); __syncthreads();
                 for (int rep = 0; rep < NREP(1); ++rep) phase_norm(args.in[0], args.in[2], args.in[6], mods, 0, H, nullptr, nullptr, nullptr, G, wg);
                 phase_wq8(args.in[16], (const float*)((const unsigned*)(ws + WS_CTL) + CW_COLMAX), ws + WS_WQ_T, lds, G, wg); if (BOTH(1)) GRID_BAR(); }
    if (IN(2)) {
        for (int rep = 0; rep < NREP(2); ++rep) {
        { pg8::Gemm g{H, (const bf16*)(ws + WS_WIN_T), NTT, 1024, 1024}; pg8::StaticOrder S; S.init(NTT, 1024, G, wg);
          pg8::EpiBf16 E{(bf16*)(ws + WS_QK), 1024, 2, 0.125f};
          pg8::gemm_phase<pg8::EpiBf16, pg8::StaticOrder, true, true>(lds + RING_OFF, g, S, E); }
        { pg8::Gemm g{(const bf16*)(ws + WS_WIN_T) + (size_t)1024 * 1024, H, 1024, NTT, 1024}; pg8::StaticOrder S; S.init(1024, NTT, G, wg);
          pg8::EpiVF E{(bf16*)(ws + WS_VT), (bf16*)(ws + WS_VTC), (bf16*)(ws + WS_FT)};
          pg8::gemm_phase<pg8::EpiVF, pg8::StaticOrder, true, true>(lds + RING_OFF, g, S, E); }
        }
        if (BOTH(2)) GRID_BAR();
    }
    if (IN(3)) {
        { LAS float* rpl = (LAS float*)(lds + NWAVES * ATT_WAVE_LDS); for (int e = tid; e < 8 * 15 * 31; e += NWAVES * 64) rpl[e] = args.in[11][e]; __syncthreads();
          for (int rep = 0; rep < ((PROBE_PHASE == 3 && PROBE_SUB != 2) ? 2 : 1); ++rep)
          for (int u0 = wg; u0 < 1024; u0 += G) {
              int u = u0; if (G == 256) { const int xcd = wg & 7, idx = wg >> 3, round = u0 >> 8; u = ((xcd * 16 + round * 4 + (idx >> 3)) << 3) | (idx & 7); }
              const int b = u >> 6, h = (u >> 3) & 7, rq = u & 7;
              na_attn32_wave((const bf16*)(ws + WS_QK), (const bf16*)(ws + WS_VT), (const bf16*)(ws + WS_VTC), rpl + h * 465, lds + wave * ATT_WAVE_LDS, (bf16*)(ws + WS_A2), b, h, 4 * rq + 2 * (wave >> 2), wave & 3, lane);
          } }
        __syncthreads();
        for (int task = gw; task < 16 * 512; task += NGW) {
            const bf16* fp = (const bf16*)(ws + WS_FT) + (size_t)task * 2048 + lane * 32; float sacc = 0.f;
#pragma unroll
            for (int q = 0; q < 4; ++q) { const u32x4 v = *(const u32x4*)(fp + 8 * q);
#pragma unroll
                for (int z = 0; z < 4; ++z) sacc += bf_lo(v[z]) - bf_hi(v[z]); }
            sacc = wave_sum(sacc);
            if (lane == 0) { bf16* op = (bf16*)(ws + WS_A2) + ((size_t)(task >> 9) * 2048 + 1024) * 1536 + 512 + (task & 511); op[0] = (bf16)(cvt_pk(sacc, 0.f) & 0xffffu); op[512] = 0; }
        }
        { pg8::Gemm g{(const bf16*)(ws + WS_DFT), (const bf16*)(ws + WS_FT), 2048, 8192, 2048}; pg8::StaticOrder S; S.init(2048, 8192, G, wg);
          pg8::EpiDft E{(bf16*)(ws + WS_A2)};
          pg8::gemm_phase<pg8::EpiDft, pg8::StaticOrder, true, true>(lds + RING_OFF, g, S, E);
          if (PROBE_PHASE == 3 && PROBE_SUB != 1) pg8::gemm_phase<pg8::EpiDft, pg8::StaticOrder, true, true>(lds + RING_OFF, g, S, E); }
        if (BOTH(3)) GRID_BAR();
    }
    if (IN(4)) {
        pg8::Gemm g{(const bf16*)(ws + WS_A2), (const bf16*)(ws + WS_WOUT_T), NTOK, 1024, 1536}; pg8::StaticOrder S; S.init(NTOK, 1024, G, wg);
        pg8::EpiRes E{args.in[0], xout, mods + 2 * 1024, 6144, 1.f};
        pg8::gemm_phase<pg8::EpiRes, pg8::StaticOrder, true, true>(lds + RING_OFF, g, S, E); if (PROBE_PHASE == 4) pg8::gemm_phase<pg8::EpiRes, pg8::StaticOrder, true, true>(lds + RING_OFF, g, S, E);
        if (BOTH(4)) GRID_BAR();
    }
#define PEER_LAYER(L, pb) do { \
        const float* modsL = mods + (size_t)(L) * 17 * 6144; \
        if (IN(pb)) { for (int rep = 0; rep < NREP(pb); ++rep) phase_norm(xout, nullptr, args.in[7] + (L) * 1024, modsL, 3, nullptr, ws + WS_HQ, ws + WS_HQ8, (float*)(ws + WS_HS), G, wg); if (BOTH(pb)) GRID_BAR(); } \
        if (IN((pb) + 1)) { \
              \
            pg8::Gemm g{(const bf16*)(ws + WS_HQ8), (const bf16*)(ws + WS_WQ_T) + (size_t)(L) * 2048 * 512, NTOK, 2048, 512}; pg8::StaticOrder S; S.init(NTOK, 2048, G, wg); \
            pg8::EpiQ8 E{(bf16*)(ws + WS_PQ), (const float*)(ws + WS_HS), (const float*)((const unsigned*)(ws + WS_CTL) + CW_COLMAX) + (L) * 2048}; \
            pg8::gemm_phase<pg8::EpiQ8, pg8::StaticOrder, true, true>(lds + RING_OFF, g, S, E); if (PROBE_PHASE == (pb) + 1) pg8::gemm_phase<pg8::EpiQ8, pg8::StaticOrder, true, true>(lds + RING_OFF, g, S, E); \
            if (BOTH((pb) + 1)) GRID_BAR(); \
        } \
        if (IN((pb) + 2)) { \
            const bf16* KEYS = (const bf16*)(ws + WS_KEYS) + (size_t)(L) * 8 * 2 * 128 * 128; \
            for (int rep = 0; rep < NREP((pb) + 2); ++rep) phase_topk(lds, (const bf16*)(ws + WS_PQ), KEYS, (int*)(ws + WS_SELE), (float*)(ws + WS_SELG), args.in[18] + (size_t)(L) * 16384 * 1024, args.in[19] + (size_t)(L) * 16384 * 1024, ws + WS_TAB + (size_t)(2 * (L)) * 8 * MiB, (float*)(ws + WS_TSC) + (2 * (L)) * 16384, G, wg); \
            if (BOTH((pb) + 2)) GRID_BAR(); \
        } \
        if (IN((pb) + 3)) { \
            const unsigned char* down8 = ws + WS_TAB + (size_t)(2 * (L)) * 8 * MiB; const unsigned char* up8 = ws + WS_TAB + (size_t)(2 * (L) + 1) * 8 * MiB; \
            const float* sdn = (const float*)(ws + WS_TSC) + (2 * (L)) * 16384; const float* sup = sdn + 16384; \
            for (int grep_ = 0; grep_ < ((PROBE_PHASE == (pb) + 3 && PROBE_SUB >= 3) ? 3 : 1); ++grep_) { const int GMODE = (PROBE_PHASE != (pb) + 3 || PROBE_SUB < 3) ? 0 : (PROBE_SUB == 3) ? ((grep_ == 1) ? 2 : 0) : (PROBE_SUB == 4) ? (((grep_ == 1) ? 2 : 0) | (grep_ < 2 ? 16 : 0)) : (grep_ < 2 ? 12 : 0); \
            if ((L) == 0) phase_gather<false>(lds, H, ws + WS_HQ, (const float*)(ws + WS_HS), (const int*)(ws + WS_SELE), (const float*)(ws + WS_SELG), down8, up8, sdn, sup, modsL, xout, args.in[6] + 1024, mods + (size_t)17 * 6144, G, wg, GMODE); \
            else phase_gather<true>(lds, H, ws + WS_HQ, (const float*)(ws + WS_HS), (const int*)(ws + WS_SELE), (const float*)(ws + WS_SELG), down8, up8, sdn, sup, modsL, xout, args.in[8], nullptr, G, wg, GMODE); } \
            if (PROBE_PHASE == (pb) + 3 && PROBE_SUB < 3) phase_gather<true>(lds, H, ws + WS_HQ, (const float*)(ws + WS_HS), (const int*)(ws + WS_SELE), (const float*)(ws + WS_SELG), down8, up8, sdn, sup, modsL, xout, args.in[8], nullptr, G, wg, 17 | (PROBE_SUB == 1 ? 8 : PROBE_SUB == 2 ? 4 : 0)); \
            if (BOTH((pb) + 3)) GRID_BAR(); \
        } } while (0)

    PEER_LAYER(0, 5);
    if (IN(9)) {
        pg8::Gemm g{H, (const bf16*)(ws + WS_CVIN_T), NTOK, 3072, 1024}; pg8::StaticOrder S; S.init(NTOK, 3072, G, wg);
        pg8::EpiCv E{(bf16*)(ws + WS_BCV)};
        pg8::gemm_phase<pg8::EpiCv, pg8::StaticOrder, true, true>(lds + RING_OFF, g, S, E); if (PROBE_PHASE == 9) pg8::gemm_phase<pg8::EpiCv, pg8::StaticOrder, true, true>(lds + RING_OFF, g, S, E);
        if (BOTH(9)) GRID_BAR();
    }
    if (IN(10)) { for (int rep = 0; rep < NREP(10); ++rep) phase_conv((const bf16*)(ws + WS_BCV), args.in[14], H, G, wg); if (BOTH(10)) GRID_BAR(); }
    if (IN(11)) {
        pg8::Gemm g{H, (const bf16*)(ws + WS_CVOUT_T), NTOK, 1024, 1024}; pg8::StaticOrder S; S.init(NTOK, 1024, G, wg);
        pg8::EpiRes E{xout, xout, mods + (size_t)17 * 6144 + 2 * 1024, 6144, 1.f};
        pg8::gemm_phase<pg8::EpiRes, pg8::StaticOrder, true, true>(lds + RING_OFF, g, S, E);
        if (PROBE_PHASE == 11) { pg8::EpiRes E0{xout, xout, mods + (size_t)17 * 6144 + 2 * 1024, 6144, __int_as_float(args.pad)}; pg8::gemm_phase<pg8::EpiRes, pg8::StaticOrder, true, true>(lds + RING_OFF, g, S, E0); }
        if (BOTH(11)) GRID_BAR();
    }
    PEER_LAYER(1, 12);
#undef PEER_LAYER
#undef IN
#undef BOTH
#undef GRID_BAR
}

extern "C" void kernel_launch(void* const* d_in, const int* in_sizes, int n_in, void* d_out, int out_size, void* d_ws, size_t ws_size, hipStream_t stream) {
    static int grid = 0;
    if (grid == 0) {
        if (n_in != 20 || out_size != NTOK * D || ws_size < WS_END) { fprintf(stderr, "kernel_launch: unexpected shapes (n_in %d, out %d, ws %zu); nothing launched\n", n_in, out_size, ws_size); grid = -1; return; }
        int dev = 0, cus = 0;
        if (hipGetDevice(&dev) != hipSuccess || hipDeviceGetAttribute(&cus, hipDeviceAttributeMultiprocessorCount, dev) != hipSuccess) { grid = -1; return; }
        if (hipFuncSetAttribute((const void*)fwd, hipFuncAttributeMaxDynamicSharedMemorySize, LDS_BYTES) != hipSuccess) { fprintf(stderr, "kernel_launch: hipFuncSetAttribute failed\n"); grid = -1; return; }
        int per_cu = 0;
        if (hipOccupancyMaxActiveBlocksPerMultiprocessor(&per_cu, (const void*)fwd, NWAVES * 64, LDS_BYTES) != hipSuccess || per_cu < 1) fprintf(stderr, "kernel_launch: occupancy query reports %d\n", per_cu);
        (void)hipGetLastError();
        grid = cus;
    }
    if (grid < 0) return;
    (void)hipMemsetAsync((char*)d_ws + WS_CTL, 0, CTL_ZERO_BYTES, stream);
    Args a{};
    for (int i = 0; i < 20; ++i) a.in[i] = (const float*)d_in[i];
    a.out = (float*)d_out; a.ws = (unsigned char*)d_ws;
    for (int li = 0; li < N_LAUNCHES; ++li) {
        a.ph_lo = (N_LAUNCHES == 1) ? 0 : li; a.ph_hi = (N_LAUNCHES == 1) ? N_PHASES : li + 1; a.li = li;
        hipLaunchKernelGGL(fwd, dim3(grid), dim3(NWAVES * 64), LDS_BYTES, stream, a);
    }
}
```

```cpp
#include <hip/hip_runtime.h>
#include <cstdio>
#include <cstdint>

#ifndef MK_N_LAUNCHES
#define MK_N_LAUNCHES 1
#endif

#ifndef PROBE_PHASE
#define PROBE_PHASE (-1)
#endif
#ifndef PROBE_SUB
#define PROBE_SUB 0
#endif
#define NREP(k) ((PROBE_PHASE == (k)) ? 2 : 1)
#define LAS __attribute__((address_space(3)))
typedef unsigned short bf16;
typedef short bf16x8 __attribute__((ext_vector_type(8)));
typedef float f32x4 __attribute__((ext_vector_type(4)));
typedef unsigned u32x4 __attribute__((ext_vector_type(4)));
typedef unsigned u32x2 __attribute__((ext_vector_type(2)));
typedef __bf16 bf16v2 __attribute__((ext_vector_type(2)));

namespace pg8 {
#define PG8_LAS __attribute__((address_space(3)))
typedef unsigned short bf16_t;
constexpr int BM = 256, BK = 64, HALF = 128, HTB = HALF * BK * 2, STAGE_BYTES = 8 * HTB, NXCD = 8, WGM = 8;

__host__ __device__ __forceinline__ int lds_byte(int r, int c) { const int st = (r >> 4) * 2 + (c >> 5), rr = r & 15, cc = c & 31, ob = rr * 64 + cc * 2; return st * 1024 + (ob ^ (((ob >> 9) & 1) << 5)); }
__host__ __device__ __forceinline__ void stage_rc(int b, int& R, int& C) { const int st = b / 1024, sb = b % 1024, swz = sb ^ (((sb >> 9) & 1) << 5); R = (st >> 1) * 16 + swz / 64; C = (st & 1) * 32 + (swz % 64) / 2; }
__host__ __device__ __forceinline__ int perm32(int rho) { const int n = rho >> 4, i = rho & 15; return 8 * (i >> 2) + 4 * n + (i & 3); }

struct Unit { int pm, pn; };
struct Gemm { const bf16_t* A; const bf16_t* Bt; int M, N, K; };

struct StaticOrder {
    int nM, nN, nwg, G, c;
    __host__ __device__ void init(int M, int N, int G_, int c_) { nM = M / BM; nN = N / BM; nwg = nM * nN; G = G_; c = c_; }
    __host__ __device__ bool next(int i, Unit& u) const {
        const long L = (long)i * G + c; if (L >= nwg) return false;
        int wgid = (int)L; { const int q = nwg / NXCD, r = nwg % NXCD, xcd = wgid % NXCD, off = wgid / NXCD; wgid = (xcd < r ? xcd * (q + 1) : r * (q + 1) + (xcd - r) * q) + off; }
        const int nig = WGM * nN, gid = wgid / nig, fm = gid * WGM, gsz = (nM - fm) < WGM ? (nM - fm) : WGM;
        u.pm = fm + ((wgid % nig) % gsz); u.pn = (wgid % nig) / gsz; return true;
    }
    __device__ __forceinline__ void a_ready(const Unit&) const {}
    __device__ __forceinline__ void done(const Unit&) const {}
};

__device__ __forceinline__ unsigned cvt_pk_bf16(float lo, float hi) { unsigned r; asm volatile("v_cvt_pk_bf16_f32 %0, %1, %2" : "=v"(r) : "v"(lo), "v"(hi)); return r; }


struct EpiBf16 {
    static constexpr bool PERM = true, AFTER_DRAIN = false;
    bf16_t* O; int ldc; int nscale; float scale0;
    __device__ __forceinline__ void operator()(const f32x4 (&acc)[2][2][4][2], const Unit& u, int wr, int wc, int fr, int fq) const {
        const int row0 = u.pm * BM + wr * 64 + fr; const int col0 = u.pn * BM + wc * 32 + 8 * fq;
        const float sc = (u.pn < nscale) ? scale0 : 1.f;
#pragma unroll
        for (int ai = 0; ai < 2; ++ai)
#pragma unroll
            for (int m = 0; m < 4; ++m) { bf16_t* rowp = O + (size_t)(row0 + ai * HALF + m * 16) * ldc + col0;
#pragma unroll
                for (int bj = 0; bj < 2; ++bj) { f32x4 v0 = acc[ai][bj][m][0] * sc, v1 = acc[ai][bj][m][1] * sc;
                    u32x4 w; w.x = cvt_pk_bf16(v0[0], v0[1]); w.y = cvt_pk_bf16(v0[2], v0[3]); w.z = cvt_pk_bf16(v1[0], v1[1]); w.w = cvt_pk_bf16(v1[2], v1[3]);
                    *(u32x4*)(rowp + bj * HALF) = w; } }
    }
};
struct EpiCv {
    static constexpr bool PERM = true, AFTER_DRAIN = false;
    bf16_t* O;
    __device__ __forceinline__ void operator()(const f32x4 (&acc)[2][2][4][2], const Unit& u, int wr, int wc, int fr, int fq) const {
        const int row0 = u.pm * BM + wr * 64 + fr;
        if (u.pn < 4) {
            const int col0 = u.pn * BM + wc * 32 + 8 * fq;
#pragma unroll
            for (int ai = 0; ai < 2; ++ai)
#pragma unroll
                for (int m = 0; m < 4; ++m) { bf16_t* rowp = O + (size_t)(row0 + ai * HALF + m * 16) * 2048 + col0;
#pragma unroll
                    for (int bj = 0; bj < 2; ++bj) { const f32x4 v0 = acc[ai][bj][m][0], v1 = acc[ai][bj][m][1];
                        u32x4 w; w.x = cvt_pk_bf16(v0[0], v0[1]); w.y = cvt_pk_bf16(v0[2], v0[3]); w.z = cvt_pk_bf16(v1[0], v1[1]); w.w = cvt_pk_bf16(v1[2], v1[3]);
                        *(u32x4*)(rowp + bj * HALF) = w; } }
        } else {
            const int col0 = 1024 + (u.pn - 4) * HALF + wc * 32 + 8 * fq;
#pragma unroll
            for (int ai = 0; ai < 2; ++ai)
#pragma unroll
                for (int m = 0; m < 4; ++m) { const f32x4 v0 = acc[ai][0][m][0] * acc[ai][1][m][0], v1 = acc[ai][0][m][1] * acc[ai][1][m][1];
                    u32x4 w; w.x = cvt_pk_bf16(v0[0], v0[1]); w.y = cvt_pk_bf16(v0[2], v0[3]); w.z = cvt_pk_bf16(v1[0], v1[1]); w.w = cvt_pk_bf16(v1[2], v1[3]);
                    *(u32x4*)(O + (size_t)(row0 + ai * HALF + m * 16) * 2048 + col0) = w; }
        }
    }
};
struct EpiVF {
    static constexpr bool PERM = true, AFTER_DRAIN = false;
    bf16_t* VT; bf16_t* VTC; bf16_t* FT;
    __device__ __forceinline__ void operator()(const f32x4 (&acc)[2][2][4][2], const Unit& u, int wr, int wc, int fr, int fq) const {
        const int row0 = u.pm * BM + wr * 64 + fr; const int tok0 = u.pn * BM;
        const bool isf = u.pm >= 2, isctx = tok0 >= 32768;
        if (isf && isctx) return;
        bf16_t* base; int pitch, cbase;
        if (!isctx) { const int b = tok0 >> 11; pitch = 2048; cbase = (tok0 & 2047) + wc * 32 + 8 * fq; base = (isf ? FT : VT) + (size_t)b * 512 * 2048; }
        else { const int tc = tok0 - 32768; const int b = tc >> 8; pitch = 256; cbase = wc * 32 + 8 * fq; base = VTC + (size_t)b * 512 * 256; }
        const int rsub = isf ? 512 : 0;
#pragma unroll
        for (int ai = 0; ai < 2; ++ai)
#pragma unroll
            for (int m = 0; m < 4; ++m) { bf16_t* rowp = base + (size_t)(row0 + ai * HALF + m * 16 - rsub) * pitch + cbase;
#pragma unroll
                for (int bj = 0; bj < 2; ++bj) { const f32x4 v0 = acc[ai][bj][m][0], v1 = acc[ai][bj][m][1];
                    u32x4 w; w.x = cvt_pk_bf16(v0[0], v0[1]); w.y = cvt_pk_bf16(v0[2], v0[3]); w.z = cvt_pk_bf16(v1[0], v1[1]); w.w = cvt_pk_bf16(v1[2], v1[3]);
                    *(u32x4*)(rowp + bj * HALF) = w; } }
    }
};
struct EpiDft {
    static constexpr bool PERM = true, AFTER_DRAIN = false;
    bf16_t* A2;
    __device__ __forceinline__ void operator()(const f32x4 (&acc)[2][2][4][2], const Unit& u, int wr, int wc, int fr, int fq) const {
        const int kp0 = u.pm * BM + wr * 64 + fr; const int part = kp0 >> 10;
        const int bc0 = u.pn * BM; const int b = bc0 >> 9; const int ch0 = (bc0 & 511) + wc * 32 + 8 * fq;
        bf16_t* base = A2 + (size_t)b * 2048 * 1536 + 512 + part * 512 + ch0;
        const float sg = part ? -1.f : 1.f;
#pragma unroll
        for (int ai = 0; ai < 2; ++ai)
#pragma unroll
            for (int m = 0; m < 4; ++m) { const int k = (kp0 & 1023) + ai * HALF + m * 16; bf16_t* rowp = base + (size_t)k * 1536; bf16_t* mirp = base + (size_t)(2048 - k) * 1536;
#pragma unroll
                for (int bj = 0; bj < 2; ++bj) { const f32x4 v0 = acc[ai][bj][m][0], v1 = acc[ai][bj][m][1];
                    u32x4 w; w.x = cvt_pk_bf16(v0[0], v0[1]); w.y = cvt_pk_bf16(v0[2], v0[3]); w.z = cvt_pk_bf16(v1[0], v1[1]); w.w = cvt_pk_bf16(v1[2], v1[3]);
                    *(u32x4*)(rowp + bj * HALF) = w;
                    if (k > 0) { const f32x4 n0 = v0 * sg, n1 = v1 * sg; u32x4 x; x.x = cvt_pk_bf16(n0[0], n0[1]); x.y = cvt_pk_bf16(n0[2], n0[3]); x.z = cvt_pk_bf16(n1[0], n1[1]); x.w = cvt_pk_bf16(n1[2], n1[3]);
                        *(u32x4*)(mirp + bj * HALF) = x; } } }
    }
};
struct EpiRes {
    static constexpr bool PERM = false, AFTER_DRAIN = false;
    const float* base; float* out; const float* gate; int gpitch; float gsc;
    __device__ __forceinline__ void operator()(const f32x4 (&acc)[2][2][4][2], const Unit& u, int wr, int wc, int fr, int fq) const {
        const int row0 = u.pm * BM + wr * 64 + fr, col0 = u.pn * BM + wc * 32 + 4 * fq;
        const float* gp = gate + (size_t)((u.pm * BM) >> 11) * gpitch + col0;
        f32x4 gv[2][2];
#pragma unroll
        for (int bj = 0; bj < 2; ++bj)
#pragma unroll
            for (int n = 0; n < 2; ++n) gv[bj][n] = *(const f32x4*)(gp + bj * HALF + n * 16);
#pragma unroll
        for (int ai = 0; ai < 2; ++ai)
#pragma unroll
            for (int m = 0; m < 4; ++m) { const size_t off = (size_t)(row0 + ai * HALF + m * 16) * 1024 + col0;
#pragma unroll
                for (int bj = 0; bj < 2; ++bj)
#pragma unroll
                    for (int n = 0; n < 2; ++n) { const f32x4 bs = *(const f32x4*)(base + off + bj * HALF + n * 16);
                        *(f32x4*)(out + off + bj * HALF + n * 16) = bs + gv[bj][n] * acc[ai][bj][m][n] * gsc; }
                asm volatile("" ::: "memory"); }
    }
};

typedef int i32x4_t __attribute__((ext_vector_type(4)));
struct EpiQ8 {
    static constexpr bool PERM = true, AFTER_DRAIN = false, I8 = true;
    bf16_t* O; const float* hs; const float* wsc;
    __device__ __forceinline__ void operator()(const f32x4 (&acc)[2][2][4][2], const Unit& u, int wr, int wc, int fr, int fq) const {
        const int row0 = u.pm * BM + wr * 64 + fr, col0 = u.pn * BM + wc * 32 + 8 * fq;
        f32x4 cs[2][2];
#pragma unroll
        for (int bj = 0; bj < 2; ++bj)
#pragma unroll
            for (int n = 0; n < 2; ++n) cs[bj][n] = *(const f32x4*)(wsc + col0 + bj * HALF + n * 4) * (1.0f / 127.0f);
#pragma unroll
        for (int ai = 0; ai < 2; ++ai)
#pragma unroll
            for (int m = 0; m < 4; ++m) { const int row = row0 + ai * HALF + m * 16; const float rs = hs[2 * (size_t)row];
                bf16_t* rowp = O + (size_t)row * 2048 + col0;
#pragma unroll
                for (int bj = 0; bj < 2; ++bj) { const i32x4_t a0 = __builtin_bit_cast(i32x4_t, acc[ai][bj][m][0]), a1 = __builtin_bit_cast(i32x4_t, acc[ai][bj][m][1]);
                    f32x4 v0, v1;
#pragma unroll
                    for (int z = 0; z < 4; ++z) { v0[z] = (float)a0[z] * rs * cs[bj][0][z]; v1[z] = (float)a1[z] * rs * cs[bj][1][z]; }
                    u32x4 w; w.x = cvt_pk_bf16(v0[0], v0[1]); w.y = cvt_pk_bf16(v0[2], v0[3]); w.z = cvt_pk_bf16(v1[0], v1[1]); w.w = cvt_pk_bf16(v1[2], v1[3]);
                    *(u32x4*)(rowp + bj * HALF) = w; } }
    }
};

template <class E, class = void> struct epi_is_i8 { static constexpr bool value = false; };
template <class E> struct epi_is_i8<E, decltype((void)E::I8)> { static constexpr bool value = E::I8; };
template <class Epi, class Sched, bool ALIGN_EPI = false, bool SP2 = false>
__device__ __forceinline__ void gemm_phase(PG8_LAS unsigned char* lds, const Gemm g, const Sched& S, const Epi& E) {
    const int tid = threadIdx.x, wid = __builtin_amdgcn_readfirstlane(tid >> 6), lane = tid & 63, wr = wid >> 2, wc = wid & 3, fr = lane & 15, fq = lane >> 4;
    const int K = g.K, nt = K / BK;
    unsigned voffA[2], voffB[2];
#pragma unroll
    for (int i = 0; i < 2; ++i) { int R, C; stage_rc(tid * 16 + i * 8192, R, C); const int Rb = Epi::PERM ? ((R & ~31) + perm32(R & 31)) : R;
        voffA[i] = (unsigned)(R * K + C) * 2u; voffB[i] = (unsigned)(Rb * K + C) * 2u; }
    const size_t kstep = (size_t)(BK * 2);
    const size_t hstep = (size_t)HALF * K * 2;
    const size_t tstep = 2 * hstep;
    const unsigned ldsw = (unsigned)wid * 1024u;
    const int aoff = lds_byte(wr * 64 + fr, fq * 8), boff = lds_byte(wc * 32 + fr, fq * 8);
#define PG8_SA(b, h) (((b) * 2 + (h)) * HTB)
#define PG8_SB(b, h) ((4 + (b) * 2 + (h)) * HTB)
#define PG8_STAGE(bufoff, gbase, voff) do { _Pragma("unroll") for (int _i = 0; _i < 2; ++_i) \
        __builtin_amdgcn_global_load_lds((const unsigned*)((const char*)(gbase) + (voff)[_i]), (PG8_LAS unsigned*)(lds + (bufoff) + ldsw + _i * 8192), 16, 0, 0); } while (0)
#define PG8_LDA(dst, b, h) do { _Pragma("unroll") for (int m = 0; m < 4; ++m) _Pragma("unroll") for (int k = 0; k < 2; ++k) dst[m][k] = *(const PG8_LAS bf16x8*)(lds + PG8_SA(b, h) + aoff + m * 2048 + k * 1024); } while (0)
#define PG8_LDB(dst, b, h) do { _Pragma("unroll") for (int n = 0; n < 2; ++n) _Pragma("unroll") for (int k = 0; k < 2; ++k) dst[n][k] = *(const PG8_LAS bf16x8*)(lds + PG8_SB(b, h) + boff + n * 2048 + k * 1024); } while (0)
#define PG8_MMA(ai, bj, At, Bt) do { __builtin_amdgcn_s_setprio(1); _Pragma("unroll") for (int m = 0; m < 4; ++m) _Pragma("unroll") for (int n = 0; n < 2; ++n) _Pragma("unroll") for (int k = 0; k < 2; ++k) { \
        if constexpr (epi_is_i8<Epi>::value) acc[ai][bj][m][n] = __builtin_bit_cast(f32x4, __builtin_amdgcn_mfma_i32_16x16x64_i8(__builtin_bit_cast(i32x4_t, Bt[n][k]), __builtin_bit_cast(i32x4_t, At[m][k]), __builtin_bit_cast(i32x4_t, acc[ai][bj][m][n]), 0, 0, 0)); \
        else acc[ai][bj][m][n] = __builtin_amdgcn_mfma_f32_16x16x32_bf16(Bt[n][k], At[m][k], acc[ai][bj][m][n], 0, 0, 0); } __builtin_amdgcn_s_setprio(0); } while (0)
#define PG8_WAIT_V(n) asm volatile("s_waitcnt vmcnt(" #n ")" ::: "memory")
#define PG8_WAIT_L(n) asm volatile("s_waitcnt lgkmcnt(" #n ")" ::: "memory")
#define PG8_BAR __builtin_amdgcn_s_barrier()
#define PG8_SCHED __builtin_amdgcn_sched_barrier(0)
    Unit cur, nxt; int ui = 0;
    if (!S.next(0, cur)) return;
    f32x4 acc[2][2][4][2];
#pragma unroll
    for (int a = 0; a < 2; ++a)
#pragma unroll
        for (int b = 0; b < 2; ++b)
#pragma unroll
            for (int m = 0; m < 4; ++m)
#pragma unroll
                for (int n = 0; n < 2; ++n) acc[a][b][m][n] = (f32x4){0.f, 0.f, 0.f, 0.f};
    bf16x8 At[4][2], B0[2][2], B1[2][2];
    const char* cA = (const char*)g.A + (size_t)cur.pm * tstep; const char* cB = (const char*)g.Bt + (size_t)cur.pn * tstep;
    S.a_ready(cur);
    if constexpr (SP2) {
        PG8_STAGE(PG8_SB(0, 0), cB, voffB); PG8_STAGE(PG8_SB(0, 1), cB + hstep, voffB); PG8_STAGE(PG8_SA(0, 0), cA, voffA); PG8_STAGE(PG8_SA(0, 1), cA + hstep, voffA);
        if (wr == 1) PG8_BAR;
        PG8_WAIT_V(2); PG8_BAR;
        PG8_STAGE(PG8_SB(1, 0), cB + kstep, voffB); PG8_STAGE(PG8_SA(1, 0), cA + kstep, voffA); PG8_STAGE(PG8_SB(1, 1), cB + hstep + kstep, voffB);
        PG8_WAIT_V(6); PG8_BAR;
    } else {
        PG8_STAGE(PG8_SB(0, 0), cB, voffB); PG8_STAGE(PG8_SA(0, 0), cA, voffA); PG8_STAGE(PG8_SB(0, 1), cB + hstep, voffB); PG8_STAGE(PG8_SA(0, 1), cA + hstep, voffA);
        if (wr == 1) PG8_BAR;
        PG8_WAIT_V(4); PG8_BAR;
        PG8_STAGE(PG8_SB(1, 0), cB + kstep, voffB); PG8_STAGE(PG8_SA(1, 0), cA + kstep, voffA); PG8_STAGE(PG8_SB(1, 1), cB + hstep + kstep, voffB);
        PG8_WAIT_V(6); PG8_BAR;
    }
    for (;;) {
        const bool has_next = S.next(ui + 1, nxt);
        const char* nA = has_next ? (const char*)g.A + (size_t)nxt.pm * tstep : cA; const char* nB = has_next ? (const char*)g.Bt + (size_t)nxt.pn * tstep : cB;
        for (int t = 0; t < nt; t += 2) {
            const bool last = (t == nt - 2);
            const char* a1 = cA + (size_t)(t + 1) * kstep;
            const char* a2 = last ? nA : cA + (size_t)(t + 2) * kstep; const char* b2 = last ? nB : cB + (size_t)(t + 2) * kstep;
            const char* a3 = a2 + kstep; const char* b3 = b2 + kstep;
            if (last && has_next) S.a_ready(nxt);
            if constexpr (SP2) {
            PG8_LDB(B0, 0, 0); PG8_LDB(B1, 0, 1); PG8_SCHED; PG8_LDA(At, 0, 0); PG8_STAGE(PG8_SA(1, 1), a1 + hstep, voffA);
            PG8_WAIT_V(8); PG8_WAIT_L(0); PG8_BAR; PG8_MMA(0, 0, At, B0); PG8_MMA(0, 1, At, B1); PG8_BAR; PG8_SCHED;
            PG8_LDA(At, 0, 1); PG8_STAGE(PG8_SB(0, 0), b2, voffB); PG8_STAGE(PG8_SB(0, 1), b2 + hstep, voffB); PG8_STAGE(PG8_SA(0, 0), a2, voffA);
            PG8_WAIT_V(8); PG8_WAIT_L(0); PG8_BAR; PG8_MMA(1, 0, At, B0); PG8_MMA(1, 1, At, B1); PG8_BAR; PG8_SCHED;
            PG8_LDB(B0, 1, 0); PG8_LDB(B1, 1, 1); PG8_SCHED; PG8_LDA(At, 1, 0); PG8_STAGE(PG8_SA(0, 1), a2 + hstep, voffA);
            PG8_WAIT_V(8); PG8_WAIT_L(0); PG8_BAR; PG8_MMA(0, 0, At, B0); PG8_MMA(0, 1, At, B1); PG8_BAR; PG8_SCHED;
            PG8_LDA(At, 1, 1); PG8_STAGE(PG8_SB(1, 0), b3, voffB); PG8_STAGE(PG8_SB(1, 1), b3 + hstep, voffB); PG8_STAGE(PG8_SA(1, 0), a3, voffA);
            PG8_WAIT_V(8); PG8_WAIT_L(0); PG8_BAR; PG8_MMA(1, 0, At, B0); PG8_MMA(1, 1, At, B1); PG8_BAR; PG8_SCHED;
            } else {
            PG8_LDB(B0, 0, 0); PG8_SCHED; PG8_LDA(At, 0, 0); PG8_STAGE(PG8_SA(1, 1), a1 + hstep, voffA);
            PG8_WAIT_L(8); PG8_BAR; PG8_WAIT_L(0); PG8_MMA(0, 0, At, B0); PG8_BAR; PG8_SCHED;
            PG8_LDB(B1, 0, 1); PG8_STAGE(PG8_SB(0, 0), b2, voffB);
            PG8_BAR; PG8_WAIT_L(0); PG8_MMA(0, 1, At, B1); PG8_BAR;
            PG8_LDA(At, 0, 1); PG8_STAGE(PG8_SA(0, 0), a2, voffA);
            PG8_BAR; PG8_WAIT_L(0); PG8_MMA(1, 0, At, B0); PG8_BAR; PG8_SCHED;
            PG8_STAGE(PG8_SB(0, 1), b2 + hstep, voffB);
            PG8_WAIT_V(6); PG8_BAR; PG8_MMA(1, 1, At, B1); PG8_BAR;
            PG8_LDB(B0, 1, 0); PG8_SCHED; PG8_LDA(At, 1, 0); PG8_STAGE(PG8_SA(0, 1), a2 + hstep, voffA);
            PG8_WAIT_L(8); PG8_BAR; PG8_WAIT_L(0); PG8_MMA(0, 0, At, B0); PG8_BAR; PG8_SCHED;
            PG8_LDB(B1, 1, 1); PG8_STAGE(PG8_SB(1, 0), b3, voffB);
            PG8_BAR; PG8_WAIT_L(0); PG8_MMA(0, 1, At, B1); PG8_BAR;
            PG8_LDA(At, 1, 1); PG8_STAGE(PG8_SA(1, 0), a3, voffA);
            PG8_BAR; PG8_WAIT_L(0); PG8_MMA(1, 0, At, B0); PG8_BAR; PG8_SCHED;
            PG8_STAGE(PG8_SB(1, 1), b3 + hstep, voffB);
            PG8_WAIT_V(6); PG8_BAR; PG8_MMA(1, 1, At, B1); PG8_BAR;
            }
        }
        if constexpr (ALIGN_EPI) { if (wr == 0) PG8_BAR; }
        if constexpr (!Epi::AFTER_DRAIN) { E(acc, cur, wr, wc, fr, fq); S.done(cur); }
        if (!has_next) break;
#pragma unroll
        for (int a = 0; a < 2; ++a)
#pragma unroll
            for (int b = 0; b < 2; ++b)
#pragma unroll
                for (int m = 0; m < 4; ++m)
#pragma unroll
                    for (int n = 0; n < 2; ++n) acc[a][b][m][n] = (f32x4){0.f, 0.f, 0.f, 0.f};
        cur = nxt; cA = nA; cB = nB; ++ui;
        if constexpr (ALIGN_EPI) { if (wr == 1) PG8_BAR; }
    }
    PG8_WAIT_V(0);
    if constexpr (!ALIGN_EPI) { if (wr == 0) PG8_BAR; }
    PG8_BAR;
#undef PG8_SA
#undef PG8_SB
#undef PG8_STAGE
#undef PG8_LDA
#undef PG8_LDB
#undef PG8_MMA
#undef PG8_WAIT_V
#undef PG8_WAIT_L
#undef PG8_BAR
#undef PG8_SCHED
}
}

constexpr int NWAVES = 8;
constexpr int NB = 16, SEQ = 2048, D = 1024, NTOK = NB * SEQ, NCTX = NB * 256, NTT = NTOK + NCTX;
constexpr int N_PHASES = 16;
constexpr int N_LAUNCHES = MK_N_LAUNCHES;
static_assert(N_LAUNCHES == 1 || N_LAUNCHES == N_PHASES, "one launch, or one launch per phase");

constexpr size_t MiB = 1u << 20;
constexpr size_t WS_CTL = 0, CTL_ZERO_BYTES = 64 * 1024;
constexpr size_t WS_MOD = 1 * MiB;
constexpr size_t WS_WIN_T = 2 * MiB;
constexpr size_t WS_WOUT_T = 6 * MiB;
constexpr size_t WS_CVIN_T = 9 * MiB;
constexpr size_t WS_CVOUT_T = 15 * MiB;
constexpr size_t WS_WQ_T = 17 * MiB;
constexpr size_t WS_KEYS = 25 * MiB;
constexpr size_t WS_DFT = 28 * MiB;
constexpr size_t WS_TAB = 48 * MiB;
constexpr size_t WS_TSC = 96 * MiB;
constexpr size_t WS_HQ = 112 * MiB;
constexpr size_t WS_HS = 144 * MiB;
constexpr size_t WS_H = 176 * MiB;
constexpr size_t WS_R = 248 * MiB;
constexpr size_t WS_QK = WS_R;
constexpr size_t WS_VT = WS_R + 72 * MiB;
constexpr size_t WS_VTC = WS_R + 104 * MiB;
constexpr size_t WS_FT = WS_R + 108 * MiB;
constexpr size_t WS_A2 = WS_R + 140 * MiB;
constexpr size_t WS_PQ = WS_R;
constexpr size_t WS_SELE = WS_R + 128 * MiB;
constexpr size_t WS_SELG = WS_R + 144 * MiB;
constexpr size_t WS_HQ8 = WS_R + 160 * MiB;
constexpr size_t WS_BCV = WS_R;
constexpr size_t WS_SET = WS_R + 240 * MiB;
constexpr size_t WS_END = 512 * MiB;
static_assert(WS_A2 + (size_t)NTOK * 1536 * 2 <= WS_END, "ws map");
constexpr int CW_BAR = 4096;
constexpr int CW_COLMAX = 8192;

constexpr int RING_OFF = 0, RING_BYTES = 131072;
constexpr int LDSCTL_OFF = RING_BYTES, MISC_OFF = LDSCTL_OFF + 320;
constexpr int LDS_BYTES = 163840;

#define LDS_WAIT() asm volatile("s_waitcnt lgkmcnt(0)" ::: "memory")

__device__ __forceinline__ unsigned cvt_pk(float lo, float hi) { return pg8::cvt_pk_bf16(lo, hi); }
__device__ __forceinline__ float bf_lo(unsigned u) { return __uint_as_float(u << 16); }
__device__ __forceinline__ float bf_hi(unsigned u) { return __uint_as_float(u & 0xffff0000u); }

#define XB_TMO      128
#define XB_XCNT(j)  (256  + 64 * (j))
#define XB_XSUB(j)  (1280 + 64 * (j))
#define XB_XGEN(j)  (2304 + 64 * (j))
#define XB_TOP      3328
#define XB_TOPGEN   3392
#define XCD_BAR_WORDS 3456
#define XB_SPIN_CAP (1u << 22)
__device__ __forceinline__ unsigned xb_ld(unsigned* p)              { return __hip_atomic_load(p, __ATOMIC_RELAXED, __HIP_MEMORY_SCOPE_AGENT); }
__device__ __forceinline__ unsigned xb_add(unsigned* p, unsigned v) { return __hip_atomic_fetch_add(p, v, __ATOMIC_RELAXED, __HIP_MEMORY_SCOPE_AGENT); }
__device__ __forceinline__ unsigned xb_xcc_id() { return (unsigned)__builtin_amdgcn_s_getreg((3 << 11) | 20) & 0xFu; }
#define XB_SPIN(cond, bar) do { unsigned _sp = 0; while (cond) { __builtin_amdgcn_s_sleep(1); \
    if ((++_sp & 255u) == 0u) { if (xb_ld(&(bar)[XB_TMO])) break; if (_sp > XB_SPIN_CAP) { atomicAdd(&(bar)[XB_TMO], 1u); break; } } } } while (0)
struct XcdBarrier { unsigned* bar; unsigned x; volatile LAS unsigned* st; };
__device__ __forceinline__ XcdBarrier xcd_barrier_post(unsigned* bar, volatile LAS unsigned* st) {
    XcdBarrier b; b.bar = bar; b.x = xb_xcc_id(); b.st = st;
    if (threadIdx.x == 0) (void)xb_add(&bar[XB_XCNT(b.x)], 1u);
    return b;
}
__device__ __forceinline__ void xcd_barrier_complete(unsigned* bar, unsigned x, unsigned& nloc, unsigned& nx) {
    const unsigned G = gridDim.x * gridDim.y * gridDim.z;
    unsigned sum, cnt, mine, sp = 0u;
    for (;;) {
        sum = 0u; cnt = 0u; mine = 0u;
#pragma unroll
        for (unsigned j = 0; j < 16; ++j) { const unsigned c = xb_ld(&bar[XB_XCNT(j)]); sum += c; cnt += (c > 0u) ? 1u : 0u; mine = (j == x) ? c : mine; }
        if (sum == G) break;
        __builtin_amdgcn_s_sleep(1);
        if ((++sp & 255u) == 0u) { if (xb_ld(&bar[XB_TMO])) break; if (sp > XB_SPIN_CAP) { atomicAdd(&bar[XB_TMO], 1u); break; } }
    }
    nloc = mine > 0u ? mine : 1u; nx = cnt > 0u ? cnt : 1u;
}
__device__ __forceinline__ void xcd_barrier(const XcdBarrier& b) {
    asm volatile("s_waitcnt vmcnt(0)" ::: "memory");
    __syncthreads();
    if (threadIdx.x == 0) {
        unsigned* bar = b.bar;
        __builtin_amdgcn_s_waitcnt(0);
        unsigned nloc = b.st[0], nx = b.st[1];
        if (nloc == 0u) { xcd_barrier_complete(bar, b.x, nloc, nx); b.st[0] = nloc; b.st[1] = nx; }
        const unsigned old = xb_add(&bar[XB_XSUB(b.x)], 1u);
        const unsigned gen = old / nloc;
        if (old + 1u == (gen + 1u) * nloc) {
            __builtin_amdgcn_fence(__ATOMIC_RELEASE, "agent");
            asm volatile("s_waitcnt vmcnt(0)" ::: "memory");
            const unsigned og = xb_add(&bar[XB_TOP], 1u);
            const unsigned tg = og / nx;
            if (og + 1u == (tg + 1u) * nx) xb_add(&bar[XB_TOPGEN], 1u);
            else XB_SPIN(xb_ld(&bar[XB_TOPGEN]) == tg, bar);
            __builtin_amdgcn_fence(__ATOMIC_ACQUIRE, "agent");
            xb_add(&bar[XB_XGEN(b.x)], 1u);
            asm volatile("s_waitcnt vmcnt(0)" ::: "memory");
        } else {
            XB_SPIN(xb_ld(&bar[XB_XGEN(b.x)]) == gen, bar);
            __builtin_amdgcn_fence(__ATOMIC_ACQUIRE, "agent");
            asm volatile("s_waitcnt vmcnt(0)" ::: "memory");
        }
    }
    __syncthreads();
}

__device__ __forceinline__ float wave_sum(float v) {
#pragma unroll
    for (int o = 1; o < 64; o <<= 1) v += __shfl_xor(v, o);
    return v;
}

__device__ __forceinline__ void p0_transpose_item(const float* W, int N, bf16* WT, int ldt, LAS float* scr, int item, int lane, bool cvmap = false) {
    const int nblk = N / 32, kb = item / nblk, nb = item % nblk, k0 = 64 * kb, n0 = 32 * nb;
    int n0m = n0; if (cvmap && n0 >= 1024) { const int isv = n0 >= 2048, d = n0 - (isv ? 2048 : 1024); n0m = 1024 + 256 * (d >> 7) + 128 * isv + (d & 127); }
#pragma unroll 8
    for (int i = 0; i < 32; ++i) { const int kk = 2 * i + (lane >> 5); scr[kk * 33 + (lane & 31)] = W[(size_t)(k0 + kk) * N + n0 + (lane & 31)]; }
    LDS_WAIT(); asm volatile("" ::: "memory");
    const int c = lane & 7;
#pragma unroll
    for (int j = 0; j < 4; ++j) { const int n = (lane >> 3) + 8 * j; const LAS float* s = scr + (8 * c) * 33 + n;
        u32x4 o; o.x = cvt_pk(s[0 * 33], s[1 * 33]); o.y = cvt_pk(s[2 * 33], s[3 * 33]); o.z = cvt_pk(s[4 * 33], s[5 * 33]); o.w = cvt_pk(s[6 * 33], s[7 * 33]);
        *(u32x4*)(WT + (size_t)(n0m + n) * ldt + k0 + 8 * c) = o; }
    LDS_WAIT(); asm volatile("" ::: "memory");
}

__device__ __forceinline__ void adaln_item(const float* c, const float* cctx, const float* ada_w, const float* ada_b, float* mods, LAS float* lds, int u) {
    const int i = u / 96, n0 = (u % 96) * 64;
    LAS float* sc = lds;
    LAS float* red = lds + 17 * 1024;
    const int tid = threadIdx.x, lane = tid & 63, w = tid >> 6, kq = lane >> 4, cg = lane & 15;
    const int kb = w * 128 + kq * 32;
    const float* wp = ada_w + (size_t)i * 1024 * 6144 + (size_t)kb * 6144 + n0 + cg * 4;
    f32x4 wv[32];
#pragma unroll
    for (int j = 0; j < 32; ++j) wv[j] = *(const f32x4*)(wp + (size_t)j * 6144);
#pragma unroll 1
    for (int q0 = 0; q0 < 34; q0 += 17) { float cv[17];
#pragma unroll
      for (int q = 0; q < 17; ++q) { const int e = tid + 512 * (q0 + q); cv[q] = e < 16 * 1024 ? c[e] : cctx[e - 16 * 1024]; }
#pragma unroll
      for (int q = 0; q < 17; ++q) sc[tid + 512 * (q0 + q)] = cv[q] / (1.f + __expf(-cv[q])); }
    __syncthreads();
    f32x4 acc[17];
#pragma unroll
    for (int r = 0; r < 17; ++r) acc[r] = (f32x4){0.f, 0.f, 0.f, 0.f};
#pragma unroll
    for (int k0 = 0; k0 < 32; k0 += 8) {
#pragma unroll
        for (int r = 0; r < 17; ++r) {
            const f32x4 s0 = *(const LAS f32x4*)(sc + r * 1024 + kb + k0), s1 = *(const LAS f32x4*)(sc + r * 1024 + kb + k0 + 4);
            acc[r] += wv[k0 + 0] * s0.x; acc[r] += wv[k0 + 1] * s0.y; acc[r] += wv[k0 + 2] * s0.z; acc[r] += wv[k0 + 3] * s0.w;
            acc[r] += wv[k0 + 4] * s1.x; acc[r] += wv[k0 + 5] * s1.y; acc[r] += wv[k0 + 6] * s1.z; acc[r] += wv[k0 + 7] * s1.w;
        }
    }
#pragma unroll
    for (int r = 0; r < 17; ++r)
#pragma unroll
        for (int j = 0; j < 4; ++j) { float v = acc[r][j]; v += __shfl_xor(v, 16); v += __shfl_xor(v, 32); acc[r][j] = v; }
    if (kq == 0) {
#pragma unroll
        for (int r = 0; r < 17; ++r) *(LAS f32x4*)(red + (w * 17 + r) * 64 + cg * 4) = acc[r];
    }
    __syncthreads();
    for (int e = tid; e < 17 * 64; e += 512) { const int r = e >> 6, l = e & 63; float s = ada_b[i * 6144 + n0 + l];
#pragma unroll
        for (int g2 = 0; g2 < 8; ++g2) s += red[(g2 * 17 + r) * 64 + l];
        mods[(size_t)(i * 17 + r) * 6144 + n0 + l] = s; }
    __syncthreads();
}

__device__ __forceinline__ void wprime_item(const float* fn_w, const float* w_out, bf16* WOUT_T, LAS float* lds, int item) {
    const int g = item >> 4, n0 = (item & 15) * 64;
    LAS float* U = lds;
    LAS float* ctab = lds + 4096;
    const int tid = threadIdx.x, np = tid & 63, lg = __builtin_amdgcn_readfirstlane(tid >> 6);
    LAS float* FW = lds + 4096 + 64;
    if (tid < 64) ctab[tid] = cospif((float)tid * (1.f / 32.f));
    {
        float wv[64];
#pragma unroll
        for (int e = 0; e < 64; ++e) wv[e] = w_out[(size_t)(512 + 64 * g + e) * 1024 + n0 + np];
        { const f32x4* fp = (const f32x4*)(fn_w + (size_t)g * 4096) + tid * 2; const f32x4 f0 = fp[0], f1 = fp[1]; *(LAS f32x4*)(FW + tid * 8) = f0; *(LAS f32x4*)(FW + tid * 8 + 4) = f1; }
        __syncthreads();
#pragma unroll 2
        for (int l = lg * 8; l < lg * 8 + 8; ++l) { float s = 0.f; const LAS float* fr = FW + l * 64;
#pragma unroll
            for (int e4 = 0; e4 < 16; ++e4) { const f32x4 f = *(const LAS f32x4*)(fr + 4 * e4); s += f.x * wv[4 * e4] + f.y * wv[4 * e4 + 1] + f.z * wv[4 * e4 + 2] + f.w * wv[4 * e4 + 3]; }
            U[l * 64 + np] = s; }
    }
    __syncthreads();
    const float sN = 0.0027621358640099515f;
    const int n4 = tid & 15, rg = tid >> 4;
    f32x4 acc[4];
#pragma unroll
    for (int q = 0; q < 4; ++q) acc[q] = (f32x4){0.f, 0.f, 0.f, 0.f};
#pragma unroll 4
    for (int l = 0; l < 64; ++l) { const f32x4 uv = *(const LAS f32x4*)(U + l * 64 + n4 * 4);
#pragma unroll
        for (int q = 0; q < 4; ++q) { const int row = rg * 4 + q, part = row >> 6, cch = row & 63, m = (l * cch) & 63; acc[q] += uv * ctab[part ? ((m - 16) & 63) : m]; } }
#pragma unroll
    for (int q = 0; q < 4; ++q) { const int row = rg * 4 + q, part = row >> 6, cch = row & 63; const float sg = part ? -sN : sN;
#pragma unroll
        for (int j = 0; j < 4; ++j) WOUT_T[(size_t)(n0 + n4 * 4 + j) * 1536 + 512 + part * 512 + g * 64 + cch] = (bf16)(cvt_pk(acc[q][j] * sg, 0.f) & 0xffffu); }
    __syncthreads();
}

struct Args { const float* in[20]; float* out; unsigned char* ws; int ph_lo, ph_hi, li, pad; };

constexpr int CW_TABQ = 64;
__device__ __forceinline__ void phase_prep(const Args& a, LAS unsigned char* lds, int G, int wg, int rep, int part) {
#define PSUB(k) (rep == 0 || PROBE_SUB == 0 || PROBE_SUB == (k))
    const int tid = threadIdx.x, lane = tid & 63, wave = __builtin_amdgcn_readfirstlane(tid >> 6);
    unsigned char* ws = a.ws;
    if (PSUB(1) && part == 0) for (int u = wg; u < 192; u += G) adaln_item(a.in[1], a.in[3], a.in[4], a.in[5], (float*)(ws + WS_MOD), (LAS float*)lds, u);
    if (PSUB(1) && part == 0) for (int u = G - 1 - wg; u < 128; u += G) wprime_item(a.in[12], a.in[10], (bf16*)(ws + WS_WOUT_T), (LAS float*)lds, u);
    if (PSUB(2)) {
        LAS float* scr = (LAS float*)(lds + wave * 16384);
        const int gw = ((wg + G / 2) % G) * NWAVES + wave, NGW = G * NWAVES;
        constexpr int I_WIN = 16 * 64, I_WO = 8 * 32, I_CVI = 16 * 96, I_CVO = 16 * 32, I_WQ = 16 * 64;
        constexpr int NIT = I_WIN + I_WO + I_CVI + I_CVO + 2 * I_WQ;
        for (int it = gw; it < NIT; it += NGW) {
            if ((part == 0) != (it >= I_WIN + I_WO + I_CVI + I_CVO)) continue;
            int r = it;
            if (r < I_WIN) { p0_transpose_item(a.in[9], 2048, (bf16*)(ws + WS_WIN_T), 1024, scr, r, lane); continue; } r -= I_WIN;
            if (r < I_WO) { p0_transpose_item(a.in[10], 1024, (bf16*)(ws + WS_WOUT_T), 1536, scr, r, lane); continue; } r -= I_WO;
            if (r < I_CVI) { p0_transpose_item(a.in[13], 3072, (bf16*)(ws + WS_CVIN_T), 1024, scr, r, lane, true); continue; } r -= I_CVI;
            if (r < I_CVO) { p0_transpose_item(a.in[15], 1024, (bf16*)(ws + WS_CVOUT_T), 1024, scr, r, lane); continue; } r -= I_CVO;
            {
              const int L = r >= I_WQ ? 1 : 0, it2 = r - L * I_WQ, kb = it2 / 64, nb = it2 % 64;
              const float* wp = a.in[16] + ((size_t)L * 1024 + kb * 64 + (lane >> 5) * 32) * 2048 + nb * 32 + (lane & 31); float am = 0.f;
#pragma unroll 8
              for (int k = 0; k < 32; ++k) am = fmaxf(am, fabsf(wp[(size_t)k * 2048]));
              am = fmaxf(am, __shfl_xor(am, 32));
              if (lane < 32) atomicMax((unsigned*)(ws + WS_CTL) + CW_COLMAX + L * 2048 + nb * 32 + lane, __float_as_uint(am)); }
        }
    }
    __syncthreads();
    if (PSUB(3) && part == 1) {
        LAS float* tab = (LAS float*)lds;
        for (int m = tid; m < 2048; m += 512) tab[m] = cospif((float)m * (1.f / 1024.f));
        __syncthreads();
        bf16* DFT = (bf16*)(ws + WS_DFT);
        for (int item = wg * 512 + tid; item < 2048 * 256; item += G * 512) {
            const int kp = item >> 8, n0 = (item & 255) * 8, k = kp & 1023, sh = (kp >> 10) ? 512 : 0;
            float v[8];
#pragma unroll
            for (int j = 0; j < 8; ++j) v[j] = tab[(k * (n0 + j) - sh) & 2047];
            u32x4 o; o.x = cvt_pk(v[0], v[1]); o.y = cvt_pk(v[2], v[3]); o.z = cvt_pk(v[4], v[5]); o.w = cvt_pk(v[6], v[7]);
            *(u32x4*)(DFT + (size_t)kp * 2048 + n0) = o;
        }
    }
    if (PSUB(4) && part == 1) {
        const size_t gt = (size_t)wg * 512 + tid, NT = (size_t)G * 512;
        const f32x4* s = (const f32x4*)a.in[17]; u32x2* d = (u32x2*)(ws + WS_KEYS);
        for (size_t i = gt; i < (size_t)2 * 8 * 2 * 128 * 128 / 4; i += NT) { const f32x4 x = s[i]; u32x2 o; o.x = cvt_pk(x[0], x[1]); o.y = cvt_pk(x[2], x[3]); d[i] = o; }
    }
#undef PSUB
}

__device__ __forceinline__ void norm_rows4(const float* xrow, const float* g, const float* sh, const float* sc, bf16* orow, unsigned char* hq, unsigned char* hq8, float* hs, int lane) {
    f32x4 v[4][4];
#pragma unroll
    for (int q = 0; q < 4; ++q)
#pragma unroll
        for (int j = 0; j < 4; ++j) v[q][j] = ((const f32x4*)(xrow + q * 1024))[lane + 64 * j];
    f32x4 gsc[4], gsh[4];
#pragma unroll
    for (int j = 0; j < 4; ++j) { const f32x4 gg = ((const f32x4*)g)[lane + 64 * j], a = ((const f32x4*)sh)[lane + 64 * j], b = ((const f32x4*)sc)[lane + 64 * j]; gsc[j] = gg * (b + 1.0f); gsh[j] = a; }
    float s[4];
#pragma unroll
    for (int q = 0; q < 4; ++q) { s[q] = 0.f;
#pragma unroll
        for (int j = 0; j < 4; ++j) s[q] += (v[q][j].x * v[q][j].x + v[q][j].y * v[q][j].y) + (v[q][j].z * v[q][j].z + v[q][j].w * v[q][j].w); }
#pragma unroll
    for (int o = 1; o < 64; o <<= 1)
#pragma unroll
        for (int q = 0; q < 4; ++q) s[q] += __shfl_xor(s[q], o);
    float am[4];
#pragma unroll
    for (int q = 0; q < 4; ++q) { const float r = 1.0f / sqrtf(s[q] * (1.f / 1024.f) + 1e-6f); am[q] = 0.f;
#pragma unroll
        for (int j = 0; j < 4; ++j) { const f32x4 y = (v[q][j] * r) * gsc[j] + gsh[j]; v[q][j] = y;
            am[q] = fmaxf(am[q], fmaxf(fmaxf(fabsf(y.x), fabsf(y.y)), fmaxf(fabsf(y.z), fabsf(y.w))));
            if (orow) { u32x2 w; w.x = cvt_pk(y.x, y.y); w.y = cvt_pk(y.z, y.w); ((u32x2*)(orow + q * 1024))[lane + 64 * j] = w; } } }
    if (hq) {
#pragma unroll
        for (int o = 1; o < 64; o <<= 1)
#pragma unroll
            for (int q = 0; q < 4; ++q) am[q] = fmaxf(am[q], __shfl_xor(am[q], o));
        float qs[4];
#pragma unroll
        for (int q = 0; q < 4; ++q) { const float inv = am[q] > 0.f ? 119.0f / am[q] : 0.f; qs[q] = 0.f;
            unsigned char* hqr = hq + q * 1024; unsigned char* h8r = hq8 + q * 1024;
#pragma unroll
            for (int j = 0; j < 4; ++j) { unsigned whi = 0u, wlo = 0u, w8 = 0u;
#pragma unroll
                for (int z = 0; z < 4; ++z) { const int q8 = (int)rintf(v[q][j][z] * inv); const int hi = (q8 + 8) >> 4, lo = q8 - 16 * hi; qs[q] += (float)q8;
                    whi |= ((unsigned)hi & 15u) << (4 * z); wlo |= ((unsigned)lo & 15u) << (4 * z); w8 |= ((unsigned)q8 & 255u) << (8 * z); }
                ((unsigned short*)hqr)[lane + 64 * j] = (unsigned short)whi; ((unsigned short*)(hqr + 512))[lane + 64 * j] = (unsigned short)wlo; ((unsigned*)h8r)[lane + 64 * j] = w8; } }
#pragma unroll
        for (int o = 1; o < 64; o <<= 1)
#pragma unroll
            for (int q = 0; q < 4; ++q) qs[q] += __shfl_xor(qs[q], o);
        if (lane == 0) {
#pragma unroll
            for (int q = 0; q < 4; ++q) { hs[2 * q] = am[q] * (1.0f / 119.0f); hs[2 * q + 1] = qs[q]; } }
    }
}
__device__ __forceinline__ void phase_norm(const float* xsrc, const float* ctx, const float* gvec, const float* modsL, int c0, bf16* H, unsigned char* HQ, unsigned char* HQ8, float* HS, int G, int wg) {
    const int lane = threadIdx.x & 63, wave = __builtin_amdgcn_readfirstlane(threadIdx.x >> 6);
    const int gw = wg * NWAVES + wave, NGW = G * NWAVES;
    const int nrows = ctx ? NTT : NTOK;
#pragma unroll 1
    for (int m = 4 * gw; m < nrows; m += 4 * NGW) {
        const float* xr; int mr;
        if (m < NTOK) { xr = xsrc + (size_t)m * D; mr = m >> 11; } else { xr = ctx + (size_t)(m - NTOK) * D; mr = 16; }
        const float* mp = modsL + (size_t)mr * 6144 + c0 * 1024;
        norm_rows4(xr, gvec, mp, mp + 1024, H ? H + (size_t)m * D : nullptr, HQ ? HQ + (size_t)m * 1024 : nullptr, HQ8 + (size_t)m * 1024, HS + 2 * (size_t)m, lane);
    }
}

__device__ __forceinline__ void wq8_transpose_item(const float* W, const float* colmax, unsigned char* WT8, LAS float* scr, int item, int lane) {
    const int kb = item / 64, nb = item % 64, k0 = 64 * kb, n0 = 32 * nb;
#pragma unroll 8
    for (int i = 0; i < 32; ++i) { const int kk = 2 * i + (lane >> 5); scr[kk * 33 + (lane & 31)] = W[(size_t)(k0 + kk) * 2048 + n0 + (lane & 31)]; }
    LDS_WAIT(); asm volatile("" ::: "memory");
    const int c = lane & 7;
#pragma unroll
    for (int j = 0; j < 4; ++j) { const int n = (lane >> 3) + 8 * j; const LAS float* sp = scr + (8 * c) * 33 + n;
        const float cm = colmax[n0 + n], inv = cm > 0.f ? 127.0f / cm : 0.f;
        unsigned w0 = 0u, w1 = 0u;
#pragma unroll
        for (int z = 0; z < 4; ++z) { w0 |= ((unsigned)(int)rintf(sp[z * 33] * inv) & 255u) << (8 * z); w1 |= ((unsigned)(int)rintf(sp[(4 + z) * 33] * inv) & 255u) << (8 * z); }
        u32x2 o; o.x = w0; o.y = w1;
        *(u32x2*)(WT8 + (size_t)(n0 + n) * 1024 + k0 + 8 * c) = o; }
    LDS_WAIT(); asm volatile("" ::: "memory");
}
__device__ __forceinline__ void phase_wq8(const float* wq, const float* colmax, unsigned char* WQ8, LAS unsigned char* lds, int G, int wg) {
    const int lane = threadIdx.x & 63, wave = __builtin_amdgcn_readfirstlane(threadIdx.x >> 6);
    LAS float* scr = (LAS float*)(lds + wave * 16384);
    for (int it = wg * NWAVES + wave; it < 2 * 1024; it += G * NWAVES) { const int L = it >> 10;
        wq8_transpose_item(wq + (size_t)L * 1024 * 2048, colmax + L * 2048, WQ8 + (size_t)L * 2048 * 1024, scr, it & 1023, lane); }
}

typedef float f32x16 __attribute__((ext_vector_type(16)));
struct AttnRaw { u32x4 k[4]; u32x4 v[4]; };
constexpr int ATT_KPITCH = 144, ATT_VPITCH = 72, ATT_WAVE_LDS = 32 * ATT_KPITCH + 64 * ATT_VPITCH;
__device__ __forceinline__ void na_load_raw(AttnRaw& f, const bf16* QK, const bf16* VT, const bf16* VTC, int b, int h, int t, int nrows, int sr0, int c32, int lane) {
    const bf16* kp; const bf16* vp; size_t vpitch;
    if (t < nrows) { const int kr = sr0 + t;
        kp = QK + ((size_t)b * 2048 + kr * 64 + c32 + (lane >> 3)) * 1024 + 512 + h * 64 + (lane & 7) * 8;
        vp = VT + (size_t)(b * 512 + h * 64 + (lane >> 2)) * 2048 + kr * 64 + c32 + (lane & 3) * 8; vpitch = 2048; }
    else { const int u = t - nrows;
        kp = QK + ((size_t)NTOK + b * 256 + 32 * u + (lane >> 3)) * 1024 + 512 + h * 64 + (lane & 7) * 8;
        vp = VTC + (size_t)(b * 512 + h * 64 + (lane >> 2)) * 256 + 32 * u + (lane & 3) * 8; vpitch = 256; }
#pragma unroll
    for (int q = 0; q < 4; ++q) { f.k[q] = *(const u32x4*)(kp + (size_t)q * 8 * 1024); f.v[q] = *(const u32x4*)(vp + (size_t)q * 16 * vpitch); }
}
__device__ __forceinline__ void na_stage(const AttnRaw& f, LAS unsigned char* kl, LAS unsigned char* vl, int lane) {
#pragma unroll
    for (int q = 0; q < 4; ++q) {
        *(LAS u32x4*)(kl + (8 * q + (lane >> 3)) * ATT_KPITCH + (lane & 7) * 16) = f.k[q];
        LAS unsigned char* vd = vl + (16 * q + (lane >> 2)) * ATT_VPITCH + (lane & 3) * 16;
        u32x2 lo, hi2; lo.x = f.v[q].x; lo.y = f.v[q].y; hi2.x = f.v[q].z; hi2.y = f.v[q].w;
        *(LAS u32x2*)vd = lo; *(LAS u32x2*)(vd + 8) = hi2;
    }
}
__device__ __forceinline__ void na_attn32_wave(const bf16* QK, const bf16* VT, const bf16* VTC, const LAS float* rpl, LAS unsigned char* wl, bf16* A2, int b, int h, int r0, int qb, int lane) {
    const int j = lane & 31, hi = lane >> 5;
    const int c0 = qb * 16;
    const int c32 = qb == 0 ? 0 : (qb == 1 ? 8 : (qb == 2 ? 24 : 32));
    const int qrow = r0 + (j >> 4), cq = c0 + (j & 15);
    const int srq = min(max(qrow - 4, 0), 24), cs = min(max(cq - 8, 0), 48);
    const int sr0 = min(max(r0 - 4, 0), 24), sr1 = min(max(r0 - 3, 0), 24);
    const int nrows = sr1 + 8 - sr0, ntiles = nrows + 8;
    const size_t tq = (size_t)b * 2048 + qrow * 64 + cq;
    LAS unsigned char* kl = wl; LAS unsigned char* vl = wl + 32 * ATT_KPITCH;
    bf16x8 qf[4];
#pragma unroll
    for (int ks = 0; ks < 4; ++ks) qf[ks] = *(const bf16x8*)(QK + tq * 1024 + h * 64 + 16 * ks + 8 * hi);
    f32x16 o0, o1;
#pragma unroll
    for (int v = 0; v < 16; ++v) { o0[v] = 0.f; o1[v] = 0.f; }
    float m_run = -1e30f, l_run = 0.f;
    AttnRaw raw;
    na_load_raw(raw, QK, VT, VTC, b, h, 0, nrows, sr0, c32, lane);
#pragma unroll 2
    for (int t = 0; t < ntiles; ++t) {
        na_stage(raw, kl, vl, lane);
        if (t + 1 < ntiles) na_load_raw(raw, QK, VT, VTC, b, h, t + 1, nrows, sr0, c32, lane);
        f32x16 sv;
#pragma unroll
        for (int v = 0; v < 16; ++v) sv[v] = 0.f;
#pragma unroll
        for (int ks = 0; ks < 4; ++ks) { const bf16x8 kf = *(const LAS bf16x8*)(kl + j * ATT_KPITCH + (2 * ks + hi) * 16);
            sv = __builtin_amdgcn_mfma_f32_32x32x16_bf16(kf, qf[ks], sv, 0, 0, 0); }
        if (t < nrows) {
            const int kr = sr0 + t;
            const bool rok = (kr >= srq) && (kr < srq + 8);
            const LAS float* rrow = rpl + min(max(kr - qrow + 7, 0), 14) * 31;
#pragma unroll
            for (int v = 0; v < 16; ++v) { const int kc = c32 + 8 * (v >> 2) + 4 * hi + (v & 3); const bool ok = rok && (kc >= cs) && (kc < cs + 16);
                const float bias = rrow[min(max(kc - cq + 15, 0), 30)];
                sv[v] = ok ? sv[v] + bias : -INFINITY; }
        }
        float mx = sv[0];
#pragma unroll
        for (int v = 1; v < 16; ++v) mx = fmaxf(mx, sv[v]);
        mx = fmaxf(mx, __shfl_xor(mx, 32));
        const float m_new = fmaxf(m_run, mx);
        const float alpha = __expf(m_run - m_new);
        float ps = 0.f;
#pragma unroll
        for (int v = 0; v < 16; ++v) { const float p = __expf(sv[v] - m_new); sv[v] = p; ps += p; }
        l_run = l_run * alpha + ps; m_run = m_new;
#pragma unroll
        for (int v = 0; v < 16; ++v) { o0[v] *= alpha; o1[v] *= alpha; }
#pragma unroll
        for (int st = 0; st < 2; ++st) {
            u32x4 pw; pw.x = cvt_pk(sv[8 * st], sv[8 * st + 1]); pw.y = cvt_pk(sv[8 * st + 2], sv[8 * st + 3]); pw.z = cvt_pk(sv[8 * st + 4], sv[8 * st + 5]); pw.w = cvt_pk(sv[8 * st + 6], sv[8 * st + 7]);
            const bf16x8 pf = __builtin_bit_cast(bf16x8, pw);
#pragma unroll
            for (int dt = 0; dt < 2; ++dt) {
                const LAS unsigned char* vr = vl + (32 * dt + j) * ATT_VPITCH + 32 * st + 8 * hi;
                const u32x2 lo = *(const LAS u32x2*)vr, h2 = *(const LAS u32x2*)(vr + 16);
                u32x4 vw; vw.x = lo.x; vw.y = lo.y; vw.z = h2.x; vw.w = h2.y;
                if (dt == 0) o0 = __builtin_amdgcn_mfma_f32_32x32x16_bf16(__builtin_bit_cast(bf16x8, vw), pf, o0, 0, 0, 0);
                else o1 = __builtin_amdgcn_mfma_f32_32x32x16_bf16(__builtin_bit_cast(bf16x8, vw), pf, o1, 0, 0, 0);
            }
        }
    }
    l_run += __shfl_xor(l_run, 32);
    const float inv = 1.0f / l_run;
    bf16* orow = A2 + tq * 1536 + h * 64 + 4 * hi;
#pragma unroll
    for (int g = 0; g < 4; ++g) {
        u32x2 w; w.x = cvt_pk(o0[4 * g] * inv, o0[4 * g + 1] * inv); w.y = cvt_pk(o0[4 * g + 2] * inv, o0[4 * g + 3] * inv); *(u32x2*)(orow + 8 * g) = w;
        w.x = cvt_pk(o1[4 * g] * inv, o1[4 * g + 1] * inv); w.y = cvt_pk(o1[4 * g + 2] * inv, o1[4 * g + 3] * inv); *(u32x2*)(orow + 32 + 8 * g) = w;
    }
}

__device__ __forceinline__ int f2key(float f) { const int b = (int)__float_as_uint(f); return b ^ ((b >> 31) & 0x7fffffff); }
__device__ __forceinline__ float key2f(int k) { return __uint_as_float((unsigned)(k ^ ((k >> 31) & 0x7fffffff))); }
__device__ __forceinline__ void ce_desc(int& a, int& b) { const int t = max(a, b); b = min(a, b); a = t; }
template <int N> __device__ __forceinline__ void bitonic_sort_desc(int (&v)[N]) {
#pragma unroll
    for (int k = 2; k <= N; k <<= 1) {
#pragma unroll
        for (int j = k >> 1; j > 0; j >>= 1) {
#pragma unroll
            for (int i = 0; i < N; ++i) { const int l = i ^ j; if (l > i) { if ((i & k) == 0) ce_desc(v[i], v[l]); else ce_desc(v[l], v[i]); } }
        }
    }
}
template <int N> __device__ __forceinline__ void bitonic_merge_desc(int (&v)[N]) {
#pragma unroll
    for (int j = N >> 1; j > 0; j >>= 1) {
#pragma unroll
        for (int i = 0; i < N; ++i) { const int l = i ^ j; if (l > i) ce_desc(v[i], v[l]); }
    }
}
constexpr int TOPK_LDS_PER_WAVE = 16 * 52 * 4;
constexpr int TOPK_KROW = 136;
__device__ __forceinline__ void peer_topk_wave(const bf16x8 (&qfa)[2][4], const LAS bf16* KL, int* sel_e, float* sel_g, int t0, int h, int lane, LAS int* scr) {
    const int fr = lane & 15, fq = lane >> 4;
    int top[2][16];
#pragma unroll
    for (int p = 0; p < 2; ++p) {
        int lo[16], hi[16];
#pragma unroll
        for (int t = 0; t < 8; ++t) {
            f32x4 av = (f32x4){0.f, 0.f, 0.f, 0.f};
#pragma unroll
            for (int ks = 0; ks < 4; ++ks) { const bf16x8 kf = *(const LAS bf16x8*)(KL + (p * 128 + t * 16 + fr) * TOPK_KROW + ks * 32 + fq * 8);
                av = __builtin_amdgcn_mfma_f32_16x16x32_bf16(kf, qfa[p][ks], av, 0, 0, 0); }
#pragma unroll
            for (int j = 0; j < 4; ++j) { const int n = 16 * t + 4 * fq + j; const int key = (f2key(av[j]) & ~127) | n;
                if (t < 4) lo[4 * t + j] = key; else hi[4 * (t - 4) + j] = key; }
        }
        bitonic_sort_desc<16>(lo); bitonic_sort_desc<16>(hi);
#pragma unroll
        for (int i = 0; i < 16; ++i) lo[i] = max(lo[i], hi[15 - i]);
        bitonic_merge_desc<16>(lo);
#pragma unroll
        for (int x = 16; x <= 32; x <<= 1) {
#pragma unroll
            for (int i = 0; i < 16; ++i) hi[i] = __shfl_xor(lo[15 - i], x);
#pragma unroll
            for (int i = 0; i < 16; ++i) lo[i] = max(lo[i], hi[i]);
            bitonic_merge_desc<16>(lo);
        }
#pragma unroll
        for (int i = 0; i < 16; ++i) top[p][i] = lo[i];
    }
    const bool b0 = (fq & 1) != 0, b1 = (fq & 2) != 0;
    const int gbase = b1 ? (b0 ? 42 : 29) : (b0 ? 16 : 0);
    LAS int* tb = scr + fr * 52;
    int g0[16];
    {
        constexpr signed char TI[4][16] = {{0,0,0,0,0,0,0,0,0,0,0,0,0,0,0,0}, {1,1,1,1,1,1,1,1,2,2,2,2,2,-1,-1,-1}, {3,3,3,3,4,4,4,5,5,6,6,7,7,-1,-1,-1}, {8,9,10,11,12,13,14,15,-1,-1,-1,-1,-1,-1,-1,-1}};
        constexpr signed char TJ[4][16] = {{0,1,2,3,4,5,6,7,8,9,10,11,12,13,14,15}, {0,1,2,3,4,5,6,7,0,1,2,3,4,-1,-1,-1}, {0,1,2,3,0,1,2,0,1,0,1,0,1,-1,-1,-1}, {0,0,0,0,0,0,0,0,-1,-1,-1,-1,-1,-1,-1,-1}};
#pragma unroll
        for (int sl = 0; sl < 16; ++sl) {
            const int ka0 = top[0][TI[0][sl]], ka1 = top[0][TI[1][sl] < 0 ? 0 : TI[1][sl]], ka2 = top[0][TI[2][sl] < 0 ? 0 : TI[2][sl]], ka3 = top[0][TI[3][sl] < 0 ? 0 : TI[3][sl]];
            const int kb0 = top[1][TJ[0][sl]], kb1 = top[1][TJ[1][sl] < 0 ? 0 : TJ[1][sl]], kb2 = top[1][TJ[2][sl] < 0 ? 0 : TJ[2][sl]], kb3 = top[1][TJ[3][sl] < 0 ? 0 : TJ[3][sl]];
            const int ka = b1 ? (b0 ? ka3 : ka2) : (b0 ? ka1 : ka0), kb = b1 ? (b0 ? kb3 : kb2) : (b0 ? kb1 : kb0);
            const bool pad = b1 ? (b0 ? (TI[3][sl] < 0) : (TI[2][sl] < 0)) : (b0 ? (TI[1][sl] < 0) : false);
            const int key = (f2key(key2f(ka) + key2f(kb)) & ~63) | (49 - gbase - sl);
            g0[sl] = pad ? (int)0x80000000 : key;
            tb[pad ? 51 : gbase + sl] = (ka & 127) * 128 + (kb & 127);
        }
    }
    bitonic_sort_desc<16>(g0);
#pragma unroll
    for (int x = 16; x <= 32; x <<= 1) {
        int hi2[16];
#pragma unroll
        for (int i = 0; i < 16; ++i) hi2[i] = __shfl_xor(g0[15 - i], x);
#pragma unroll
        for (int i = 0; i < 16; ++i) g0[i] = max(g0[i], hi2[i]);
        bitonic_merge_desc<16>(g0);
    }
    int kmax = g0[0];
#pragma unroll
    for (int i = 1; i < 16; ++i) kmax = max(kmax, g0[i]);
    const float mx = key2f(kmax);
    float wv[16]; float sum = 0.f;
#pragma unroll
    for (int i = 0; i < 16; ++i) { wv[i] = __expf(key2f(g0[i]) - mx); sum += wv[i]; }
    const float inv = 1.0f / sum;
    LDS_WAIT(); asm volatile("" ::: "memory");
    int we[16];
#pragma unroll
    for (int i = 0; i < 16; ++i) we[i] = tb[49 - (g0[i] & 63)];
    if (fq == 0) {
        int* ep = sel_e + ((size_t)(t0 + fr) * 8 + h) * 16; float* gp = sel_g + ((size_t)(t0 + fr) * 8 + h) * 16;
#pragma unroll
        for (int rd = 0; rd < 16; ++rd) { ep[rd] = we[rd]; gp[rd] = wv[rd] * inv; }
    }
    LDS_WAIT(); asm volatile("" ::: "memory");
}

__device__ __forceinline__ void phase_topk(LAS unsigned char* lds, const bf16* Q, const bf16* KEYS, int* sel_e, float* sel_g, const float* tdown, const float* tup, unsigned char* tab4, float* tsc, int G, int wg) {
    const int tid = threadIdx.x, lane = tid & 63, wave = __builtin_amdgcn_readfirstlane(tid >> 6), fr = lane & 15, fq = lane >> 4;
    LAS bf16* KL = (LAS bf16*)lds;
    LAS int* scr = (LAS int*)(lds + 2 * 128 * TOPK_KROW * 2 + wave * TOPK_LDS_PER_WAVE);
    const int nh = (G % 8 == 0) ? 1 : 8;
#pragma unroll 1
    for (int hh = 0; hh < nh; ++hh) {
        const int h = (nh == 1) ? (wg & 7) : hh;
        const int nwh = (nh == 1) ? (G >> 3) : G, wi = (nh == 1) ? (wg >> 3) : wg;
        __syncthreads();
        for (int p = tid; p < 4096; p += 512) { const int row = p >> 4, c16 = p & 15;
            *(LAS u32x4*)(KL + row * TOPK_KROW + c16 * 8) = *(const u32x4*)(KEYS + (size_t)(h * 256 + row) * 128 + c16 * 8); }
        __syncthreads();
        int b = wave * nwh + wi;
        bf16x8 qn[2][4];
        if (b < 2048) {
#pragma unroll
            for (int p = 0; p < 2; ++p)
#pragma unroll
                for (int ks = 0; ks < 4; ++ks) qn[p][ks] = *(const bf16x8*)(Q + (size_t)(b * 16 + fr) * 2048 + h * 256 + p * 128 + ks * 32 + fq * 8);
        }
        const int gw = wg * NWAVES + wave, NGW = G * NWAVES;
        int trow = (hh == 0) ? gw : 32768;
#define TOPK_ROW_PTR(R) ((const f32x4*)((((R) < 16384) ? tdown : tup) + (size_t)((R) & 16383) * 1024) + lane * 4)
#define TOPK_ROW_STORE(R, X) do { u32x2 pk; float scv; \
            if ((R) < 16384) {     \
                float ss = 0.f, am = 0.f; \
                _Pragma("unroll") for (int q = 0; q < 4; ++q) { ss += (X[q][0] * X[q][0] + X[q][1] * X[q][1]) + (X[q][2] * X[q][2] + X[q][3] * X[q][3]); \
                    am = fmaxf(am, fmaxf(fmaxf(fabsf(X[q][0]), fabsf(X[q][1])), fmaxf(fabsf(X[q][2]), fabsf(X[q][3])))); } \
                ss = wave_sum(ss); _Pragma("unroll") for (int o = 1; o < 64; o <<= 1) am = fmaxf(am, __shfl_xor(am, o)); \
                scv = fmaxf(0.35f * sqrtf(ss * (1.0f / 1024.0f)), am * (1.0f / 16.0f)); const float inv = scv > 0.f ? 1.0f / scv : 0.f; \
                unsigned w0 = 0u, w1 = 0u; \
                _Pragma("unroll") for (int q = 0; q < 4; ++q) _Pragma("unroll") for (int z = 0; z < 4; ++z) { \
                    const int cd = min(max((int)floorf(X[q][z] * inv), -8), 7); const unsigned nb = (unsigned)cd & 15u; \
                    if (q < 2) w0 |= nb << (4 * (4 * q + z)); else w1 |= nb << (4 * (4 * (q - 2) + z)); } \
                pk.x = w0; pk.y = w1; \
            } else {               \
                float am = 0.f; \
                _Pragma("unroll") for (int q = 0; q < 4; ++q) am = fmaxf(am, fmaxf(fmaxf(fabsf(X[q][0]), fabsf(X[q][1])), fmaxf(fabsf(X[q][2]), fabsf(X[q][3])))); \
                _Pragma("unroll") for (int o = 1; o < 64; o <<= 1) am = fmaxf(am, __shfl_xor(am, o)); \
                const float inv = am > 0.f ? 6.0f / am : 0.f; unsigned p0 = 0u, p1 = 0u; \
                p0 = __builtin_amdgcn_cvt_scalef32_pk_fp4_f32(p0, X[0][0] * inv, X[0][1] * inv, 1.0f, 0); p0 = __builtin_amdgcn_cvt_scalef32_pk_fp4_f32(p0, X[0][2] * inv, X[0][3] * inv, 1.0f, 1); \
                p0 = __builtin_amdgcn_cvt_scalef32_pk_fp4_f32(p0, X[1][0] * inv, X[1][1] * inv, 1.0f, 2); p0 = __builtin_amdgcn_cvt_scalef32_pk_fp4_f32(p0, X[1][2] * inv, X[1][3] * inv, 1.0f, 3); \
                p1 = __builtin_amdgcn_cvt_scalef32_pk_fp4_f32(p1, X[2][0] * inv, X[2][1] * inv, 1.0f, 0); p1 = __builtin_amdgcn_cvt_scalef32_pk_fp4_f32(p1, X[2][2] * inv, X[2][3] * inv, 1.0f, 1); \
                p1 = __builtin_amdgcn_cvt_scalef32_pk_fp4_f32(p1, X[3][0] * inv, X[3][1] * inv, 1.0f, 2); p1 = __builtin_amdgcn_cvt_scalef32_pk_fp4_f32(p1, X[3][2] * inv, X[3][3] * inv, 1.0f, 3); \
                pk.x = p0; pk.y = p1; scv = am * (1.0f / 6.0f); } \
            *((u32x2*)(tab4 + (((R) < 16384) ? (size_t)0 : (size_t)8 * MiB) + (size_t)(lane >> 4) * (2 * MiB) + (size_t)((R) & 16383) * 128) + (lane & 15)) = pk; \
            if (lane == 0) tsc[R] = scv; } while (0)
#pragma unroll 1
        for (; b < 2048; b += 8 * nwh) {
            f32x4 tx0[4], tx1[4]; const int ra = trow, rb = trow + NGW; const bool t0 = ra < 32768, t1 = rb < 32768;
            if (t0) { const f32x4* sp = TOPK_ROW_PTR(ra);
#pragma unroll
                for (int q = 0; q < 4; ++q) tx0[q] = sp[q]; }
            if (t1) { const f32x4* sp = TOPK_ROW_PTR(rb);
#pragma unroll
                for (int q = 0; q < 4; ++q) tx1[q] = sp[q]; }
            bf16x8 qc[2][4];
#pragma unroll
            for (int p = 0; p < 2; ++p)
#pragma unroll
                for (int ks = 0; ks < 4; ++ks) qc[p][ks] = qn[p][ks];
            const int bn = b + 8 * nwh;
            if (bn < 2048) {
#pragma unroll
                for (int p = 0; p < 2; ++p)
#pragma unroll
                    for (int ks = 0; ks < 4; ++ks) qn[p][ks] = *(const bf16x8*)(Q + (size_t)(bn * 16 + fr) * 2048 + h * 256 + p * 128 + ks * 32 + fq * 8);
            }
            peer_topk_wave(qc, KL, sel_e, sel_g, b * 16, h, lane, scr);
            if (t0) TOPK_ROW_STORE(ra, tx0);
            if (t1) TOPK_ROW_STORE(rb, tx1);
            trow += 2 * NGW;
        }
#pragma unroll 1
        for (; trow < 32768; trow += NGW) { f32x4 tx0[4]; const f32x4* sp = TOPK_ROW_PTR(trow);
#pragma unroll
            for (int q = 0; q < 4; ++q) tx0[q] = sp[q];
            TOPK_ROW_STORE(trow, tx0); }
#undef TOPK_ROW_PTR
#undef TOPK_ROW_STORE
    }
}

typedef float f32x2 __attribute__((ext_vector_type(2)));
template <int CTRL> __device__ __forceinline__ float dppf(float v) { return __uint_as_float((unsigned)__builtin_amdgcn_update_dpp(0, (int)__float_as_uint(v), CTRL, 0xf, 0xf, true)); }
typedef int i32x8 __attribute__((ext_vector_type(8)));
constexpr int GA_SE_OFF = 0, GA_AW_OFF = 32768;
constexpr int GA_IMG_OFF = 0, GA_IMG_WAVE = 16384;
constexpr int GA_WA_OFF = 131072 + 1024, GA_WS_OFF = GA_WA_OFF + 24576;
static_assert(GA_IMG_OFF + 8 * GA_IMG_WAVE <= LDSCTL_OFF && GA_WS_OFF + 512 <= LDS_BYTES, "gather LDS map");
typedef __amdgpu_buffer_rsrc_t brsrc_t;
__device__ __forceinline__ brsrc_t ga_rsrc(const unsigned char* tab) { return __builtin_amdgcn_make_buffer_rsrc((void*)tab, 0, 8 << 20, 0x00020000); }
__device__ __forceinline__ void ga_issue8(u32x4 (&rw)[8], brsrc_t tab, const LAS unsigned short* sep, unsigned so) {
#pragma unroll
    for (int i = 0; i < 8; ++i) { const unsigned e = sep[8 * i]; rw[i] = __builtin_amdgcn_raw_buffer_load_b128(tab, (int)((e << 7) + so), 0, 0); }
}
__device__ __forceinline__ void ga_down8(u32x4 (&rw)[8], const u32x4 hhi, const u32x4 hlo, LAS float* awp, bool c0, brsrc_t tab, const LAS unsigned short* sepn, unsigned son) {
    float d[8];
#pragma unroll
    for (int i = 0; i < 8; ++i) { int ahi = 0, alo = 0;
        const unsigned en = sepn[8 * i];
#pragma unroll
        for (int q = 0; q < 4; ++q) { ahi = __builtin_amdgcn_sdot8((int)rw[i][q], (int)hhi[q], ahi, false); alo = __builtin_amdgcn_sdot8((int)rw[i][q], (int)hlo[q], alo, false); }
        d[i] = (float)(ahi * 16 + alo);
        rw[i] = __builtin_amdgcn_raw_buffer_load_b128(tab, (int)((en << 7) + son), 0, 0);
        __builtin_amdgcn_sched_barrier(0); }
#pragma unroll
    for (int i = 0; i < 8; ++i) d[i] += dppf<0xB1>(d[i]);
#pragma unroll
    for (int i = 0; i < 8; ++i) d[i] += dppf<0x4E>(d[i]);
#pragma unroll
    for (int i = 0; i < 8; ++i) d[i] += dppf<0x141>(d[i]);
    if (c0) { float o[8];
#pragma unroll
        for (int i = 0; i < 8; ++i) o[i] = awp[8 * i];
#pragma unroll
        for (int i = 0; i < 8; ++i) awp[8 * i] = o[i] + d[i]; }
}
template <bool FINAL>
__device__ __forceinline__ void ga_norm16(float* xout, bf16* H, const float* ng, const float* modsN, const size_t t0, const int lane) {
    f32x4 gsc[4], gsh[4];
#pragma unroll
    for (int j = 0; j < 4; ++j) { const f32x4 gg = ((const f32x4*)ng)[lane + 64 * j];
        if (FINAL) { gsc[j] = gg; gsh[j] = (f32x4){0.f, 0.f, 0.f, 0.f}; }
        else { const float* mp = modsN + (size_t)(t0 >> 11) * 6144; const f32x4 a = ((const f32x4*)mp)[lane + 64 * j], b = ((const f32x4*)(mp + 1024))[lane + 64 * j]; gsc[j] = gg * (b + 1.0f); gsh[j] = a; } }
#pragma unroll 1
    for (int tg = 0; tg < 16; tg += 4) {
        f32x4 xv[4][4];
#pragma unroll
        for (int q = 0; q < 4; ++q)
#pragma unroll
            for (int j = 0; j < 4; ++j) xv[q][j] = ((const f32x4*)(xout + (t0 + tg + q) * 1024))[lane + 64 * j];
        float ss[4];
#pragma unroll
        for (int q = 0; q < 4; ++q) { ss[q] = 0.f;
#pragma unroll
            for (int j = 0; j < 4; ++j) ss[q] += (xv[q][j].x * xv[q][j].x + xv[q][j].y * xv[q][j].y) + (xv[q][j].z * xv[q][j].z + xv[q][j].w * xv[q][j].w); }
#pragma unroll
        for (int o = 1; o < 64; o <<= 1)
#pragma unroll
            for (int q = 0; q < 4; ++q) ss[q] += __shfl_xor(ss[q], o);
#pragma unroll
        for (int q = 0; q < 4; ++q) { const float rn = 1.0f / sqrtf(ss[q] * (1.f / 1024.f) + 1e-6f); const size_t t = t0 + tg + q;
            if (FINAL) {
#pragma unroll
                for (int j = 0; j < 4; ++j) ((f32x4*)(xout + t * 1024))[lane + 64 * j] = xv[q][j] * rn * gsc[j];
            } else { u32x2* o8 = (u32x2*)(H + t * 1024) + lane;
#pragma unroll
                for (int j = 0; j < 4; ++j) { const f32x4 y = (xv[q][j] * rn) * gsc[j] + gsh[j]; u32x2 w; w.x = cvt_pk(y.x, y.y); w.y = cvt_pk(y.z, y.w); o8[64 * j] = w; } } }
    }
}
template <bool FINAL>
__device__ __forceinline__ void phase_gather(LAS unsigned char* lds, bf16* H, const unsigned char* HQ, const float* HS, const int* sel_e, const float* sel_g, const unsigned char* down4, const unsigned char* up4, const float* sdown, const float* sup,
                                             const float* modsL, float* xout, const float* ng, const float* modsN, int G, int wg, int mode) {
    const bool dummy = (mode & 1) != 0;
    const int tid = threadIdx.x, lane = tid & 63, wave = __builtin_amdgcn_readfirstlane(tid >> 6);
    const int r = lane >> 3, c = lane & 7;
    LAS unsigned short* SE = (LAS unsigned short*)(lds + GA_SE_OFF);
    LAS float* AW = (LAS float*)(lds + GA_AW_OFF);
#pragma unroll 1
    for (int blk = wg; blk < NTOK / 128; blk += G) {
        const int tb = blk * 128;
        for (int i = tid; i < 128 * 128 / 4; i += 512) { typedef int i32x4 __attribute__((ext_vector_type(4))); const i32x4 e = ((const i32x4*)(sel_e + (size_t)tb * 128))[i];
            u32x2 w; w.x = (unsigned)e.x | ((unsigned)e.y << 16); w.y = (unsigned)e.z | ((unsigned)e.w << 16); ((LAS u32x2*)SE)[i] = w;
            ((LAS f32x4*)AW)[i] = (f32x4){0.f, 0.f, 0.f, 0.f}; }
        __syncthreads();
        const LAS unsigned short* sew = SE + wave * 2048 + r;
        LAS float* aww = AW + wave * 2048 + r;
        unsigned char* const setw = (unsigned char*)sel_e + (WS_SET - WS_SELE) + ((size_t)tb + wave * 16) * 256 + r * 16;
#pragma unroll
        for (int p = c; p < 32; p += 8) { const LAS unsigned short* sp = sew + (p >> 1) * 128 + 64 * (p & 1);
            u32x4 w; w.x = (unsigned)sp[0] | ((unsigned)sp[8] << 16); w.y = (unsigned)sp[16] | ((unsigned)sp[24] << 16); w.z = (unsigned)sp[32] | ((unsigned)sp[40] << 16); w.w = (unsigned)sp[48] | ((unsigned)sp[56] << 16);
            *(u32x4*)(setw + p * 128) = w; }
        if (!(mode & 4)) {
            u32x4 r0[8], r1[8]; u32x4 hn0, hn1;
            const brsrc_t rsd = ga_rsrc(down4);
            const unsigned char* hqw = HQ + ((size_t)tb + wave * 16) * 1024 + c * 16;
            ga_issue8(r0, rsd, sew, (unsigned)(c * 16)); ga_issue8(r1, rsd, sew + 64, (unsigned)(c * 16));
            hn0 = *(const u32x4*)hqw; hn1 = *(const u32x4*)(hqw + 512);
            asm volatile("" :: "v"(hn0), "v"(hn1));
#pragma unroll 1
            for (int it = 0; it < 64; ++it) {
                const u32x4 hhi = hn0, hlo = hn1;
                const int i1 = (it + 1) & 63; const unsigned so1 = ((unsigned)(i1 >> 4) << 21) + (unsigned)(c * 16);
                { const unsigned char* hx = hqw + (size_t)(i1 & 15) * 1024 + (i1 >> 4) * 128; hn0 = *(const u32x4*)hx; hn1 = *(const u32x4*)(hx + 512); }
                __builtin_amdgcn_sched_barrier(0);
                ga_down8(r0, hhi, hlo, aww + (it & 15) * 128, c == 0, rsd, sew + (i1 & 15) * 128, so1);
                ga_down8(r1, hhi, hlo, aww + (it & 15) * 128 + 64, c == 0, rsd, sew + (i1 & 15) * 128 + 64, so1);
                asm volatile("" :: "v"(hn0), "v"(hn1));
            }
        }
        float wr[32];
#pragma unroll 16
        for (int j = 0; j < 32; ++j) { const int idx = wave * 2048 + j * 64 + lane; const unsigned e = SE[idx]; const float* hsp = HS + 2 * ((size_t)tb + (idx >> 7)); const float x = (AW[idx] + 0.5f * hsp[1]) * (sdown[e] * hsp[0]);
            const float g = sel_g[(size_t)tb * 128 + idx]; wr[j] = dummy ? 0.f : ((mode & 2) ? -g : g) * 0.5f * x * (1.0f + erff(x * 0.70710678118654752f)) * sup[e]; }
        __syncthreads();
        {
            LAS unsigned char* WA = lds + GA_WA_OFF + wave * 3072; LAS float* WS = (LAS float*)(lds + GA_WS_OFF) + wave * 16;
#pragma unroll
            for (int tk = 0; tk < 16; ++tk) {
                float m = fmaxf(fabsf(wr[2 * tk]), fabsf(wr[2 * tk + 1]));
#pragma unroll
                for (int o = 1; o < 64; o <<= 1) m = fmaxf(m, __shfl_xor(m, o));
                const float inv = m > 0.f ? 6.0f / m : 0.f;
                if (lane == 0) WS[tk] = m * (1.0f / 6.0f);
#pragma unroll
                for (int hf = 0; hf < 2; ++hf) {
                    const float y = wr[2 * tk + hf] * inv;
                    const unsigned p1 = __builtin_amdgcn_cvt_scalef32_pk_fp4_f32(0u, y, 0.f, 1.0f, 0) & 15u; const float v1 = __builtin_amdgcn_cvt_scalef32_pk_f32_fp4(p1, 1.0f, 0)[0];
                    const float r1 = (y - v1) * 4.0f;
                    const unsigned p2 = __builtin_amdgcn_cvt_scalef32_pk_fp4_f32(0u, r1, 0.f, 1.0f, 0) & 15u; const float v2 = __builtin_amdgcn_cvt_scalef32_pk_f32_fp4(p2, 1.0f, 0)[0];
                    const float r2 = (r1 - v2) * 4.0f;
                    const unsigned p3 = __builtin_amdgcn_cvt_scalef32_pk_fp4_f32(0u, r2, 0.f, 1.0f, 0) & 15u;
                    const unsigned mine = p1 | (p2 << 8) | (p3 << 16);
                    const unsigned other = (unsigned)__builtin_amdgcn_update_dpp(0, (int)mine, 0xB1, 0xf, 0xf, true);
                    const unsigned both = mine | (other << 4);
                    if ((lane & 1) == 0) { LAS unsigned char* wp = WA + tk * 192 + hf * 96 + (lane >> 1);
                        wp[0] = (unsigned char)both; wp[32] = (unsigned char)(both >> 8); wp[64] = (unsigned char)(both >> 16); }
                }
            }
        }
        if (!(mode & 8)) {
            LAS unsigned char* img = lds + GA_IMG_OFF + wave * GA_IMG_WAVE;
            const int ir = 4 * (lane >> 5) + ((lane >> 3) & 1), rr = lane & 7;
            const unsigned rdo = (unsigned)(1024 * ir + 128 * rr + 8 * ((lane >> 4) & 1) + 16 * ((rr >> 1) | ((ir & 1) << 2)));
            const LAS unsigned char* WA = lds + GA_WA_OFF + wave * 3072 + (lane >> 5) * 16 + (lane & 31) * 32;
            const LAS float* WS = (const LAS float*)(lds + GA_WS_OFF) + wave * 16;
            const bool arow = (lane & 31) < 3;
            const brsrc_t rsu = ga_rsrc(up4);
            const unsigned ce16 = 16u * (unsigned)(c ^ (r >> 1));
            const unsigned char* const setr = setw;
#define GA_DMA8(se, buf, so) do { _Pragma("unroll") for (int i = 0; i < 8; ++i) { const unsigned en = ((i & 1) ? ((se)[i >> 1] >> 16) : ((se)[i >> 1] & 0xffffu)); \
                __builtin_amdgcn_raw_ptr_buffer_load_lds(rsu, (__attribute__((address_space(3))) void*)(img + (buf) * 8192 + i * 1024), 16, (int)((en << 7) + ((so) ^ (64u * (i & 1)))), 0, 0, 0); } } while (0)
#define GA_WAITV(n) asm volatile("s_waitcnt vmcnt(" #n ")" ::: "memory")
            const unsigned rda = (unsigned)(__UINTPTR_TYPE__)img + rdo, waa = (unsigned)(__UINTPTR_TYPE__)WA;
            float wsv; { const unsigned a = (unsigned)(__UINTPTR_TYPE__)(WS + (lane & 15)); asm volatile("ds_read_b32 %0, %1\n\ts_waitcnt lgkmcnt(0)" : "=v"(wsv) : "v"(a) : "memory"); }
            u32x4 seA = *(const u32x4*)setr, seB = *(const u32x4*)(setr + 128);
            { const u32x4 seC = *(const u32x4*)(setr + 256);
                GA_DMA8(seA, 0, ce16); GA_DMA8(seB, 1, ce16); seA = seC; }
            float acc8[8], x0[4], g0[4];
#pragma unroll 1
            for (int it = 0; it < 64; ++it) {
                const size_t t = (size_t)tb + wave * 16 + (it & 15); const int col = (it >> 4) * 256 + 128 * (lane >> 5) + (lane & 31);
                float* xp = xout + t * 1024 + col;
#pragma unroll
                for (int hf = 0; hf < 2; ++hf) {
                    if (hf == 0) { if (it == 0) GA_WAITV(8); else GA_WAITV(12); } else GA_WAITV(8);
                    __builtin_amdgcn_sched_barrier(0);
                    typedef int i32x2_t __attribute__((ext_vector_type(2)));
                    i32x2_t b0[8], b1[8]; u32x4 wa;
                    { const unsigned a = waa + (unsigned)((it & 15) * 192 + hf * 96); asm volatile("ds_read_b128 %0, %1" : "=v"(wa) : "v"(a) : "memory"); }
#pragma unroll
                    for (int cb = 0; cb < 8; ++cb) { const unsigned a = (rda ^ (unsigned)(16 * cb)) + (unsigned)(hf * 8192);
                        asm volatile("ds_read_b64_tr_b4 %0, %1" : "=v"(b0[cb]) : "v"(a) : "memory");
                        asm volatile("ds_read_b64_tr_b4 %0, %1 offset:2048" : "=v"(b1[cb]) : "v"(a) : "memory"); }
                    asm volatile("s_waitcnt lgkmcnt(0)" : "+v"(b0[0]), "+v"(b0[1]), "+v"(b0[2]), "+v"(b0[3]), "+v"(b0[4]), "+v"(b0[5]), "+v"(b0[6]), "+v"(b0[7]) :: "memory");
                    asm volatile("" : "+v"(b1[0]), "+v"(b1[1]), "+v"(b1[2]), "+v"(b1[3]), "+v"(b1[4]), "+v"(b1[5]), "+v"(b1[6]), "+v"(b1[7]) :: "memory");
                    asm volatile("" : "+v"(wa) :: "memory");
                    __builtin_amdgcn_sched_barrier(0);
                    const int itn = (it + 1) & 63; const unsigned son = ((unsigned)(itn >> 4) << 21) + ce16;
                    if (hf == 0) { const float* gp = modsL + (size_t)(t >> 11) * 6144 + 5 * 1024 + col;
#pragma unroll
                        for (int j = 0; j < 4; ++j) { x0[j] = xp[32 * j]; g0[j] = gp[32 * j]; }
                        seB = *(const u32x4*)(setr + (size_t)(itn & 15) * 256 + 128);
                        __builtin_amdgcn_sched_barrier(0);
                        GA_DMA8(seA, 0, son);
                    } else {
                        seA = *(const u32x4*)(setr + (size_t)((it + 2) & 15) * 256);
                        __builtin_amdgcn_sched_barrier(0);
                        GA_DMA8(seB, 1, son);
                    }
                    __builtin_amdgcn_sched_barrier(0);
                    i32x8 av; av[0] = arow ? (int)wa[0] : 0; av[1] = arow ? (int)wa[1] : 0; av[2] = arow ? (int)wa[2] : 0; av[3] = arow ? (int)wa[3] : 0; av[4] = 0; av[5] = 0; av[6] = 0; av[7] = 0;
#pragma unroll
                    for (int cb = 0; cb < 8; ++cb) {
                        i32x8 bv; bv[0] = b0[cb][0]; bv[1] = b0[cb][1]; bv[2] = b1[cb][0]; bv[3] = b1[cb][1]; bv[4] = 0; bv[5] = 0; bv[6] = 0; bv[7] = 0;
                        f32x16 dz;
#pragma unroll
                        for (int v = 0; v < 16; ++v) dz[v] = 0.f;
                        dz = __builtin_amdgcn_mfma_scale_f32_32x32x64_f8f6f4(av, bv, dz, 4, 4, 0, 0x7f7f7f7f, 0, 0x7f7f7f7f);
                        const float sdz = dz[0] + 0.25f * dz[1] + 0.0625f * dz[2];
                        acc8[cb] = hf ? acc8[cb] + sdz : sdz;
                    }
                    asm volatile("" : "+v"(acc8[0]), "+v"(acc8[1]), "+v"(acc8[2]), "+v"(acc8[3]), "+v"(acc8[4]), "+v"(acc8[5]), "+v"(acc8[6]), "+v"(acc8[7]));
                    if (hf == 1) { const float sw = __builtin_bit_cast(float, __builtin_amdgcn_readlane(__builtin_bit_cast(int, wsv), it & 15));
#pragma unroll
                        for (int j = 0; j < 4; ++j) { const u32x2 p = __builtin_amdgcn_permlane32_swap(__float_as_uint(acc8[j]), __float_as_uint(acc8[j + 4]), false, false);
                            xp[32 * j] = x0[j] + g0[j] * (sw * __uint_as_float(p.x)); } }
                    __builtin_amdgcn_sched_barrier(0);
                }
            }
            GA_WAITV(0);
        }
        if (!(mode & 16)) ga_norm16<FINAL>(xout, H, ng, modsN, (size_t)tb + wave * 16, lane);
        __syncthreads();
    }
}

__device__ __forceinline__ void phase_conv(const bf16* BGU, const float* cw, bf16* Z, int G, int wg) {
    for (int item = wg * 512 + threadIdx.x; item < NTOK * 128; item += G * 512) {
        const int t = item >> 7, d0 = (item & 127) * 8, n = t & 2047;
        const bf16* row = BGU + (size_t)t * 2048 + d0;
        const u32x4 bg = *(const u32x4*)row;
        float y[8];
#pragma unroll
        for (int i = 0; i < 8; ++i) y[i] = 0.f;
#pragma unroll
        for (int dn = -1; dn <= 1; ++dn) {
            if (n + dn < 0 || n + dn >= 2048) continue;
            const u32x4 uu = *(const u32x4*)(row + (ptrdiff_t)dn * 2048 + 1024);
            const f32x4 w0 = *(const f32x4*)(cw + (dn + 1) * 1024 + d0), w1 = *(const f32x4*)(cw + (dn + 1) * 1024 + d0 + 4);
#pragma unroll
            for (int q = 0; q < 4; ++q) { const float wl = (q < 2) ? w0[2 * q] : w1[2 * q - 4], wh = (q < 2) ? w0[2 * q + 1] : w1[2 * q - 3];
                y[2 * q] += wl * bf_lo(uu[q]); y[2 * q + 1] += wh * bf_hi(uu[q]); }
        }
        u32x4 o;
#pragma unroll
        for (int q = 0; q < 4; ++q) o[q] = cvt_pk(bf_lo(bg[q]) * y[2 * q], bf_hi(bg[q]) * y[2 * q + 1]);
        *(u32x4*)(Z + (size_t)t * 1024 + d0) = o;
    }
}

__global__ void __launch_bounds__(NWAVES * 64, 2) fwd(Args args) {
    extern __shared__ __attribute__((aligned(16))) unsigned char lds_raw[];
    LAS unsigned char* lds = (LAS unsigned char*)lds_raw;
    const int tid = threadIdx.x, lane = tid & 63, wave = __builtin_amdgcn_readfirstlane(tid >> 6);
    const int G = gridDim.x, wg = blockIdx.x;
    const int gw = wg * NWAVES + wave, NGW = G * NWAVES;
    unsigned char* ws = args.ws;
    unsigned* ctl = (unsigned*)(ws + WS_CTL);
    for (int u = tid; u < (LDS_BYTES - LDSCTL_OFF) / 4; u += NWAVES * 64) ((LAS unsigned*)(lds + LDSCTL_OFF))[u] = 0u;
    __syncthreads();
    XcdBarrier bar; bar.bar = ctl + CW_BAR; bar.x = 0; bar.st = nullptr;
    if (N_LAUNCHES == 1) bar = xcd_barrier_post(ctl + CW_BAR, (volatile LAS unsigned*)(lds + MISC_OFF) + 8);
#define GRID_BAR() do { if (N_LAUNCHES == 1) xcd_barrier(bar); } while (0)
    const int lo = args.ph_lo, hi = args.ph_hi;
#ifndef PHASE_MASK
#define PHASE_MASK 0xffff
#endif
#define IN(k) (((PHASE_MASK >> (k)) & 1) && lo <= (k) && (k) < hi)
#define BOTH(k) (IN(k) && IN((k) + 1))
    const float* mods = (const float*)(ws + WS_MOD);
    float* xout = args.out;
    bf16* H = (bf16*)(ws + WS_H);

    if (IN(0)) { for (int rep = 0; rep < NREP(0); ++rep) { phase_prep(args, lds, G, wg, rep, 0); __syncthreads(); } if (BOTH(0)) GRID_BAR(); }
    if (IN(1)) { for (int rep = 0; rep < ((PROBE_PHASE == 1 && PROBE_SUB == 1) ? 2 : 1); ++rep) { phase_prep(args, lds, G, wg, 0, 1); __syncthreads(); }
                 for (int rep = 0; rep < ((PROBE_PHASE == 1 && PROBE_SUB == 0) ? 2 : 1); ++rep) phase_norm(args.in[0], args.in[2], args.in[6], mods, 0, H, nullptr, nullptr, nullptr, G, wg);
                 for (int rep = 0; rep < ((PROBE_PHASE == 1 && PROBE_SUB == 2) ? 2 : 1); ++rep) phase_wq8(args.in[16], (const float*)((const unsigned*)(ws + WS_CTL) + CW_COLMAX), ws + WS_WQ_T, lds, G, wg);
                 if (BOTH(1)) GRID_BAR(); }
    if (IN(2)) {
        for (int rep = 0; rep < NREP(2); ++rep) {
        { pg8::Gemm g{H, (const bf16*)(ws + WS_WIN_T), NTT, 1024, 1024}; pg8::StaticOrder S; S.init(NTT, 1024, G, wg);
          pg8::EpiBf16 E{(bf16*)(ws + WS_QK), 1024, 2, 0.125f};
          pg8::gemm_phase<pg8::EpiBf16, pg8::StaticOrder, true, true>(lds + RING_OFF, g, S, E); }
        { pg8::Gemm g{(const bf16*)(ws + WS_WIN_T) + (size_t)1024 * 1024, H, 1024, NTT, 1024}; pg8::StaticOrder S; S.init(1024, NTT, G, wg);
          pg8::EpiVF E{(bf16*)(ws + WS_VT), (bf16*)(ws + WS_VTC), (bf16*)(ws + WS_FT)};
          pg8::gemm_phase<pg8::EpiVF, pg8::StaticOrder, true, true>(lds + RING_OFF, g, S, E); }
        }
        if (BOTH(2)) GRID_BAR();
    }
    if (IN(3)) {
        { LAS float* rpl = (LAS float*)(lds + NWAVES * ATT_WAVE_LDS); for (int e = tid; e < 8 * 15 * 31; e += NWAVES * 64) rpl[e] = args.in[11][e]; __syncthreads();
          for (int rep = 0; rep < ((PROBE_PHASE == 3 && PROBE_SUB != 2) ? 2 : 1); ++rep)
          for (int u0 = wg; u0 < 1024; u0 += G) {
              int u = u0; if (G == 256) { const int xcd = wg & 7, idx = wg >> 3, round = u0 >> 8; u = ((xcd * 16 + round * 4 + (idx >> 3)) << 3) | (idx & 7); }
              const int b = u >> 6, h = (u >> 3) & 7, rq = u & 7;
              na_attn32_wave((const bf16*)(ws + WS_QK), (const bf16*)(ws + WS_VT), (const bf16*)(ws + WS_VTC), rpl + h * 465, lds + wave * ATT_WAVE_LDS, (bf16*)(ws + WS_A2), b, h, 4 * rq + 2 * (wave >> 2), wave & 3, lane);
          } }
        __syncthreads();
        for (int task = gw; task < 16 * 512; task += NGW) {
            const bf16* fp = (const bf16*)(ws + WS_FT) + (size_t)task * 2048 + lane * 32; float sacc = 0.f;
#pragma unroll
            for (int q = 0; q < 4; ++q) { const u32x4 v = *(const u32x4*)(fp + 8 * q);
#pragma unroll
                for (int z = 0; z < 4; ++z) sacc += bf_lo(v[z]) - bf_hi(v[z]); }
            sacc = wave_sum(sacc);
            if (lane == 0) { bf16* op = (bf16*)(ws + WS_A2) + ((size_t)(task >> 9) * 2048 + 1024) * 1536 + 512 + (task & 511); op[0] = (bf16)(cvt_pk(sacc, 0.f) & 0xffffu); op[512] = 0; }
        }
        { pg8::Gemm g{(const bf16*)(ws + WS_DFT), (const bf16*)(ws + WS_FT), 2048, 8192, 2048}; pg8::StaticOrder S; S.init(2048, 8192, G, wg);
          pg8::EpiDft E{(bf16*)(ws + WS_A2)};
          pg8::gemm_phase<pg8::EpiDft, pg8::StaticOrder, true, true>(lds + RING_OFF, g, S, E);
          if (PROBE_PHASE == 3 && PROBE_SUB != 1) pg8::gemm_phase<pg8::EpiDft, pg8::StaticOrder, true, true>(lds + RING_OFF, g, S, E); }
        if (BOTH(3)) GRID_BAR();
    }
    if (IN(4)) {
        pg8::Gemm g{(const bf16*)(ws + WS_A2), (const bf16*)(ws + WS_WOUT_T), NTOK, 1024, 1536}; pg8::StaticOrder S; S.init(NTOK, 1024, G, wg);
        pg8::EpiRes E{args.in[0], xout, mods + 2 * 1024, 6144, 1.f};
        pg8::gemm_phase<pg8::EpiRes, pg8::StaticOrder, true, true>(lds + RING_OFF, g, S, E); if (PROBE_PHASE == 4) pg8::gemm_phase<pg8::EpiRes, pg8::StaticOrder, true, true>(lds + RING_OFF, g, S, E);
        if (BOTH(4)) GRID_BAR();
    }
#define PEER_LAYER(L, pb) do { \
        const float* modsL = mods + (size_t)(L) * 17 * 6144; \
        if (IN(pb)) { for (int rep = 0; rep < NREP(pb); ++rep) phase_norm(xout, nullptr, args.in[7] + (L) * 1024, modsL, 3, nullptr, ws + WS_HQ, ws + WS_HQ8, (float*)(ws + WS_HS), G, wg); if (BOTH(pb)) GRID_BAR(); } \
        if (IN((pb) + 1)) { \
              \
            pg8::Gemm g{(const bf16*)(ws + WS_HQ8), (const bf16*)(ws + WS_WQ_T) + (size_t)(L) * 2048 * 512, NTOK, 2048, 512}; pg8::StaticOrder S; S.init(NTOK, 2048, G, wg); \
            pg8::EpiQ8 E{(bf16*)(ws + WS_PQ), (const float*)(ws + WS_HS), (const float*)((const unsigned*)(ws + WS_CTL) + CW_COLMAX) + (L) * 2048}; \
            pg8::gemm_phase<pg8::EpiQ8, pg8::StaticOrder, true, true>(lds + RING_OFF, g, S, E); if (PROBE_PHASE == (pb) + 1) pg8::gemm_phase<pg8::EpiQ8, pg8::StaticOrder, true, true>(lds + RING_OFF, g, S, E); \
            if (BOTH((pb) + 1)) GRID_BAR(); \
        } \
        if (IN((pb) + 2)) { \
            const bf16* KEYS = (const bf16*)(ws + WS_KEYS) + (size_t)(L) * 8 * 2 * 128 * 128; \
            for (int rep = 0; rep < NREP((pb) + 2); ++rep) phase_topk(lds, (const bf16*)(ws + WS_PQ), KEYS, (int*)(ws + WS_SELE), (float*)(ws + WS_SELG), args.in[18] + (size_t)(L) * 16384 * 1024, args.in[19] + (size_t)(L) * 16384 * 1024, ws + WS_TAB + (size_t)(2 * (L)) * 8 * MiB, (float*)(ws + WS_TSC) + (2 * (L)) * 16384, G, wg); \
            if (BOTH((pb) + 2)) GRID_BAR(); \
        } \
        if (IN((pb) + 3)) { \
            const unsigned char* down8 = ws + WS_TAB + (size_t)(2 * (L)) * 8 * MiB; const unsigned char* up8 = ws + WS_TAB + (size_t)(2 * (L) + 1) * 8 * MiB; \
            const float* sdn = (const float*)(ws + WS_TSC) + (2 * (L)) * 16384; const float* sup = sdn + 16384; \
            for (int grep_ = 0; grep_ < ((PROBE_PHASE == (pb) + 3 && PROBE_SUB >= 3) ? 3 : 1); ++grep_) { const int GMODE = (PROBE_PHASE != (pb) + 3 || PROBE_SUB < 3) ? 0 : (PROBE_SUB == 3) ? ((grep_ == 1) ? 2 : 0) : (PROBE_SUB == 4) ? (((grep_ == 1) ? 2 : 0) | (grep_ < 2 ? 16 : 0)) : (grep_ < 2 ? 12 : 0); \
            if ((L) == 0) phase_gather<false>(lds, H, ws + WS_HQ, (const float*)(ws + WS_HS), (const int*)(ws + WS_SELE), (const float*)(ws + WS_SELG), down8, up8, sdn, sup, modsL, xout, args.in[6] + 1024, mods + (size_t)17 * 6144, G, wg, GMODE); \
            else phase_gather<true>(lds, H, ws + WS_HQ, (const float*)(ws + WS_HS), (const int*)(ws + WS_SELE), (const float*)(ws + WS_SELG), down8, up8, sdn, sup, modsL, xout, args.in[8], nullptr, G, wg, GMODE); } \
            if (PROBE_PHASE == (pb) + 3 && PROBE_SUB < 3) phase_gather<true>(lds, H, ws + WS_HQ, (const float*)(ws + WS_HS), (const int*)(ws + WS_SELE), (const float*)(ws + WS_SELG), down8, up8, sdn, sup, modsL, xout, args.in[8], nullptr, G, wg, 17 | (PROBE_SUB == 1 ? 8 : PROBE_SUB == 2 ? 4 : 0)); \
            if (BOTH((pb) + 3)) GRID_BAR(); \
        } } while (0)

    PEER_LAYER(0, 5);
    if (IN(9)) {
        pg8::Gemm g{H, (const bf16*)(ws + WS_CVIN_T), NTOK, 3072, 1024}; pg8::StaticOrder S; S.init(NTOK, 3072, G, wg);
        pg8::EpiCv E{(bf16*)(ws + WS_BCV)};
        pg8::gemm_phase<pg8::EpiCv, pg8::StaticOrder, true, true>(lds + RING_OFF, g, S, E); if (PROBE_PHASE == 9) pg8::gemm_phase<pg8::EpiCv, pg8::StaticOrder, true, true>(lds + RING_OFF, g, S, E);
        if (BOTH(9)) GRID_BAR();
    }
    if (IN(10)) { for (int rep = 0; rep < NREP(10); ++rep) phase_conv((const bf16*)(ws + WS_BCV), args.in[14], H, G, wg); if (BOTH(10)) GRID_BAR(); }
    if (IN(11)) {
        pg8::Gemm g{H, (const bf16*)(ws + WS_CVOUT_T), NTOK, 1024, 1024}; pg8::StaticOrder S; S.init(NTOK, 1024, G, wg);
        pg8::EpiRes E{xout, xout, mods + (size_t)17 * 6144 + 2 * 1024, 6144, 1.f};
        pg8::gemm_phase<pg8::EpiRes, pg8::StaticOrder, true, true>(lds + RING_OFF, g, S, E);
        if (PROBE_PHASE == 11) { pg8::EpiRes E0{xout, xout, mods + (size_t)17 * 6144 + 2 * 1024, 6144, __int_as_float(args.pad)}; pg8::gemm_phase<pg8::EpiRes, pg8::StaticOrder, true, true>(lds + RING_OFF, g, S, E0); }
        if (BOTH(11)) GRID_BAR();
    }
    PEER_LAYER(1, 12);
#undef PEER_LAYER
#undef IN
#undef BOTH
#undef GRID_BAR
}

extern "C" void kernel_launch(void* const* d_in, const int* in_sizes, int n_in, void* d_out, int out_size, void* d_ws, size_t ws_size, hipStream_t stream) {
    static int grid = 0;
    if (grid == 0) {
        if (n_in != 20 || out_size != NTOK * D || ws_size < WS_END) { fprintf(stderr, "kernel_launch: unexpected shapes (n_in %d, out %d, ws %zu); nothing launched\n", n_in, out_size, ws_size); grid = -1; return; }
        int dev = 0, cus = 0;
        if (hipGetDevice(&dev) != hipSuccess || hipDeviceGetAttribute(&cus, hipDeviceAttributeMultiprocessorCount, dev) != hipSuccess) { grid = -1; return; }
        if (hipFuncSetAttribute((const void*)fwd, hipFuncAttributeMaxDynamicSharedMemorySize, LDS_BYTES) != hipSuccess) { fprintf(stderr, "kernel_launch: hipFuncSetAttribute failed\n"); grid = -1; return; }
        int per_cu = 0;
        if (hipOccupancyMaxActiveBlocksPerMultiprocessor(&per_cu, (const void*)fwd, NWAVES * 64, LDS_BYTES) != hipSuccess || per_cu < 1) fprintf(stderr, "kernel_launch: occupancy query reports %d\n", per_cu);
        (void)hipGetLastError();
        grid = cus;
    }
    if (grid < 0) return;
    (void)hipMemsetAsync((char*)d_ws + WS_CTL, 0, CTL_ZERO_BYTES, stream);
    Args a{};
    for (int i = 0; i < 20; ++i) a.in[i] = (const float*)d_in[i];
    a.out = (float*)d_out; a.ws = (unsigned char*)d_ws;
    for (int li = 0; li < N_LAUNCHES; ++li) {
        a.ph_lo = (N_LAUNCHES == 1) ? 0 : li; a.ph_hi = (N_LAUNCHES == 1) ? N_PHASES : li + 1; a.li = li;
        hipLaunchKernelGGL(fwd, dim3(grid), dim3(NWAVES * 64), LDS_BYTES, stream, a);
    }
}
```

```cpp
#include <hip/hip_runtime.h>
#include <cstdio>
#include <cstdint>

#ifndef MK_N_LAUNCHES
#define MK_N_LAUNCHES 1
#endif

#ifndef PROBE_PHASE
#define PROBE_PHASE (-1)
#endif
#ifndef PROBE_SUB
#define PROBE_SUB 0
#endif
#define NREP(k) ((PROBE_PHASE == (k)) ? 2 : 1)
#define LAS __attribute__((address_space(3)))
typedef unsigned short bf16;
typedef short bf16x8 __attribute__((ext_vector_type(8)));
typedef float f32x4 __attribute__((ext_vector_type(4)));
typedef unsigned u32x4 __attribute__((ext_vector_type(4)));
typedef unsigned u32x2 __attribute__((ext_vector_type(2)));
typedef __bf16 bf16v2 __attribute__((ext_vector_type(2)));

namespace pg8 {
#define PG8_LAS __attribute__((address_space(3)))
typedef unsigned short bf16_t;
constexpr int BM = 256, BK = 64, HALF = 128, HTB = HALF * BK * 2, STAGE_BYTES = 8 * HTB, NXCD = 8, WGM = 8;

__host__ __device__ __forceinline__ int lds_byte(int r, int c) { const int st = (r >> 4) * 2 + (c >> 5), rr = r & 15, cc = c & 31, ob = rr * 64 + cc * 2; return st * 1024 + (ob ^ (((ob >> 9) & 1) << 5)); }
__host__ __device__ __forceinline__ void stage_rc(int b, int& R, int& C) { const int st = b / 1024, sb = b % 1024, swz = sb ^ (((sb >> 9) & 1) << 5); R = (st >> 1) * 16 + swz / 64; C = (st & 1) * 32 + (swz % 64) / 2; }
__host__ __device__ __forceinline__ int perm32(int rho) { const int n = rho >> 4, i = rho & 15; return 8 * (i >> 2) + 4 * n + (i & 3); }

struct Unit { int pm, pn; int which = 0; };
struct Gemm { const bf16_t* A; const bf16_t* Bt; int M, N, K; const bf16_t* A2 = nullptr; const bf16_t* Bt2 = nullptr; };

struct StaticOrder {
    int nM, nN, nwg, G, c;
    __host__ __device__ void init(int M, int N, int G_, int c_) { nM = M / BM; nN = N / BM; nwg = nM * nN; G = G_; c = c_; }
    __host__ __device__ bool next(int i, Unit& u) const {
        const long L = (long)i * G + c; if (L >= nwg) return false;
        int wgid = (int)L; { const int q = nwg / NXCD, r = nwg % NXCD, xcd = wgid % NXCD, off = wgid / NXCD; wgid = (xcd < r ? xcd * (q + 1) : r * (q + 1) + (xcd - r) * q) + off; }
        const int nig = WGM * nN, gid = wgid / nig, fm = gid * WGM, gsz = (nM - fm) < WGM ? (nM - fm) : WGM;
        u.pm = fm + ((wgid % nig) % gsz); u.pn = (wgid % nig) / gsz; return true;
    }
    __device__ __forceinline__ void a_ready(const Unit&) const {}
    __device__ __forceinline__ void done(const Unit&) const {}
};

struct DualOrder {
    StaticOrder s1, s2;
    __host__ __device__ void init(int M1, int N1, int M2, int N2, int G_, int c_) { s1.init(M1, N1, G_, c_); s2.init(M2, N2, G_, c_); }
    __host__ __device__ bool next(int i, Unit& u) const {
        const long L = (long)i * s1.G + s1.c;
        if (L < s1.nwg) { u.which = 0; return s1.next(i, u); }
        const long L2 = L - s1.nwg; if (L2 >= s2.nwg) return false;
        StaticOrder t = s2; t.c = (int)(L2 % s2.G); u.which = 1; return t.next((int)(L2 / s2.G), u);
    }
    __device__ __forceinline__ void a_ready(const Unit&) const {}
    __device__ __forceinline__ void done(const Unit&) const {}
};

__device__ __forceinline__ unsigned cvt_pk_bf16(float lo, float hi) { unsigned r; asm("v_cvt_pk_bf16_f32 %0, %1, %2" : "=v"(r) : "v"(lo), "v"(hi)); return r; }


struct EpiBf16 {
    static constexpr bool PERM = true, AFTER_DRAIN = false;
    bf16_t* O; int ldc; int nscale; float scale0;
    __device__ __forceinline__ void operator()(const f32x4 (&acc)[2][2][4][2], const Unit& u, int wr, int wc, int fr, int fq) const {
        const int row0 = u.pm * BM + wr * 64 + fr; const int col0 = u.pn * BM + wc * 32 + 8 * fq;
        const float sc = (u.pn < nscale) ? scale0 : 1.f;
#pragma unroll
        for (int ai = 0; ai < 2; ++ai)
#pragma unroll
            for (int m = 0; m < 4; ++m) { bf16_t* rowp = O + (size_t)(row0 + ai * HALF + m * 16) * ldc + col0;
#pragma unroll
                for (int bj = 0; bj < 2; ++bj) { f32x4 v0 = acc[ai][bj][m][0] * sc, v1 = acc[ai][bj][m][1] * sc;
                    u32x4 w; w.x = cvt_pk_bf16(v0[0], v0[1]); w.y = cvt_pk_bf16(v0[2], v0[3]); w.z = cvt_pk_bf16(v1[0], v1[1]); w.w = cvt_pk_bf16(v1[2], v1[3]);
                    *(u32x4*)(rowp + bj * HALF) = w; } }
    }
};
struct EpiCv {
    static constexpr bool PERM = true, AFTER_DRAIN = false;
    bf16_t* O;
    __device__ __forceinline__ void operator()(const f32x4 (&acc)[2][2][4][2], const Unit& u, int wr, int wc, int fr, int fq) const {
        const int row0 = u.pm * BM + wr * 64 + fr;
        if (u.pn < 4) {
            const int col0 = u.pn * BM + wc * 32 + 8 * fq;
#pragma unroll
            for (int ai = 0; ai < 2; ++ai)
#pragma unroll
                for (int m = 0; m < 4; ++m) { bf16_t* rowp = O + (size_t)(row0 + ai * HALF + m * 16) * 2048 + col0;
#pragma unroll
                    for (int bj = 0; bj < 2; ++bj) { const f32x4 v0 = acc[ai][bj][m][0], v1 = acc[ai][bj][m][1];
                        u32x4 w; w.x = cvt_pk_bf16(v0[0], v0[1]); w.y = cvt_pk_bf16(v0[2], v0[3]); w.z = cvt_pk_bf16(v1[0], v1[1]); w.w = cvt_pk_bf16(v1[2], v1[3]);
                        *(u32x4*)(rowp + bj * HALF) = w; } }
        } else {
            const int col0 = 1024 + (u.pn - 4) * HALF + wc * 32 + 8 * fq;
#pragma unroll
            for (int ai = 0; ai < 2; ++ai)
#pragma unroll
                for (int m = 0; m < 4; ++m) { const f32x4 v0 = acc[ai][0][m][0] * acc[ai][1][m][0], v1 = acc[ai][0][m][1] * acc[ai][1][m][1];
                    u32x4 w; w.x = cvt_pk_bf16(v0[0], v0[1]); w.y = cvt_pk_bf16(v0[2], v0[3]); w.z = cvt_pk_bf16(v1[0], v1[1]); w.w = cvt_pk_bf16(v1[2], v1[3]);
                    *(u32x4*)(O + (size_t)(row0 + ai * HALF + m * 16) * 2048 + col0) = w; }
        }
    }
};
struct EpiVF {
    static constexpr bool PERM = true, AFTER_DRAIN = false;
    bf16_t* VT; bf16_t* VTC; bf16_t* FT;
    __device__ __forceinline__ void operator()(const f32x4 (&acc)[2][2][4][2], const Unit& u, int wr, int wc, int fr, int fq) const {
        const int row0 = u.pm * BM + wr * 64 + fr; const int tok0 = u.pn * BM;
        const bool isf = u.pm >= 2, isctx = tok0 >= 32768;
        if (isf && isctx) return;
        bf16_t* base; int pitch, cbase;
        if (!isctx) { const int b = tok0 >> 11; pitch = 2048; cbase = (tok0 & 2047) + wc * 32 + 8 * fq; base = (isf ? FT : VT) + (size_t)b * 512 * 2048; }
        else { const int tc = tok0 - 32768; const int b = tc >> 8; pitch = 256; cbase = wc * 32 + 8 * fq; base = VTC + (size_t)b * 512 * 256; }
        const int rsub = isf ? 512 : 0;
#pragma unroll
        for (int ai = 0; ai < 2; ++ai)
#pragma unroll
            for (int m = 0; m < 4; ++m) { bf16_t* rowp = base + (size_t)(row0 + ai * HALF + m * 16 - rsub) * pitch + cbase;
#pragma unroll
                for (int bj = 0; bj < 2; ++bj) { const f32x4 v0 = acc[ai][bj][m][0], v1 = acc[ai][bj][m][1];
                    u32x4 w; w.x = cvt_pk_bf16(v0[0], v0[1]); w.y = cvt_pk_bf16(v0[2], v0[3]); w.z = cvt_pk_bf16(v1[0], v1[1]); w.w = cvt_pk_bf16(v1[2], v1[3]);
                    *(u32x4*)(rowp + bj * HALF) = w; } }
    }
};
struct EpiQKVF {
    static constexpr bool PERM = true, AFTER_DRAIN = false;
    EpiBf16 e1; EpiVF e2;
    __device__ __forceinline__ void operator()(const f32x4 (&acc)[2][2][4][2], const Unit& u, int wr, int wc, int fr, int fq) const { if (u.which) e2(acc, u, wr, wc, fr, fq); else e1(acc, u, wr, wc, fr, fq); }
};
struct EpiDft {
    static constexpr bool PERM = true, AFTER_DRAIN = false;
    bf16_t* A2;
    __device__ __forceinline__ void operator()(const f32x4 (&acc)[2][2][4][2], const Unit& u, int wr, int wc, int fr, int fq) const {
        const int kp0 = u.pm * BM + wr * 64 + fr; const int part = kp0 >> 10;
        const int bc0 = u.pn * BM; const int b = bc0 >> 9; const int ch0 = (bc0 & 511) + wc * 32 + 8 * fq;
        bf16_t* base = A2 + (size_t)b * 2048 * 1536 + 512 + part * 512 + ch0;
        const float sg = part ? -1.f : 1.f;
#pragma unroll
        for (int ai = 0; ai < 2; ++ai)
#pragma unroll
            for (int m = 0; m < 4; ++m) { const int k = (kp0 & 1023) + ai * HALF + m * 16; bf16_t* rowp = base + (size_t)k * 1536; bf16_t* mirp = base + (size_t)(2048 - k) * 1536;
#pragma unroll
                for (int bj = 0; bj < 2; ++bj) { const f32x4 v0 = acc[ai][bj][m][0], v1 = acc[ai][bj][m][1];
                    u32x4 w; w.x = cvt_pk_bf16(v0[0], v0[1]); w.y = cvt_pk_bf16(v0[2], v0[3]); w.z = cvt_pk_bf16(v1[0], v1[1]); w.w = cvt_pk_bf16(v1[2], v1[3]);
                    *(u32x4*)(rowp + bj * HALF) = w;
                    if (k > 0) { const f32x4 n0 = v0 * sg, n1 = v1 * sg; u32x4 x; x.x = cvt_pk_bf16(n0[0], n0[1]); x.y = cvt_pk_bf16(n0[2], n0[3]); x.z = cvt_pk_bf16(n1[0], n1[1]); x.w = cvt_pk_bf16(n1[2], n1[3]);
                        *(u32x4*)(mirp + bj * HALF) = x; } } }
    }
};
template <bool BASE_F32>
struct EpiResB {
    static constexpr bool PERM = true, AFTER_DRAIN = false;
    const void* base; bf16_t* out; const float* gate; int gpitch; float gsc;
    __device__ __forceinline__ void operator()(const f32x4 (&acc)[2][2][4][2], const Unit& u, int wr, int wc, int fr, int fq) const {
        const int row0 = u.pm * BM + wr * 64 + fr, col0 = u.pn * BM + wc * 32 + 8 * fq;
        const float* gp = gate + (size_t)((u.pm * BM) >> 11) * gpitch + col0;
        f32x4 gv[2][2];
#pragma unroll
        for (int bj = 0; bj < 2; ++bj)
#pragma unroll
            for (int n = 0; n < 2; ++n) gv[bj][n] = *(const f32x4*)(gp + bj * HALF + n * 4) * gsc;
#pragma unroll
        for (int ai = 0; ai < 2; ++ai) {
            f32x4 bq[4][2][2]; u32x4 bw[4][2];
#pragma unroll
            for (int m = 0; m < 4; ++m) { const size_t off = (size_t)(row0 + ai * HALF + m * 16) * 1024 + col0;
#pragma unroll
                for (int bj = 0; bj < 2; ++bj) {
                    if (BASE_F32) { bq[m][bj][0] = *(const f32x4*)((const float*)base + off + bj * HALF); bq[m][bj][1] = *(const f32x4*)((const float*)base + off + bj * HALF + 4); }
                    else bw[m][bj] = *(const u32x4*)((const bf16_t*)base + off + bj * HALF); } }
#pragma unroll
            for (int m = 0; m < 4; ++m) { const size_t off = (size_t)(row0 + ai * HALF + m * 16) * 1024 + col0;
#pragma unroll
                for (int bj = 0; bj < 2; ++bj) { f32x4 b0, b1;
                    if (BASE_F32) { b0 = bq[m][bj][0]; b1 = bq[m][bj][1]; }
                    else { const u32x4 w = bw[m][bj];
                        b0 = (f32x4){__uint_as_float(w.x << 16), __uint_as_float(w.x & 0xffff0000u), __uint_as_float(w.y << 16), __uint_as_float(w.y & 0xffff0000u)};
                        b1 = (f32x4){__uint_as_float(w.z << 16), __uint_as_float(w.z & 0xffff0000u), __uint_as_float(w.w << 16), __uint_as_float(w.w & 0xffff0000u)}; }
                    const f32x4 v0 = b0 + gv[bj][0] * acc[ai][bj][m][0], v1 = b1 + gv[bj][1] * acc[ai][bj][m][1];
                    u32x4 o; o.x = cvt_pk_bf16(v0[0], v0[1]); o.y = cvt_pk_bf16(v0[2], v0[3]); o.z = cvt_pk_bf16(v1[0], v1[1]); o.w = cvt_pk_bf16(v1[2], v1[3]);
                    *(u32x4*)(out + off + bj * HALF) = o; } }
        }
    }
};

typedef int i32x4_t __attribute__((ext_vector_type(4)));
struct EpiQ8 {
    static constexpr bool PERM = true, AFTER_DRAIN = false, I8 = true;
    bf16_t* O; const float* hs; const float* wsc;
    __device__ __forceinline__ void operator()(const f32x4 (&acc)[2][2][4][2], const Unit& u, int wr, int wc, int fr, int fq) const {
        const int row0 = u.pm * BM + wr * 64 + fr, col0 = u.pn * BM + wc * 32 + 8 * fq;
        f32x4 cs[2][2];
#pragma unroll
        for (int bj = 0; bj < 2; ++bj)
#pragma unroll
            for (int n = 0; n < 2; ++n) cs[bj][n] = *(const f32x4*)(wsc + col0 + bj * HALF + n * 4) * (1.0f / 127.0f);
        float rsv[2][4];
#pragma unroll
        for (int ai = 0; ai < 2; ++ai)
#pragma unroll
            for (int m = 0; m < 4; ++m) rsv[ai][m] = hs[2 * (size_t)(row0 + ai * HALF + m * 16)];
        asm volatile("" : "+v"(rsv[0][0]), "+v"(rsv[0][1]), "+v"(rsv[0][2]), "+v"(rsv[0][3]), "+v"(rsv[1][0]), "+v"(rsv[1][1]), "+v"(rsv[1][2]), "+v"(rsv[1][3]));
#pragma unroll
        for (int ai = 0; ai < 2; ++ai)
#pragma unroll
            for (int m = 0; m < 4; ++m) { const int row = row0 + ai * HALF + m * 16; const float rs = rsv[ai][m];
                bf16_t* rowp = O + (size_t)row * 2048 + col0;
#pragma unroll
                for (int bj = 0; bj < 2; ++bj) { const i32x4_t a0 = __builtin_bit_cast(i32x4_t, acc[ai][bj][m][0]), a1 = __builtin_bit_cast(i32x4_t, acc[ai][bj][m][1]);
                    f32x4 v0, v1;
#pragma unroll
                    for (int z = 0; z < 4; ++z) { v0[z] = (float)a0[z] * rs * cs[bj][0][z]; v1[z] = (float)a1[z] * rs * cs[bj][1][z]; }
                    u32x4 w; w.x = cvt_pk_bf16(v0[0], v0[1]); w.y = cvt_pk_bf16(v0[2], v0[3]); w.z = cvt_pk_bf16(v1[0], v1[1]); w.w = cvt_pk_bf16(v1[2], v1[3]);
                    *(u32x4*)(rowp + bj * HALF) = w; } }
    }
};

template <class E, class = void> struct epi_is_i8 { static constexpr bool value = false; };
template <class E> struct epi_is_i8<E, decltype((void)E::I8)> { static constexpr bool value = E::I8; };
template <class Epi, class Sched, bool ALIGN_EPI = false, bool SP2 = false>
__device__ __forceinline__ void gemm_phase(PG8_LAS unsigned char* lds, const Gemm g, const Sched& S, const Epi& E) {
    const int tid = threadIdx.x, wid = __builtin_amdgcn_readfirstlane(tid >> 6), lane = tid & 63, wr = wid >> 2, wc = wid & 3, fr = lane & 15, fq = lane >> 4;
    const int K = g.K, nt = K / BK;
    unsigned voffA[2], voffB[2];
#pragma unroll
    for (int i = 0; i < 2; ++i) { int R, C; stage_rc(tid * 16 + i * 8192, R, C); const int Rb = Epi::PERM ? ((R & ~31) + perm32(R & 31)) : R;
        voffA[i] = (unsigned)(R * K + C) * 2u; voffB[i] = (unsigned)(Rb * K + C) * 2u; }
    const size_t kstep = (size_t)(BK * 2);
    const size_t hstep = (size_t)HALF * K * 2;
    const size_t tstep = 2 * hstep;
    const unsigned ldsw = (unsigned)wid * 1024u;
    const int aoff = lds_byte(wr * 64 + fr, fq * 8), boff = lds_byte(wc * 32 + fr, fq * 8);
#define PG8_SA(b, h) (((b) * 2 + (h)) * HTB)
#define PG8_SB(b, h) ((4 + (b) * 2 + (h)) * HTB)
#define PG8_STAGE(bufoff, gbase, voff) do { _Pragma("unroll") for (int _i = 0; _i < 2; ++_i) \
        __builtin_amdgcn_global_load_lds((const unsigned*)((const char*)(gbase) + (voff)[_i]), (PG8_LAS unsigned*)(lds + (bufoff) + ldsw + _i * 8192), 16, 0, 0); } while (0)
#define PG8_LDA(dst, b, h) do { _Pragma("unroll") for (int m = 0; m < 4; ++m) _Pragma("unroll") for (int k = 0; k < 2; ++k) dst[m][k] = *(const PG8_LAS bf16x8*)(lds + PG8_SA(b, h) + aoff + m * 2048 + k * 1024); } while (0)
#define PG8_LDB(dst, b, h) do { _Pragma("unroll") for (int n = 0; n < 2; ++n) _Pragma("unroll") for (int k = 0; k < 2; ++k) dst[n][k] = *(const PG8_LAS bf16x8*)(lds + PG8_SB(b, h) + boff + n * 2048 + k * 1024); } while (0)
#define PG8_MMA(ai, bj, At, Bt) do { __builtin_amdgcn_s_setprio(1); _Pragma("unroll") for (int m = 0; m < 4; ++m) _Pragma("unroll") for (int n = 0; n < 2; ++n) _Pragma("unroll") for (int k = 0; k < 2; ++k) { \
        if constexpr (epi_is_i8<Epi>::value) acc[ai][bj][m][n] = __builtin_bit_cast(f32x4, __builtin_amdgcn_mfma_i32_16x16x64_i8(__builtin_bit_cast(i32x4_t, Bt[n][k]), __builtin_bit_cast(i32x4_t, At[m][k]), __builtin_bit_cast(i32x4_t, acc[ai][bj][m][n]), 0, 0, 0)); \
        else acc[ai][bj][m][n] = __builtin_amdgcn_mfma_f32_16x16x32_bf16(Bt[n][k], At[m][k], acc[ai][bj][m][n], 0, 0, 0); } __builtin_amdgcn_s_setprio(0); } while (0)
#define PG8_WAIT_V(n) asm volatile("s_waitcnt vmcnt(" #n ")" ::: "memory")
#define PG8_WAIT_L(n) asm volatile("s_waitcnt lgkmcnt(" #n ")" ::: "memory")
#define PG8_BAR __builtin_amdgcn_s_barrier()
#define PG8_SCHED __builtin_amdgcn_sched_barrier(0)
    Unit cur, nxt; int ui = 0;
    if (!S.next(0, cur)) return;
    f32x4 acc[2][2][4][2];
#pragma unroll
    for (int a = 0; a < 2; ++a)
#pragma unroll
        for (int b = 0; b < 2; ++b)
#pragma unroll
            for (int m = 0; m < 4; ++m)
#pragma unroll
                for (int n = 0; n < 2; ++n) acc[a][b][m][n] = (f32x4){0.f, 0.f, 0.f, 0.f};
    bf16x8 At[4][2], B0[2][2], B1[2][2];
    const char* cA = (const char*)(cur.which ? g.A2 : g.A) + (size_t)cur.pm * tstep; const char* cB = (const char*)(cur.which ? g.Bt2 : g.Bt) + (size_t)cur.pn * tstep;
    S.a_ready(cur);
    if constexpr (SP2) {
        PG8_STAGE(PG8_SB(0, 0), cB, voffB); PG8_STAGE(PG8_SB(0, 1), cB + hstep, voffB); PG8_STAGE(PG8_SA(0, 0), cA, voffA); PG8_STAGE(PG8_SA(0, 1), cA + hstep, voffA);
        if (wr == 1) PG8_BAR;
        PG8_WAIT_V(2); PG8_BAR;
        PG8_STAGE(PG8_SB(1, 0), cB + kstep, voffB); PG8_STAGE(PG8_SA(1, 0), cA + kstep, voffA); PG8_STAGE(PG8_SB(1, 1), cB + hstep + kstep, voffB);
        PG8_WAIT_V(6); PG8_BAR;
    } else {
        PG8_STAGE(PG8_SB(0, 0), cB, voffB); PG8_STAGE(PG8_SA(0, 0), cA, voffA); PG8_STAGE(PG8_SB(0, 1), cB + hstep, voffB); PG8_STAGE(PG8_SA(0, 1), cA + hstep, voffA);
        if (wr == 1) PG8_BAR;
        PG8_WAIT_V(4); PG8_BAR;
        PG8_STAGE(PG8_SB(1, 0), cB + kstep, voffB); PG8_STAGE(PG8_SA(1, 0), cA + kstep, voffA); PG8_STAGE(PG8_SB(1, 1), cB + hstep + kstep, voffB);
        PG8_WAIT_V(6); PG8_BAR;
    }
    for (;;) {
        const bool has_next = S.next(ui + 1, nxt);
        const char* nA = has_next ? (const char*)(nxt.which ? g.A2 : g.A) + (size_t)nxt.pm * tstep : cA; const char* nB = has_next ? (const char*)(nxt.which ? g.Bt2 : g.Bt) + (size_t)nxt.pn * tstep : cB;
        for (int t = 0; t < nt; t += 2) {
            const bool last = (t == nt - 2);
            const char* a1 = cA + (size_t)(t + 1) * kstep;
            const char* a2 = last ? nA : cA + (size_t)(t + 2) * kstep; const char* b2 = last ? nB : cB + (size_t)(t + 2) * kstep;
            const char* a3 = a2 + kstep; const char* b3 = b2 + kstep;
            if (last && has_next) S.a_ready(nxt);
            if constexpr (SP2) {
            PG8_LDB(B0, 0, 0); PG8_LDB(B1, 0, 1); PG8_SCHED; PG8_LDA(At, 0, 0); PG8_STAGE(PG8_SA(1, 1), a1 + hstep, voffA);
            PG8_WAIT_V(8); PG8_WAIT_L(0); PG8_BAR; PG8_MMA(0, 0, At, B0); PG8_MMA(0, 1, At, B1); PG8_BAR; PG8_SCHED;
            PG8_LDA(At, 0, 1); PG8_STAGE(PG8_SB(0, 0), b2, voffB); PG8_STAGE(PG8_SB(0, 1), b2 + hstep, voffB); PG8_STAGE(PG8_SA(0, 0), a2, voffA);
            PG8_WAIT_V(8); PG8_WAIT_L(0); PG8_BAR; PG8_MMA(1, 0, At, B0); PG8_MMA(1, 1, At, B1); PG8_BAR; PG8_SCHED;
            PG8_LDB(B0, 1, 0); PG8_LDB(B1, 1, 1); PG8_SCHED; PG8_LDA(At, 1, 0); PG8_STAGE(PG8_SA(0, 1), a2 + hstep, voffA);
            PG8_WAIT_V(8); PG8_WAIT_L(0); PG8_BAR; PG8_MMA(0, 0, At, B0); PG8_MMA(0, 1, At, B1); PG8_BAR; PG8_SCHED;
            PG8_LDA(At, 1, 1); PG8_STAGE(PG8_SB(1, 0), b3, voffB); PG8_STAGE(PG8_SB(1, 1), b3 + hstep, voffB); PG8_STAGE(PG8_SA(1, 0), a3, voffA);
            PG8_WAIT_V(8); PG8_WAIT_L(0); PG8_BAR; PG8_MMA(1, 0, At, B0); PG8_MMA(1, 1, At, B1); PG8_BAR; PG8_SCHED;
            } else {
            PG8_LDB(B0, 0, 0); PG8_SCHED; PG8_LDA(At, 0, 0); PG8_STAGE(PG8_SA(1, 1), a1 + hstep, voffA);
            PG8_WAIT_L(8); PG8_BAR; PG8_WAIT_L(0); PG8_MMA(0, 0, At, B0); PG8_BAR; PG8_SCHED;
            PG8_LDB(B1, 0, 1); PG8_STAGE(PG8_SB(0, 0), b2, voffB);
            PG8_BAR; PG8_WAIT_L(0); PG8_MMA(0, 1, At, B1); PG8_BAR;
            PG8_LDA(At, 0, 1); PG8_STAGE(PG8_SA(0, 0), a2, voffA);
            PG8_BAR; PG8_WAIT_L(0); PG8_MMA(1, 0, At, B0); PG8_BAR; PG8_SCHED;
            PG8_STAGE(PG8_SB(0, 1), b2 + hstep, voffB);
            PG8_WAIT_V(6); PG8_BAR; PG8_MMA(1, 1, At, B1); PG8_BAR;
            PG8_LDB(B0, 1, 0); PG8_SCHED; PG8_LDA(At, 1, 0); PG8_STAGE(PG8_SA(0, 1), a2 + hstep, voffA);
            PG8_WAIT_L(8); PG8_BAR; PG8_WAIT_L(0); PG8_MMA(0, 0, At, B0); PG8_BAR; PG8_SCHED;
            PG8_LDB(B1, 1, 1); PG8_STAGE(PG8_SB(1, 0), b3, voffB);
            PG8_BAR; PG8_WAIT_L(0); PG8_MMA(0, 1, At, B1); PG8_BAR;
            PG8_LDA(At, 1, 1); PG8_STAGE(PG8_SA(1, 0), a3, voffA);
            PG8_BAR; PG8_WAIT_L(0); PG8_MMA(1, 0, At, B0); PG8_BAR; PG8_SCHED;
            PG8_STAGE(PG8_SB(1, 1), b3 + hstep, voffB);
            PG8_WAIT_V(6); PG8_BAR; PG8_MMA(1, 1, At, B1); PG8_BAR;
            }
        }
        if constexpr (ALIGN_EPI) { if (wr == 0) PG8_BAR; }
        if constexpr (!Epi::AFTER_DRAIN) { E(acc, cur, wr, wc, fr, fq); S.done(cur); }
        if (!has_next) break;
#pragma unroll
        for (int a = 0; a < 2; ++a)
#pragma unroll
            for (int b = 0; b < 2; ++b)
#pragma unroll
                for (int m = 0; m < 4; ++m)
#pragma unroll
                    for (int n = 0; n < 2; ++n) acc[a][b][m][n] = (f32x4){0.f, 0.f, 0.f, 0.f};
        cur = nxt; cA = nA; cB = nB; ++ui;
        if constexpr (ALIGN_EPI) { if (wr == 1) PG8_BAR; }
    }
    PG8_WAIT_V(0);
    if constexpr (!ALIGN_EPI) { if (wr == 0) PG8_BAR; }
    PG8_BAR;
#undef PG8_SA
#undef PG8_SB
#undef PG8_STAGE
#undef PG8_LDA
#undef PG8_LDB
#undef PG8_MMA
#undef PG8_WAIT_V
#undef PG8_WAIT_L
#undef PG8_BAR
#undef PG8_SCHED
}
}

constexpr int NWAVES = 8;
constexpr int NB = 16, SEQ = 2048, D = 1024, NTOK = NB * SEQ, NCTX = NB * 256, NTT = NTOK + NCTX;
constexpr int N_PHASES = 16;
constexpr int N_LAUNCHES = MK_N_LAUNCHES;
static_assert(N_LAUNCHES == 1 || N_LAUNCHES == N_PHASES, "one launch, or one launch per phase");

constexpr size_t MiB = 1u << 20;
constexpr size_t WS_CTL = 0, CTL_ZERO_BYTES = 64 * 1024;
constexpr size_t WS_MOD = 1 * MiB;
constexpr size_t WS_WIN_T = 2 * MiB;
constexpr size_t WS_WOUT_T = 6 * MiB;
constexpr size_t WS_CVIN_T = 9 * MiB;
constexpr size_t WS_CVOUT_T = 15 * MiB;
constexpr size_t WS_WQ_T = 17 * MiB;
constexpr size_t WS_KEYS = 25 * MiB;
constexpr size_t WS_DFT = 28 * MiB;
constexpr size_t WS_TAB = 48 * MiB;
constexpr size_t WS_TSC = 44 * MiB;
constexpr size_t WS_HQ = 80 * MiB;
constexpr size_t WS_HS = 45 * MiB;
constexpr size_t WS_XS = 112 * MiB;
constexpr size_t WS_H = 176 * MiB;
constexpr size_t WS_R = 248 * MiB;
constexpr size_t WS_QK = WS_R;
constexpr size_t WS_VT = WS_R + 72 * MiB;
constexpr size_t WS_VTC = WS_R + 104 * MiB;
constexpr size_t WS_FT = WS_R + 108 * MiB;
constexpr size_t WS_A2 = WS_R + 140 * MiB;
constexpr size_t WS_PQ = WS_R;
constexpr size_t WS_SELE = WS_R + 128 * MiB;
constexpr size_t WS_SELG = WS_R + 144 * MiB;
constexpr size_t WS_HQ8 = WS_R + 160 * MiB;
constexpr size_t WS_BCV = WS_R;
constexpr size_t WS_SET = WS_R + 240 * MiB;
constexpr size_t WS_END = 512 * MiB;
static_assert(WS_A2 + (size_t)NTOK * 1536 * 2 <= WS_END, "ws map");
constexpr int CW_BAR = 4096;
constexpr int CW_COLMAX = 8192;

constexpr int RING_OFF = 0, RING_BYTES = 131072;
constexpr int LDSCTL_OFF = RING_BYTES, MISC_OFF = LDSCTL_OFF + 320;
constexpr int LDS_BYTES = 163840;

#define LDS_WAIT() asm volatile("s_waitcnt lgkmcnt(0)" ::: "memory")

__device__ __forceinline__ unsigned cvt_pk(float lo, float hi) { return pg8::cvt_pk_bf16(lo, hi); }
__device__ __forceinline__ float bf_lo(unsigned u) { return __uint_as_float(u << 16); }
__device__ __forceinline__ float bf_hi(unsigned u) { return __uint_as_float(u & 0xffff0000u); }

#define XB_TMO      128
#define XB_XCNT(j)  (256  + 64 * (j))
#define XB_XSUB(j)  (1280 + 64 * (j))
#define XB_XGEN(j)  (2304 + 64 * (j))
#define XB_TOP      3328
#define XB_TOPGEN   3392
#define XCD_BAR_WORDS 3456
#define XB_SPIN_CAP (1u << 22)
__device__ __forceinline__ unsigned xb_ld(unsigned* p)              { return __hip_atomic_load(p, __ATOMIC_RELAXED, __HIP_MEMORY_SCOPE_AGENT); }
__device__ __forceinline__ unsigned xb_add(unsigned* p, unsigned v) { return __hip_atomic_fetch_add(p, v, __ATOMIC_RELAXED, __HIP_MEMORY_SCOPE_AGENT); }
__device__ __forceinline__ unsigned xb_xcc_id() { return (unsigned)__builtin_amdgcn_s_getreg((3 << 11) | 20) & 0xFu; }
#define XB_SPIN(cond, bar) do { unsigned _sp = 0; while (cond) { __builtin_amdgcn_s_sleep(1); \
    if ((++_sp & 255u) == 0u) { if (xb_ld(&(bar)[XB_TMO])) break; if (_sp > XB_SPIN_CAP) { atomicAdd(&(bar)[XB_TMO], 1u); break; } } } } while (0)
struct XcdBarrier { unsigned* bar; unsigned x; volatile LAS unsigned* st; };
__device__ __forceinline__ XcdBarrier xcd_barrier_post(unsigned* bar, volatile LAS unsigned* st) {
    XcdBarrier b; b.bar = bar; b.x = xb_xcc_id(); b.st = st;
    if (threadIdx.x == 0) (void)xb_add(&bar[XB_XCNT(b.x)], 1u);
    return b;
}
__device__ __forceinline__ void xcd_barrier_complete(unsigned* bar, unsigned x, unsigned& nloc, unsigned& nx) {
    const unsigned G = gridDim.x * gridDim.y * gridDim.z;
    unsigned sum, cnt, mine, sp = 0u;
    for (;;) {
        sum = 0u; cnt = 0u; mine = 0u;
#pragma unroll
        for (unsigned j = 0; j < 16; ++j) { const unsigned c = xb_ld(&bar[XB_XCNT(j)]); sum += c; cnt += (c > 0u) ? 1u : 0u; mine = (j == x) ? c : mine; }
        if (sum == G) break;
        __builtin_amdgcn_s_sleep(1);
        if ((++sp & 255u) == 0u) { if (xb_ld(&bar[XB_TMO])) break; if (sp > XB_SPIN_CAP) { atomicAdd(&bar[XB_TMO], 1u); break; } }
    }
    nloc = mine > 0u ? mine : 1u; nx = cnt > 0u ? cnt : 1u;
}
__device__ __forceinline__ void xcd_barrier(const XcdBarrier& b) {
    asm volatile("s_waitcnt vmcnt(0)" ::: "memory");
    __syncthreads();
    if (threadIdx.x == 0) {
        unsigned* bar = b.bar;
        __builtin_amdgcn_s_waitcnt(0);
        unsigned nloc = b.st[0], nx = b.st[1];
        if (nloc == 0u) { xcd_barrier_complete(bar, b.x, nloc, nx); b.st[0] = nloc; b.st[1] = nx; }
        const unsigned old = xb_add(&bar[XB_XSUB(b.x)], 1u);
        const unsigned gen = old / nloc;
        if (old + 1u == (gen + 1u) * nloc) {
            __builtin_amdgcn_fence(__ATOMIC_RELEASE, "agent");
            asm volatile("s_waitcnt vmcnt(0)" ::: "memory");
            const unsigned og = xb_add(&bar[XB_TOP], 1u);
            const unsigned tg = og / nx;
            if (og + 1u == (tg + 1u) * nx) xb_add(&bar[XB_TOPGEN], 1u);
            else XB_SPIN(xb_ld(&bar[XB_TOPGEN]) == tg, bar);
            __builtin_amdgcn_fence(__ATOMIC_ACQUIRE, "agent");
            xb_add(&bar[XB_XGEN(b.x)], 1u);
            asm volatile("s_waitcnt vmcnt(0)" ::: "memory");
        } else {
            XB_SPIN(xb_ld(&bar[XB_XGEN(b.x)]) == gen, bar);
            __builtin_amdgcn_fence(__ATOMIC_ACQUIRE, "agent");
            asm volatile("s_waitcnt vmcnt(0)" ::: "memory");
        }
    }
    __syncthreads();
}

template <int CTRL> __device__ __forceinline__ float dpp_mov(float v) { return __uint_as_float((unsigned)__builtin_amdgcn_update_dpp(0, (int)__float_as_uint(v), CTRL, 0xf, 0xf, true)); }
__device__ __forceinline__ float xor16_of(float v) { const u32x2 p = __builtin_amdgcn_permlane16_swap(__float_as_uint(v), __float_as_uint(v), false, false);
    return __uint_as_float(((threadIdx.x >> 4) & 1) ? p.x : p.y); }
__device__ __forceinline__ float xor32_of(float v) { const u32x2 p = __builtin_amdgcn_permlane32_swap(__float_as_uint(v), __float_as_uint(v), false, false);
    return __uint_as_float(((threadIdx.x >> 5) & 1) ? p.x : p.y); }
__device__ __forceinline__ float wave_sum(float v) {
    v += dpp_mov<0xB1>(v); v += dpp_mov<0x4E>(v); v += dpp_mov<0x141>(v); v += dpp_mov<0x140>(v);
    { const u32x2 p = __builtin_amdgcn_permlane16_swap(__float_as_uint(v), __float_as_uint(v), false, false); v = __uint_as_float(p.x) + __uint_as_float(p.y); }
    { const u32x2 p = __builtin_amdgcn_permlane32_swap(__float_as_uint(v), __float_as_uint(v), false, false); v = __uint_as_float(p.x) + __uint_as_float(p.y); }
    return v;
}
__device__ __forceinline__ float wave_max(float v) {
    v = fmaxf(v, dpp_mov<0xB1>(v)); v = fmaxf(v, dpp_mov<0x4E>(v)); v = fmaxf(v, dpp_mov<0x141>(v)); v = fmaxf(v, dpp_mov<0x140>(v));
    { const u32x2 p = __builtin_amdgcn_permlane16_swap(__float_as_uint(v), __float_as_uint(v), false, false); v = fmaxf(__uint_as_float(p.x), __uint_as_float(p.y)); }
    { const u32x2 p = __builtin_amdgcn_permlane32_swap(__float_as_uint(v), __float_as_uint(v), false, false); v = fmaxf(__uint_as_float(p.x), __uint_as_float(p.y)); }
    return v;
}

__device__ __forceinline__ void p0_transpose_item(const float* W, int N, bf16* WT, int ldt, LAS float* scr, int item, int lane, bool cvmap = false) {
    const int nblk = N / 32, kb = item / nblk, nb = item % nblk, k0 = 64 * kb, n0 = 32 * nb;
    int n0m = n0; if (cvmap && n0 >= 1024) { const int isv = n0 >= 2048, d = n0 - (isv ? 2048 : 1024); n0m = 1024 + 256 * (d >> 7) + 128 * isv + (d & 127); }
#pragma unroll 32
    for (int i = 0; i < 32; ++i) { const int kk = 2 * i + (lane >> 5); scr[kk * 33 + (lane & 31)] = W[(size_t)(k0 + kk) * N + n0 + (lane & 31)]; }
    LDS_WAIT(); asm volatile("" ::: "memory");
    const int c = lane & 7;
#pragma unroll
    for (int j = 0; j < 4; ++j) { const int n = (lane >> 3) + 8 * j; const LAS float* s = scr + (8 * c) * 33 + n;
        u32x4 o; o.x = cvt_pk(s[0 * 33], s[1 * 33]); o.y = cvt_pk(s[2 * 33], s[3 * 33]); o.z = cvt_pk(s[4 * 33], s[5 * 33]); o.w = cvt_pk(s[6 * 33], s[7 * 33]);
        *(u32x4*)(WT + (size_t)(n0m + n) * ldt + k0 + 8 * c) = o; }
    LDS_WAIT(); asm volatile("" ::: "memory");
}

__device__ __forceinline__ void adaln_item(const float* c, const float* cctx, const float* ada_w, const float* ada_b, float* mods, LAS float* lds, int u) {
    const int i = u / 96, n0 = (u % 96) * 64;
    LAS float* sc = lds;
    LAS float* red = lds + 17 * 1024;
    const int tid = threadIdx.x, lane = tid & 63, w = tid >> 6, kq = lane >> 4, cg = lane & 15;
    const int kb = w * 128 + kq * 32;
    const float* wp = ada_w + (size_t)i * 1024 * 6144 + (size_t)kb * 6144 + n0 + cg * 4;
    f32x4 wv[32];
#pragma unroll
    for (int j = 0; j < 32; ++j) wv[j] = *(const f32x4*)(wp + (size_t)j * 6144);
#pragma unroll 1
    for (int q0 = 0; q0 < 34; q0 += 17) { float cv[17];
#pragma unroll
      for (int q = 0; q < 17; ++q) { const int e = tid + 512 * (q0 + q); cv[q] = e < 16 * 1024 ? c[e] : cctx[e - 16 * 1024]; }
#pragma unroll
      for (int q = 0; q < 17; ++q) sc[tid + 512 * (q0 + q)] = cv[q] / (1.f + __expf(-cv[q])); }
    __syncthreads();
    f32x4 acc[17];
#pragma unroll
    for (int r = 0; r < 17; ++r) acc[r] = (f32x4){0.f, 0.f, 0.f, 0.f};
#pragma unroll
    for (int k0 = 0; k0 < 32; k0 += 8) {
#pragma unroll
        for (int r = 0; r < 17; ++r) {
            const f32x4 s0 = *(const LAS f32x4*)(sc + r * 1024 + kb + k0), s1 = *(const LAS f32x4*)(sc + r * 1024 + kb + k0 + 4);
            acc[r] += wv[k0 + 0] * s0.x; acc[r] += wv[k0 + 1] * s0.y; acc[r] += wv[k0 + 2] * s0.z; acc[r] += wv[k0 + 3] * s0.w;
            acc[r] += wv[k0 + 4] * s1.x; acc[r] += wv[k0 + 5] * s1.y; acc[r] += wv[k0 + 6] * s1.z; acc[r] += wv[k0 + 7] * s1.w;
        }
    }
#pragma unroll
    for (int r = 0; r < 17; ++r)
#pragma unroll
        for (int j = 0; j < 4; ++j) { float v = acc[r][j]; v += xor16_of(v); v += xor32_of(v); acc[r][j] = v; }
    if (kq == 0) {
#pragma unroll
        for (int r = 0; r < 17; ++r) *(LAS f32x4*)(red + (w * 17 + r) * 64 + cg * 4) = acc[r];
    }
    __syncthreads();
    for (int e = tid; e < 17 * 64; e += 512) { const int r = e >> 6, l = e & 63; float s = ada_b[i * 6144 + n0 + l];
#pragma unroll
        for (int g2 = 0; g2 < 8; ++g2) s += red[(g2 * 17 + r) * 64 + l];
        mods[(size_t)(i * 17 + r) * 6144 + n0 + l] = s; }
    __syncthreads();
}

__device__ __forceinline__ void wprime_item(const float* fn_w, const float* w_out, bf16* WOUT_T, LAS float* lds, int item) {
    const int g = item >> 4, n0 = (item & 15) * 64;
    LAS float* U = lds;
    LAS float* ctab = lds + 4096;
    const int tid = threadIdx.x, np = tid & 63, lg = __builtin_amdgcn_readfirstlane(tid >> 6);
    LAS float* FW = lds + 4096 + 64;
    if (tid < 64) ctab[tid] = cospif((float)tid * (1.f / 32.f));
    {
        float wv[64];
#pragma unroll
        for (int e = 0; e < 64; ++e) wv[e] = w_out[(size_t)(512 + 64 * g + e) * 1024 + n0 + np];
        { const f32x4* fp = (const f32x4*)(fn_w + (size_t)g * 4096) + tid * 2; const f32x4 f0 = fp[0], f1 = fp[1]; *(LAS f32x4*)(FW + tid * 8) = f0; *(LAS f32x4*)(FW + tid * 8 + 4) = f1; }
        __syncthreads();
#pragma unroll 2
        for (int l = lg * 8; l < lg * 8 + 8; ++l) { float s = 0.f; const LAS float* fr = FW + l * 64;
#pragma unroll
            for (int e4 = 0; e4 < 16; ++e4) { const f32x4 f = *(const LAS f32x4*)(fr + 4 * e4); s += f.x * wv[4 * e4] + f.y * wv[4 * e4 + 1] + f.z * wv[4 * e4 + 2] + f.w * wv[4 * e4 + 3]; }
            U[l * 64 + np] = s; }
    }
    __syncthreads();
    const float sN = 0.0027621358640099515f;
    const int n4 = tid & 15, rg = tid >> 4;
    f32x4 acc[4];
#pragma unroll
    for (int q = 0; q < 4; ++q) acc[q] = (f32x4){0.f, 0.f, 0.f, 0.f};
#pragma unroll 4
    for (int l = 0; l < 64; ++l) { const f32x4 uv = *(const LAS f32x4*)(U + l * 64 + n4 * 4);
#pragma unroll
        for (int q = 0; q < 4; ++q) { const int row = rg * 4 + q, part = row >> 6, cch = row & 63, m = (l * cch) & 63; acc[q] += uv * ctab[part ? ((m - 16) & 63) : m]; } }
#pragma unroll
    for (int q = 0; q < 4; ++q) { const int row = rg * 4 + q, part = row >> 6, cch = row & 63; const float sg = part ? -sN : sN;
#pragma unroll
        for (int j = 0; j < 4; ++j) WOUT_T[(size_t)(n0 + n4 * 4 + j) * 1536 + 512 + part * 512 + g * 64 + cch] = (bf16)(cvt_pk(acc[q][j] * sg, 0.f) & 0xffffu); }
    __syncthreads();
}

struct Args { const float* in[20]; float* out; unsigned char* ws; int ph_lo, ph_hi, li, pad; };

constexpr int CW_TABQ = 64;
__device__ __forceinline__ void phase_prep(const Args& a, LAS unsigned char* lds, int G, int wg, int rep, int part) {
#define PSUB(k) (rep == 0 || PROBE_SUB == 0 || PROBE_SUB == (k))
    const int tid = threadIdx.x, lane = tid & 63, wave = __builtin_amdgcn_readfirstlane(tid >> 6);
    unsigned char* ws = a.ws;
    if (PSUB(1) && part == 0) for (int u = wg; u < 192; u += G) adaln_item(a.in[1], a.in[3], a.in[4], a.in[5], (float*)(ws + WS_MOD), (LAS float*)lds, u);
    if (PSUB(1) && part == 0) {
        if (G >= 256) { const int nfree = G - 192; if (wg >= 192) for (int u = wg - 192; u < 128; u += nfree) wprime_item(a.in[12], a.in[10], (bf16*)(ws + WS_WOUT_T), (LAS float*)lds, u); }
        else for (int u = G - 1 - wg; u < 128; u += G) wprime_item(a.in[12], a.in[10], (bf16*)(ws + WS_WOUT_T), (LAS float*)lds, u);
    }
    if (PSUB(2)) {
        LAS float* scr = (LAS float*)(lds + wave * 16384);
        const int gw = ((wg + G / 2) % G) * NWAVES + wave, NGW = G * NWAVES;
        constexpr int I_WIN = 16 * 64, I_WO = 8 * 32, I_CVI = 16 * 96, I_CVO = 16 * 32, I_WQ = 16 * 64;
        constexpr int NIT = I_WIN + I_WO + I_CVI + I_CVO + 2 * I_WQ;
        for (int it = gw; it < NIT; it += NGW) {
            if ((part == 0) != (it >= I_WIN + I_WO + I_CVI + I_CVO)) continue;
            int r = it;
            if (r < I_WIN) { p0_transpose_item(a.in[9], 2048, (bf16*)(ws + WS_WIN_T), 1024, scr, r, lane); continue; } r -= I_WIN;
            if (r < I_WO) { p0_transpose_item(a.in[10], 1024, (bf16*)(ws + WS_WOUT_T), 1536, scr, r, lane); continue; } r -= I_WO;
            if (r < I_CVI) { p0_transpose_item(a.in[13], 3072, (bf16*)(ws + WS_CVIN_T), 1024, scr, r, lane, true); continue; } r -= I_CVI;
            if (r < I_CVO) { p0_transpose_item(a.in[15], 1024, (bf16*)(ws + WS_CVOUT_T), 1024, scr, r, lane); continue; } r -= I_CVO;
            {
              const int L = r >= I_WQ ? 1 : 0, it2 = r - L * I_WQ, kb = it2 / 64, nb = it2 % 64;
              const float* wp = a.in[16] + ((size_t)L * 1024 + kb * 64 + (lane >> 5) * 32) * 2048 + nb * 32 + (lane & 31); float am = 0.f;
#pragma unroll 32
              for (int k = 0; k < 32; ++k) am = fmaxf(am, fabsf(wp[(size_t)k * 2048]));
              am = fmaxf(am, xor32_of(am));
              if (lane < 32) atomicMax((unsigned*)(ws + WS_CTL) + CW_COLMAX + L * 2048 + nb * 32 + lane, __float_as_uint(am)); }
        }
    }
    __syncthreads();
    if (PSUB(3) && part == 1) {
        LAS float* tab = (LAS float*)lds;
        for (int m = tid; m < 2048; m += 512) tab[m] = cospif((float)m * (1.f / 1024.f));
        __syncthreads();
        bf16* DFT = (bf16*)(ws + WS_DFT);
        for (int item = wg * 512 + tid; item < 2048 * 256; item += G * 512) {
            const int kp = item >> 8, n0 = (item & 255) * 8, k = kp & 1023, sh = (kp >> 10) ? 512 : 0;
            float v[8];
#pragma unroll
            for (int j = 0; j < 8; ++j) v[j] = tab[(k * (n0 + j) - sh) & 2047];
            u32x4 o; o.x = cvt_pk(v[0], v[1]); o.y = cvt_pk(v[2], v[3]); o.z = cvt_pk(v[4], v[5]); o.w = cvt_pk(v[6], v[7]);
            *(u32x4*)(DFT + (size_t)kp * 2048 + n0) = o;
        }
    }
    if (PSUB(4) && part == 1) {
        const size_t gt = (size_t)wg * 512 + tid, NT = (size_t)G * 512;
        const f32x4* s = (const f32x4*)a.in[17]; u32x2* d = (u32x2*)(ws + WS_KEYS);
        for (size_t i = gt; i < (size_t)2 * 8 * 2 * 128 * 128 / 4; i += NT) { const f32x4 x = s[i]; u32x2 o; o.x = cvt_pk(x[0], x[1]); o.y = cvt_pk(x[2], x[3]); d[i] = o; }
    }
#undef PSUB
}

template <bool XBF>
__device__ __forceinline__ void norm_rows4(const void* xrow, const float* g, const float* sh, const float* sc, bf16* orow, unsigned char* hq, unsigned char* hq8, float* hs, int lane) {
    f32x4 v[4][4];
#pragma unroll
    for (int q = 0; q < 4; ++q)
#pragma unroll
        for (int j = 0; j < 4; ++j) {
            if (XBF) { const u32x2 w = ((const u32x2*)((const bf16*)xrow + q * 1024))[lane + 64 * j]; v[q][j] = (f32x4){bf_lo(w.x), bf_hi(w.x), bf_lo(w.y), bf_hi(w.y)}; }
            else v[q][j] = ((const f32x4*)((const float*)xrow + q * 1024))[lane + 64 * j]; }
    f32x4 gsc[4], gsh[4];
#pragma unroll
    for (int j = 0; j < 4; ++j) { const f32x4 gg = ((const f32x4*)g)[lane + 64 * j], a = ((const f32x4*)sh)[lane + 64 * j], b = ((const f32x4*)sc)[lane + 64 * j]; gsc[j] = gg * (b + 1.0f); gsh[j] = a; }
    float s[4];
#pragma unroll
    for (int q = 0; q < 4; ++q) { s[q] = 0.f;
#pragma unroll
        for (int j = 0; j < 4; ++j) s[q] += (v[q][j].x * v[q][j].x + v[q][j].y * v[q][j].y) + (v[q][j].z * v[q][j].z + v[q][j].w * v[q][j].w); }
#pragma unroll
    for (int q = 0; q < 4; ++q) s[q] = wave_sum(s[q]);
    float am[4];
#pragma unroll
    for (int q = 0; q < 4; ++q) { const float r = 1.0f / sqrtf(s[q] * (1.f / 1024.f) + 1e-6f); am[q] = 0.f;
#pragma unroll
        for (int j = 0; j < 4; ++j) { const f32x4 y = (v[q][j] * r) * gsc[j] + gsh[j]; v[q][j] = y;
            am[q] = fmaxf(am[q], fmaxf(fmaxf(fabsf(y.x), fabsf(y.y)), fmaxf(fabsf(y.z), fabsf(y.w))));
            if (orow) { u32x2 w; w.x = cvt_pk(y.x, y.y); w.y = cvt_pk(y.z, y.w); ((u32x2*)(orow + q * 1024))[lane + 64 * j] = w; } } }
    if (hq) {
#pragma unroll
        for (int q = 0; q < 4; ++q) am[q] = wave_max(am[q]);
        float qs[4];
#pragma unroll
        for (int q = 0; q < 4; ++q) { const float inv = am[q] > 0.f ? 119.0f / am[q] : 0.f; qs[q] = 0.f;
            unsigned char* hqr = hq + q * 1024; unsigned char* h8r = hq8 + q * 1024;
#pragma unroll
            for (int j = 0; j < 4; ++j) { unsigned whi = 0u, wlo = 0u, w8 = 0u;
#pragma unroll
                for (int z = 0; z < 4; ++z) { const int q8 = (int)rintf(v[q][j][z] * inv); const int hi = (q8 + 8) >> 4, lo = q8 - 16 * hi; qs[q] += (float)q8;
                    whi |= ((unsigned)hi & 15u) << (4 * z); wlo |= ((unsigned)lo & 15u) << (4 * z); w8 |= ((unsigned)q8 & 255u) << (8 * z); }
                ((unsigned short*)hqr)[lane + 64 * j] = (unsigned short)whi; ((unsigned short*)(hqr + 512))[lane + 64 * j] = (unsigned short)wlo; ((unsigned*)h8r)[lane + 64 * j] = w8; } }
#pragma unroll
        for (int q = 0; q < 4; ++q) qs[q] = wave_sum(qs[q]);
        if (lane == 0) {
#pragma unroll
            for (int q = 0; q < 4; ++q) { hs[2 * q] = am[q] * (1.0f / 119.0f); hs[2 * q + 1] = qs[q]; } }
    }
}
template <bool XBF>
__device__ __forceinline__ void phase_norm(const void* xsrc, const float* ctx, const float* gvec, const float* modsL, int c0, bf16* H, unsigned char* HQ, unsigned char* HQ8, float* HS, int G, int wg) {
    const int lane = threadIdx.x & 63, wave = __builtin_amdgcn_readfirstlane(threadIdx.x >> 6);
    const int gw = wg * NWAVES + wave, NGW = G * NWAVES;
    const int nrows = ctx ? NTT : NTOK;
#pragma unroll 1
    for (int m = 4 * gw; m < nrows; m += 4 * NGW) {
        const void* xr; int mr;
        if (m < NTOK) { xr = XBF ? (const void*)((const bf16*)xsrc + (size_t)m * D) : (const void*)((const float*)xsrc + (size_t)m * D); mr = m >> 11; } else { xr = ctx + (size_t)(m - NTOK) * D; mr = 16; }
        const float* mp = modsL + (size_t)mr * 6144 + c0 * 1024;
        norm_rows4<XBF>(xr, gvec, mp, mp + 1024, H ? H + (size_t)m * D : nullptr, HQ ? HQ + (size_t)m * 1024 : nullptr, HQ8 + (size_t)m * 1024, HS + 2 * (size_t)m, lane);
    }
}

__device__ __forceinline__ void wq8_transpose_item(const float* W, const float* colmax, unsigned char* WT8, LAS float* scr, int item, int lane) {
    const int kb = item / 64, nb = item % 64, k0 = 64 * kb, n0 = 32 * nb;
#pragma unroll 32
    for (int i = 0; i < 32; ++i) { const int kk = 2 * i + (lane >> 5); scr[kk * 33 + (lane & 31)] = W[(size_t)(k0 + kk) * 2048 + n0 + (lane & 31)]; }
    LDS_WAIT(); asm volatile("" ::: "memory");
    const int c = lane & 7;
#pragma unroll
    for (int j = 0; j < 4; ++j) { const int n = (lane >> 3) + 8 * j; const LAS float* sp = scr + (8 * c) * 33 + n;
        const float cm = colmax[n0 + n], inv = cm > 0.f ? 127.0f / cm : 0.f;
        unsigned w0 = 0u, w1 = 0u;
#pragma unroll
        for (int z = 0; z < 4; ++z) { w0 |= ((unsigned)(int)rintf(sp[z * 33] * inv) & 255u) << (8 * z); w1 |= ((unsigned)(int)rintf(sp[(4 + z) * 33] * inv) & 255u) << (8 * z); }
        u32x2 o; o.x = w0; o.y = w1;
        *(u32x2*)(WT8 + (size_t)(n0 + n) * 1024 + k0 + 8 * c) = o; }
    LDS_WAIT(); asm volatile("" ::: "memory");
}
__device__ __forceinline__ void phase_wq8(const float* wq, const float* colmax, unsigned char* WQ8, LAS unsigned char* lds, int G, int wg) {
    const int lane = threadIdx.x & 63, wave = __builtin_amdgcn_readfirstlane(threadIdx.x >> 6);
    LAS float* scr = (LAS float*)(lds + wave * 16384);
    for (int it = wg * NWAVES + wave; it < 2 * 1024; it += G * NWAVES) { const int L = it >> 10;
        wq8_transpose_item(wq + (size_t)L * 1024 * 2048, colmax + L * 2048, WQ8 + (size_t)L * 2048 * 1024, scr, it & 1023, lane); }
}

typedef float f32x16 __attribute__((ext_vector_type(16)));
struct AttnRaw { u32x4 k[4]; u32x4 v[4]; };
constexpr int ATT_KPITCH = 144, ATT_VPITCH = 72, ATT_WAVE_LDS = 32 * ATT_KPITCH + 64 * ATT_VPITCH;
__device__ __forceinline__ void na_load_raw(AttnRaw& f, const bf16* QK, const bf16* VT, const bf16* VTC, int b, int h, int t, int nrows, int sr0, int c32, int lane) {
    const bf16* kp; const bf16* vp; size_t vpitch;
    if (t < nrows) { const int kr = sr0 + t;
        kp = QK + ((size_t)b * 2048 + kr * 64 + c32 + (lane >> 3)) * 1024 + 512 + h * 64 + (lane & 7) * 8;
        vp = VT + (size_t)(b * 512 + h * 64 + (lane >> 2)) * 2048 + kr * 64 + c32 + (lane & 3) * 8; vpitch = 2048; }
    else { const int u = t - nrows;
        kp = QK + ((size_t)NTOK + b * 256 + 32 * u + (lane >> 3)) * 1024 + 512 + h * 64 + (lane & 7) * 8;
        vp = VTC + (size_t)(b * 512 + h * 64 + (lane >> 2)) * 256 + 32 * u + (lane & 3) * 8; vpitch = 256; }
#pragma unroll
    for (int q = 0; q < 4; ++q) { f.k[q] = *(const u32x4*)(kp + (size_t)q * 8 * 1024); f.v[q] = *(const u32x4*)(vp + (size_t)q * 16 * vpitch); }
}
__device__ __forceinline__ void na_stage(const AttnRaw& f, LAS unsigned char* kl, LAS unsigned char* vl, int lane) {
#pragma unroll
    for (int q = 0; q < 4; ++q) {
        *(LAS u32x4*)(kl + (8 * q + (lane >> 3)) * ATT_KPITCH + (lane & 7) * 16) = f.k[q];
        LAS unsigned char* vd = vl + (16 * q + (lane >> 2)) * ATT_VPITCH + (lane & 3) * 16;
        u32x2 lo, hi2; lo.x = f.v[q].x; lo.y = f.v[q].y; hi2.x = f.v[q].z; hi2.y = f.v[q].w;
        *(LAS u32x2*)vd = lo; *(LAS u32x2*)(vd + 8) = hi2;
    }
}
__device__ __forceinline__ void na_attn32_wave(const bf16* QK, const bf16* VT, const bf16* VTC, const LAS float* rpl, LAS unsigned char* wl, bf16* A2, int b, int h, int r0, int qb, int lane) {
    const int j = lane & 31, hi = lane >> 5;
    const int c0 = qb * 16;
    const int c32 = qb == 0 ? 0 : (qb == 1 ? 8 : (qb == 2 ? 24 : 32));
    const int qrow = r0 + (j >> 4), cq = c0 + (j & 15);
    const int srq = min(max(qrow - 4, 0), 24), cs = min(max(cq - 8, 0), 48);
    const int sr0 = min(max(r0 - 4, 0), 24), sr1 = min(max(r0 - 3, 0), 24);
    const int nrows = sr1 + 8 - sr0, ntiles = nrows + 8;
    const size_t tq = (size_t)b * 2048 + qrow * 64 + cq;
    LAS unsigned char* kl = wl; LAS unsigned char* vl = wl + 32 * ATT_KPITCH;
    bf16x8 qf[4];
#pragma unroll
    for (int ks = 0; ks < 4; ++ks) qf[ks] = *(const bf16x8*)(QK + tq * 1024 + h * 64 + 16 * ks + 8 * hi);
    f32x16 o0, o1;
#pragma unroll
    for (int v = 0; v < 16; ++v) { o0[v] = 0.f; o1[v] = 0.f; }
    float m_run = -1e30f, l_run = 0.f;
    AttnRaw raw;
    na_load_raw(raw, QK, VT, VTC, b, h, 0, nrows, sr0, c32, lane);
#pragma unroll 2
    for (int t = 0; t < ntiles; ++t) {
        na_stage(raw, kl, vl, lane);
        if (t + 1 < ntiles) na_load_raw(raw, QK, VT, VTC, b, h, t + 1, nrows, sr0, c32, lane);
        f32x16 sv;
#pragma unroll
        for (int v = 0; v < 16; ++v) sv[v] = 0.f;
#pragma unroll
        for (int ks = 0; ks < 4; ++ks) { const bf16x8 kf = *(const LAS bf16x8*)(kl + j * ATT_KPITCH + (2 * ks + hi) * 16);
            sv = __builtin_amdgcn_mfma_f32_32x32x16_bf16(kf, qf[ks], sv, 0, 0, 0); }
        if (t < nrows) {
            const int kr = sr0 + t;
            const bool rok = (kr >= srq) && (kr < srq + 8);
            const LAS float* rrow = rpl + min(max(kr - qrow + 7, 0), 14) * 31;
            float bias[16];
#pragma unroll
            for (int v = 0; v < 16; ++v) { const int kc = c32 + 8 * (v >> 2) + 4 * hi + (v & 3); bias[v] = rrow[min(max(kc - cq + 15, 0), 30)]; }
            asm volatile("" : "+v"(bias[0]), "+v"(bias[1]), "+v"(bias[2]), "+v"(bias[3]), "+v"(bias[4]), "+v"(bias[5]), "+v"(bias[6]), "+v"(bias[7]));
            asm volatile("" : "+v"(bias[8]), "+v"(bias[9]), "+v"(bias[10]), "+v"(bias[11]), "+v"(bias[12]), "+v"(bias[13]), "+v"(bias[14]), "+v"(bias[15]));
#pragma unroll
            for (int v = 0; v < 16; ++v) { const int kc = c32 + 8 * (v >> 2) + 4 * hi + (v & 3); const bool ok = rok && (kc >= cs) && (kc < cs + 16);
                sv[v] = ok ? sv[v] + bias[v] : -INFINITY; }
        }
        float mx = sv[0];
#pragma unroll
        for (int v = 1; v < 16; ++v) mx = fmaxf(mx, sv[v]);
        mx = fmaxf(mx, xor32_of(mx));
        const float m_new = fmaxf(m_run, mx);
        const float alpha = __expf(m_run - m_new);
        float ps = 0.f;
#pragma unroll
        for (int v = 0; v < 16; ++v) { const float p = __expf(sv[v] - m_new); sv[v] = p; ps += p; }
        l_run = l_run * alpha + ps; m_run = m_new;
#pragma unroll
        for (int v = 0; v < 16; ++v) { o0[v] *= alpha; o1[v] *= alpha; }
#pragma unroll
        for (int st = 0; st < 2; ++st) {
            u32x4 pw; pw.x = cvt_pk(sv[8 * st], sv[8 * st + 1]); pw.y = cvt_pk(sv[8 * st + 2], sv[8 * st + 3]); pw.z = cvt_pk(sv[8 * st + 4], sv[8 * st + 5]); pw.w = cvt_pk(sv[8 * st + 6], sv[8 * st + 7]);
            const bf16x8 pf = __builtin_bit_cast(bf16x8, pw);
#pragma unroll
            for (int dt = 0; dt < 2; ++dt) {
                const LAS unsigned char* vr = vl + (32 * dt + j) * ATT_VPITCH + 32 * st + 8 * hi;
                const u32x2 lo = *(const LAS u32x2*)vr, h2 = *(const LAS u32x2*)(vr + 16);
                u32x4 vw; vw.x = lo.x; vw.y = lo.y; vw.z = h2.x; vw.w = h2.y;
                if (dt == 0) o0 = __builtin_amdgcn_mfma_f32_32x32x16_bf16(__builtin_bit_cast(bf16x8, vw), pf, o0, 0, 0, 0);
                else o1 = __builtin_amdgcn_mfma_f32_32x32x16_bf16(__builtin_bit_cast(bf16x8, vw), pf, o1, 0, 0, 0);
            }
        }
    }
    l_run += xor32_of(l_run);
    const float inv = 1.0f / l_run;
    bf16* orow = A2 + tq * 1536 + h * 64 + 4 * hi;
#pragma unroll
    for (int g = 0; g < 4; ++g) {
        u32x2 w; w.x = cvt_pk(o0[4 * g] * inv, o0[4 * g + 1] * inv); w.y = cvt_pk(o0[4 * g + 2] * inv, o0[4 * g + 3] * inv); *(u32x2*)(orow + 8 * g) = w;
        w.x = cvt_pk(o1[4 * g] * inv, o1[4 * g + 1] * inv); w.y = cvt_pk(o1[4 * g + 2] * inv, o1[4 * g + 3] * inv); *(u32x2*)(orow + 32 + 8 * g) = w;
    }
}

__device__ __forceinline__ int f2key(float f) { const int b = (int)__float_as_uint(f); return b ^ ((b >> 31) & 0x7fffffff); }
__device__ __forceinline__ float key2f(int k) { return __uint_as_float((unsigned)(k ^ ((k >> 31) & 0x7fffffff))); }
__device__ __forceinline__ void ce_desc(int& a, int& b) { const int t = max(a, b); b = min(a, b); a = t; }
__device__ __forceinline__ void sort16_desc(int (&v)[16]) {
#define CE(a, b) ce_desc(v[a], v[b])
    CE(0, 13); CE(1, 12); CE(2, 15); CE(3, 14); CE(4, 8); CE(5, 6); CE(7, 11); CE(9, 10);
    CE(0, 5); CE(1, 7); CE(2, 9); CE(3, 4); CE(6, 13); CE(8, 14); CE(10, 15); CE(11, 12);
    CE(0, 1); CE(2, 3); CE(4, 5); CE(6, 8); CE(7, 9); CE(10, 11); CE(12, 13); CE(14, 15);
    CE(0, 2); CE(1, 3); CE(4, 10); CE(5, 11); CE(6, 7); CE(8, 9); CE(12, 14); CE(13, 15);
    CE(1, 2); CE(3, 12); CE(4, 6); CE(5, 7); CE(8, 10); CE(9, 11); CE(13, 14);
    CE(1, 4); CE(2, 6); CE(5, 8); CE(7, 10); CE(9, 13); CE(11, 14);
    CE(2, 4); CE(3, 6); CE(9, 12); CE(11, 13);
    CE(3, 5); CE(6, 8); CE(7, 9); CE(10, 12);
    CE(3, 4); CE(5, 6); CE(7, 8); CE(9, 10); CE(11, 12);
    CE(6, 7); CE(8, 9);
#undef CE
}
template <int N> __device__ __forceinline__ void bitonic_merge_desc(int (&v)[N]) {
#pragma unroll
    for (int j = N >> 1; j > 0; j >>= 1) {
#pragma unroll
        for (int i = 0; i < N; ++i) { const int l = i ^ j; if (l > i) ce_desc(v[i], v[l]); }
    }
}
template <int X> __device__ __forceinline__ void topk_cross_max(int (&v)[16]) {
#pragma unroll
    for (int i = 0; i < 8; ++i) { const int j = 15 - i;
        u32x2 s1, s2;
        if (X == 16) { s1 = __builtin_amdgcn_permlane16_swap((unsigned)v[i], (unsigned)v[j], false, false); s2 = __builtin_amdgcn_permlane16_swap((unsigned)v[j], (unsigned)v[i], false, false); }
        else { s1 = __builtin_amdgcn_permlane32_swap((unsigned)v[i], (unsigned)v[j], false, false); s2 = __builtin_amdgcn_permlane32_swap((unsigned)v[j], (unsigned)v[i], false, false); }
        v[i] = max((int)s1.x, (int)s2.y); v[j] = max((int)s2.x, (int)s1.y); }
}
constexpr int TOPK_LDS_PER_WAVE = 16 * 52 * 4;
constexpr int TOPK_KROW = 136;
__device__ __forceinline__ void peer_topk_wave(const bf16x8 (&qfa)[2][4], const LAS bf16* KL, int* sel_e, float* sel_g, int t0, int h, int lane, LAS int* scr) {
    const int fr = lane & 15, fq = lane >> 4;
    int top[2][16];
#pragma unroll
    for (int p = 0; p < 2; ++p) {
        int lo[16], hi[16];
#pragma unroll
        for (int t = 0; t < 8; ++t) {
            f32x4 av = (f32x4){0.f, 0.f, 0.f, 0.f};
#pragma unroll
            for (int ks = 0; ks < 4; ++ks) { const bf16x8 kf = *(const LAS bf16x8*)(KL + (p * 128 + t * 16 + fr) * TOPK_KROW + ks * 32 + fq * 8);
                av = __builtin_amdgcn_mfma_f32_16x16x32_bf16(kf, qfa[p][ks], av, 0, 0, 0); }
#pragma unroll
            for (int j = 0; j < 4; ++j) { const int n = 16 * t + 4 * fq + j; const int key = (f2key(av[j]) & ~127) | n;
                if (t < 4) lo[4 * t + j] = key; else hi[4 * (t - 4) + j] = key; }
        }
        sort16_desc(lo); sort16_desc(hi);
#pragma unroll
        for (int i = 0; i < 16; ++i) lo[i] = max(lo[i], hi[15 - i]);
        bitonic_merge_desc<16>(lo);
        topk_cross_max<16>(lo); bitonic_merge_desc<16>(lo);
        topk_cross_max<32>(lo); bitonic_merge_desc<16>(lo);
#pragma unroll
        for (int i = 0; i < 16; ++i) top[p][i] = lo[i];
    }
    const bool b0 = (fq & 1) != 0, b1 = (fq & 2) != 0;
    const int gbase = b1 ? (b0 ? 42 : 29) : (b0 ? 16 : 0);
    LAS int* tb = scr + fr * 52;
    int g0[16];
    {
        constexpr signed char TI[4][16] = {{0,0,0,0,0,0,0,0,0,0,0,0,0,0,0,0}, {1,1,1,1,1,1,1,1,2,2,2,2,2,-1,-1,-1}, {3,3,3,3,4,4,4,5,5,6,6,7,7,-1,-1,-1}, {8,9,10,11,12,13,14,15,-1,-1,-1,-1,-1,-1,-1,-1}};
        constexpr signed char TJ[4][16] = {{0,1,2,3,4,5,6,7,8,9,10,11,12,13,14,15}, {0,1,2,3,4,5,6,7,0,1,2,3,4,-1,-1,-1}, {0,1,2,3,0,1,2,0,1,0,1,0,1,-1,-1,-1}, {0,0,0,0,0,0,0,0,-1,-1,-1,-1,-1,-1,-1,-1}};
#pragma unroll
        for (int sl = 0; sl < 16; ++sl) {
            const int ka0 = top[0][TI[0][sl]], ka1 = top[0][TI[1][sl] < 0 ? 0 : TI[1][sl]], ka2 = top[0][TI[2][sl] < 0 ? 0 : TI[2][sl]], ka3 = top[0][TI[3][sl] < 0 ? 0 : TI[3][sl]];
            const int kb0 = top[1][TJ[0][sl]], kb1 = top[1][TJ[1][sl] < 0 ? 0 : TJ[1][sl]], kb2 = top[1][TJ[2][sl] < 0 ? 0 : TJ[2][sl]], kb3 = top[1][TJ[3][sl] < 0 ? 0 : TJ[3][sl]];
            const int ka = b1 ? (b0 ? ka3 : ka2) : (b0 ? ka1 : ka0), kb = b1 ? (b0 ? kb3 : kb2) : (b0 ? kb1 : kb0);
            const bool pad = b1 ? (b0 ? (TI[3][sl] < 0) : (TI[2][sl] < 0)) : (b0 ? (TI[1][sl] < 0) : false);
            const int key = (f2key(key2f(ka) + key2f(kb)) & ~63) | (49 - gbase - sl);
            g0[sl] = pad ? (int)0x80000000 : key;
            tb[pad ? 51 : gbase + sl] = (ka & 127) * 128 + (kb & 127);
        }
    }
    sort16_desc(g0);
    topk_cross_max<16>(g0); bitonic_merge_desc<16>(g0);
    topk_cross_max<32>(g0); bitonic_merge_desc<16>(g0);
    int kmax = g0[0];
#pragma unroll
    for (int i = 1; i < 16; ++i) kmax = max(kmax, g0[i]);
    const float mx = key2f(kmax);
    float wv[16]; float sum = 0.f;
#pragma unroll
    for (int i = 0; i < 16; ++i) { wv[i] = __expf(key2f(g0[i]) - mx); sum += wv[i]; }
    const float inv = 1.0f / sum;
    LDS_WAIT(); asm volatile("" ::: "memory");
    int we[16];
#pragma unroll
    for (int i = 0; i < 16; ++i) we[i] = tb[49 - (g0[i] & 63)];
    if (fq == 0) {
        int* ep = sel_e + ((size_t)(t0 + fr) * 8 + h) * 16; float* gp = sel_g + ((size_t)(t0 + fr) * 8 + h) * 16;
#pragma unroll
        for (int rd = 0; rd < 16; ++rd) { ep[rd] = we[rd]; gp[rd] = wv[rd] * inv; }
    }
    LDS_WAIT(); asm volatile("" ::: "memory");
}

__device__ __forceinline__ void phase_topk(LAS unsigned char* lds, const bf16* Q, const bf16* KEYS, int* sel_e, float* sel_g, const float* tdown, const float* tup, unsigned char* tab4, float* tsc, int G, int wg) {
    const int tid = threadIdx.x, lane = tid & 63, wave = __builtin_amdgcn_readfirstlane(tid >> 6), fr = lane & 15, fq = lane >> 4;
    LAS bf16* KL = (LAS bf16*)lds;
    LAS int* scr = (LAS int*)(lds + 2 * 128 * TOPK_KROW * 2 + wave * TOPK_LDS_PER_WAVE);
    const int nh = (G % 8 == 0) ? 1 : 8;
#pragma unroll 1
    for (int hh = 0; hh < nh; ++hh) {
        const int h = (nh == 1) ? (wg & 7) : hh;
        const int nwh = (nh == 1) ? (G >> 3) : G, wi = (nh == 1) ? (wg >> 3) : wg;
        __syncthreads();
        for (int p = tid; p < 4096; p += 512) { const int row = p >> 4, c16 = p & 15;
            *(LAS u32x4*)(KL + row * TOPK_KROW + c16 * 8) = *(const u32x4*)(KEYS + (size_t)(h * 256 + row) * 128 + c16 * 8); }
        __syncthreads();
        int b = wave * nwh + wi;
        bf16x8 qn[2][4];
        if (b < 2048) {
#pragma unroll
            for (int p = 0; p < 2; ++p)
#pragma unroll
                for (int ks = 0; ks < 4; ++ks) qn[p][ks] = *(const bf16x8*)(Q + (size_t)(b * 16 + fr) * 2048 + h * 256 + p * 128 + ks * 32 + fq * 8);
        }
        const int gw = wg * NWAVES + wave, NGW = G * NWAVES;
        int trow = (hh == 0) ? gw : 32768;
#define TOPK_ROW_PTR(R) ((const f32x4*)((((R) < 16384) ? tdown : tup) + (size_t)((R) & 16383) * 1024) + lane * 4)
#define TOPK_ROW_STORE(R, X) do { u32x2 pk; float scv; \
            if ((R) < 16384) {     \
                float ss = 0.f, am = 0.f; \
                _Pragma("unroll") for (int q = 0; q < 4; ++q) { ss += (X[q][0] * X[q][0] + X[q][1] * X[q][1]) + (X[q][2] * X[q][2] + X[q][3] * X[q][3]); \
                    am = fmaxf(am, fmaxf(fmaxf(fabsf(X[q][0]), fabsf(X[q][1])), fmaxf(fabsf(X[q][2]), fabsf(X[q][3])))); } \
                ss = wave_sum(ss); am = wave_max(am); \
                scv = fmaxf(0.35f * sqrtf(ss * (1.0f / 1024.0f)), am * (1.0f / 16.0f)); const float inv = scv > 0.f ? 1.0f / scv : 0.f; \
                unsigned w0 = 0u, w1 = 0u; \
                _Pragma("unroll") for (int q = 0; q < 4; ++q) _Pragma("unroll") for (int z = 0; z < 4; ++z) { \
                    const int cd = min(max((int)floorf(X[q][z] * inv), -8), 7); const unsigned nb = (unsigned)cd & 15u; \
                    if (q < 2) w0 |= nb << (4 * (4 * q + z)); else w1 |= nb << (4 * (4 * (q - 2) + z)); } \
                pk.x = w0; pk.y = w1; \
            } else {               \
                float am = 0.f; \
                _Pragma("unroll") for (int q = 0; q < 4; ++q) am = fmaxf(am, fmaxf(fmaxf(fabsf(X[q][0]), fabsf(X[q][1])), fmaxf(fabsf(X[q][2]), fabsf(X[q][3])))); \
                am = wave_max(am); \
                const float inv = am > 0.f ? 6.0f / am : 0.f; unsigned p0 = 0u, p1 = 0u; \
                p0 = __builtin_amdgcn_cvt_scalef32_pk_fp4_f32(p0, X[0][0] * inv, X[0][1] * inv, 1.0f, 0); p0 = __builtin_amdgcn_cvt_scalef32_pk_fp4_f32(p0, X[0][2] * inv, X[0][3] * inv, 1.0f, 1); \
                p0 = __builtin_amdgcn_cvt_scalef32_pk_fp4_f32(p0, X[1][0] * inv, X[1][1] * inv, 1.0f, 2); p0 = __builtin_amdgcn_cvt_scalef32_pk_fp4_f32(p0, X[1][2] * inv, X[1][3] * inv, 1.0f, 3); \
                p1 = __builtin_amdgcn_cvt_scalef32_pk_fp4_f32(p1, X[2][0] * inv, X[2][1] * inv, 1.0f, 0); p1 = __builtin_amdgcn_cvt_scalef32_pk_fp4_f32(p1, X[2][2] * inv, X[2][3] * inv, 1.0f, 1); \
                p1 = __builtin_amdgcn_cvt_scalef32_pk_fp4_f32(p1, X[3][0] * inv, X[3][1] * inv, 1.0f, 2); p1 = __builtin_amdgcn_cvt_scalef32_pk_fp4_f32(p1, X[3][2] * inv, X[3][3] * inv, 1.0f, 3); \
                pk.x = p0; pk.y = p1; scv = am * (1.0f / 6.0f); } \
            *((u32x2*)(tab4 + (((R) < 16384) ? (size_t)0 : (size_t)8 * MiB) + (size_t)(lane >> 4) * (2 * MiB) + (size_t)((R) & 16383) * 128) + (lane & 15)) = pk; \
            if (lane == 0) tsc[R] = scv; } while (0)
#pragma unroll 1
        for (; b < 2048; b += 8 * nwh) {
            f32x4 tx0[4], tx1[4]; const int ra = trow, rb = trow + NGW; const bool t0 = ra < 32768, t1 = rb < 32768;
            if (t0) { const f32x4* sp = TOPK_ROW_PTR(ra);
#pragma unroll
                for (int q = 0; q < 4; ++q) tx0[q] = sp[q]; }
            if (t1) { const f32x4* sp = TOPK_ROW_PTR(rb);
#pragma unroll
                for (int q = 0; q < 4; ++q) tx1[q] = sp[q]; }
            bf16x8 qc[2][4];
#pragma unroll
            for (int p = 0; p < 2; ++p)
#pragma unroll
                for (int ks = 0; ks < 4; ++ks) qc[p][ks] = qn[p][ks];
            const int bn = b + 8 * nwh;
            if (bn < 2048) {
#pragma unroll
                for (int p = 0; p < 2; ++p)
#pragma unroll
                    for (int ks = 0; ks < 4; ++ks) qn[p][ks] = *(const bf16x8*)(Q + (size_t)(bn * 16 + fr) * 2048 + h * 256 + p * 128 + ks * 32 + fq * 8);
            }
            peer_topk_wave(qc, KL, sel_e, sel_g, b * 16, h, lane, scr);
            if (t0) TOPK_ROW_STORE(ra, tx0);
            if (t1) TOPK_ROW_STORE(rb, tx1);
            trow += 2 * NGW;
        }
#pragma unroll 1
        for (; trow < 32768; trow += NGW) { f32x4 tx0[4]; const f32x4* sp = TOPK_ROW_PTR(trow);
#pragma unroll
            for (int q = 0; q < 4; ++q) tx0[q] = sp[q];
            TOPK_ROW_STORE(trow, tx0); }
#undef TOPK_ROW_PTR
#undef TOPK_ROW_STORE
    }
}

typedef float f32x2 __attribute__((ext_vector_type(2)));
template <int CTRL> __device__ __forceinline__ float dppf(float v) { return __uint_as_float((unsigned)__builtin_amdgcn_update_dpp(0, (int)__float_as_uint(v), CTRL, 0xf, 0xf, true)); }
typedef int i32x8 __attribute__((ext_vector_type(8)));
constexpr int GA_SE_OFF = 0, GA_AW_OFF = 32768;
constexpr int GA_IMG_OFF = 0, GA_IMG_WAVE = 16384;
constexpr int GA_WA_OFF = 131072 + 1024, GA_WS_OFF = GA_WA_OFF + 24576;
constexpr int GA_GATE_OFF = GA_WS_OFF + 512;
static_assert(GA_GATE_OFF + 4096 <= LDS_BYTES, "gather LDS map");
static_assert(GA_IMG_OFF + 8 * GA_IMG_WAVE <= LDSCTL_OFF && GA_WS_OFF + 512 <= LDS_BYTES, "gather LDS map");
typedef __amdgpu_buffer_rsrc_t brsrc_t;
__device__ __forceinline__ brsrc_t ga_rsrc(const unsigned char* tab) { return __builtin_amdgcn_make_buffer_rsrc((void*)tab, 0, 8 << 20, 0x00020000); }
__device__ __forceinline__ void ga_issue8(u32x4 (&rw)[8], brsrc_t tab, const LAS unsigned short* sep, unsigned so) {
#pragma unroll
    for (int i = 0; i < 8; ++i) { const unsigned e = sep[8 * i]; rw[i] = __builtin_amdgcn_raw_buffer_load_b128(tab, (int)((e << 7) + so), 0, 0); }
}
__device__ __forceinline__ void ga_down8(u32x4 (&rw)[8], const u32x4 hhi, const u32x4 hlo, LAS float* awp, bool c0, brsrc_t tab, const LAS unsigned short* sepn, unsigned son) {
    float d[8];
#pragma unroll
    for (int i = 0; i < 8; ++i) { int ahi = 0, alo = 0;
        const unsigned en = sepn[8 * i];
#pragma unroll
        for (int q = 0; q < 4; ++q) { ahi = __builtin_amdgcn_sdot8((int)rw[i][q], (int)hhi[q], ahi, false); alo = __builtin_amdgcn_sdot8((int)rw[i][q], (int)hlo[q], alo, false); }
        d[i] = (float)(ahi * 16 + alo);
        rw[i] = __builtin_amdgcn_raw_buffer_load_b128(tab, (int)((en << 7) + son), 0, 0);
        __builtin_amdgcn_sched_barrier(0); }
#pragma unroll
    for (int i = 0; i < 8; ++i) d[i] += dppf<0xB1>(d[i]);
#pragma unroll
    for (int i = 0; i < 8; ++i) d[i] += dppf<0x4E>(d[i]);
#pragma unroll
    for (int i = 0; i < 8; ++i) d[i] += dppf<0x141>(d[i]);
    if (c0) { float o[8];
#pragma unroll
        for (int i = 0; i < 8; ++i) o[i] = awp[8 * i];
#pragma unroll
        for (int i = 0; i < 8; ++i) awp[8 * i] = o[i] + d[i]; }
}
template <bool FINAL>
__device__ __forceinline__ void ga_norm16(const bf16* xs, float* fout, bf16* H, const float* ng, const float* modsN, const size_t t0, const int lane) {
    f32x4 gsc[4], gsh[4];
#pragma unroll
    for (int j = 0; j < 4; ++j) { const f32x4 gg = ((const f32x4*)ng)[lane + 64 * j];
        if (FINAL) { gsc[j] = gg; gsh[j] = (f32x4){0.f, 0.f, 0.f, 0.f}; }
        else { const float* mp = modsN + (size_t)(t0 >> 11) * 6144; const f32x4 a = ((const f32x4*)mp)[lane + 64 * j], b = ((const f32x4*)(mp + 1024))[lane + 64 * j]; gsc[j] = gg * (b + 1.0f); gsh[j] = a; } }
#pragma unroll 1
    for (int tg = 0; tg < 16; tg += 4) {
        f32x4 xv[4][4];
#pragma unroll
        for (int q = 0; q < 4; ++q)
#pragma unroll
            for (int j = 0; j < 4; ++j) { const u32x2 w = ((const u32x2*)(xs + (t0 + tg + q) * 1024))[lane + 64 * j]; xv[q][j] = (f32x4){bf_lo(w.x), bf_hi(w.x), bf_lo(w.y), bf_hi(w.y)}; }
        float ss[4];
#pragma unroll
        for (int q = 0; q < 4; ++q) { ss[q] = 0.f;
#pragma unroll
            for (int j = 0; j < 4; ++j) ss[q] += (xv[q][j].x * xv[q][j].x + xv[q][j].y * xv[q][j].y) + (xv[q][j].z * xv[q][j].z + xv[q][j].w * xv[q][j].w); }
#pragma unroll
        for (int q = 0; q < 4; ++q) ss[q] = wave_sum(ss[q]);
#pragma unroll
        for (int q = 0; q < 4; ++q) { const float rn = 1.0f / sqrtf(ss[q] * (1.f / 1024.f) + 1e-6f); const size_t t = t0 + tg + q;
            if (FINAL) {
#pragma unroll
                for (int j = 0; j < 4; ++j) ((f32x4*)(fout + t * 1024))[lane + 64 * j] = xv[q][j] * rn * gsc[j];
            } else { u32x2* o8 = (u32x2*)(H + t * 1024) + lane;
#pragma unroll
                for (int j = 0; j < 4; ++j) { const f32x4 y = (xv[q][j] * rn) * gsc[j] + gsh[j]; u32x2 w; w.x = cvt_pk(y.x, y.y); w.y = cvt_pk(y.z, y.w); o8[64 * j] = w; } } }
    }
}
__device__ __forceinline__ float erf_as(float x) {
    const float ax = fabsf(x), t = 1.0f / __builtin_fmaf(0.3275911f, ax, 1.0f);
    float p = __builtin_fmaf(1.061405429f, t, -1.453152027f); p = __builtin_fmaf(p, t, 1.421413741f); p = __builtin_fmaf(p, t, -0.284496736f); p = __builtin_fmaf(p, t, 0.254829592f);
    const float y = 1.0f - p * t * __expf(-ax * ax);
    return copysignf(y, x);
}
template <bool FINAL>
__device__ __forceinline__ void phase_gather(LAS unsigned char* lds, bf16* H, const unsigned char* HQ, const float* HS, const int* sel_e, const float* sel_g, const unsigned char* down4, const unsigned char* up4, const float* sdown, const float* sup,
                                             const float* modsL, bf16* xs, float* fout, const float* ng, const float* modsN, int G, int wg, int mode) {
    const bool dummy = (mode & 1) != 0;
    const int tid = threadIdx.x, lane = tid & 63, wave = __builtin_amdgcn_readfirstlane(tid >> 6);
    const int r = lane >> 3, c = lane & 7;
    LAS unsigned short* SE = (LAS unsigned short*)(lds + GA_SE_OFF);
    LAS float* AW = (LAS float*)(lds + GA_AW_OFF);
#pragma unroll 1
    for (int blk = wg; blk < NTOK / 128; blk += G) {
        const int tb = blk * 128;
        { typedef int i32x4 __attribute__((ext_vector_type(4))); i32x4 ev[8];
#pragma unroll
            for (int k = 0; k < 8; ++k) ev[k] = ((const i32x4*)(sel_e + (size_t)tb * 128))[tid + 512 * k];
            asm volatile("" : "+v"(ev[0]), "+v"(ev[1]), "+v"(ev[2]), "+v"(ev[3]), "+v"(ev[4]), "+v"(ev[5]), "+v"(ev[6]), "+v"(ev[7]));
#pragma unroll
            for (int k = 0; k < 8; ++k) { const int i = tid + 512 * k; const i32x4 e = ev[k];
                u32x2 w; w.x = (unsigned)e.x | ((unsigned)e.y << 16); w.y = (unsigned)e.z | ((unsigned)e.w << 16); ((LAS u32x2*)SE)[i] = w;
                ((LAS f32x4*)AW)[i] = (f32x4){0.f, 0.f, 0.f, 0.f}; } }
        __syncthreads();
        const LAS unsigned short* sew = SE + wave * 2048 + r;
        LAS float* aww = AW + wave * 2048 + r;
        unsigned char* const setw = (unsigned char*)sel_e + (WS_SET - WS_SELE) + ((size_t)tb + wave * 16) * 256 + r * 16;
#pragma unroll
        for (int p = c; p < 32; p += 8) { const LAS unsigned short* sp = sew + (p >> 1) * 128 + 64 * (p & 1);
            u32x4 w; w.x = (unsigned)sp[0] | ((unsigned)sp[8] << 16); w.y = (unsigned)sp[16] | ((unsigned)sp[24] << 16); w.z = (unsigned)sp[32] | ((unsigned)sp[40] << 16); w.w = (unsigned)sp[48] | ((unsigned)sp[56] << 16);
            *(u32x4*)(setw + p * 128) = w; }
        if (!(mode & 4)) {
            u32x4 r0[8], r1[8]; u32x4 hn0, hn1;
            const brsrc_t rsd = ga_rsrc(down4);
            const unsigned char* hqw = HQ + ((size_t)tb + wave * 16) * 1024 + c * 16;
            ga_issue8(r0, rsd, sew, (unsigned)(c * 16)); ga_issue8(r1, rsd, sew + 64, (unsigned)(c * 16));
            hn0 = *(const u32x4*)hqw; hn1 = *(const u32x4*)(hqw + 512);
            asm volatile("" :: "v"(hn0), "v"(hn1));
#pragma unroll 1
            for (int it = 0; it < 64; ++it) {
                const u32x4 hhi = hn0, hlo = hn1;
                const int i1 = (it + 1) & 63; const unsigned so1 = ((unsigned)(i1 >> 4) << 21) + (unsigned)(c * 16);
                { const unsigned char* hx = hqw + (size_t)(i1 & 15) * 1024 + (i1 >> 4) * 128; hn0 = *(const u32x4*)hx; hn1 = *(const u32x4*)(hx + 512); }
                __builtin_amdgcn_sched_barrier(0);
                ga_down8(r0, hhi, hlo, aww + (it & 15) * 128, c == 0, rsd, sew + (i1 & 15) * 128, so1);
                ga_down8(r1, hhi, hlo, aww + (it & 15) * 128 + 64, c == 0, rsd, sew + (i1 & 15) * 128 + 64, so1);
                asm volatile("" :: "v"(hn0), "v"(hn1));
            }
        }
        float wr[32];
        {
            LAS float* SC = (LAS float*)(lds + GA_AW_OFF);
            unsigned ev2[16];
#pragma unroll
            for (int j = 0; j < 32; ++j) { const int idx = wave * 2048 + j * 64 + lane; const unsigned e = SE[idx]; const float* hsp = HS + 2 * ((size_t)tb + (idx >> 7));
                wr[j] = __builtin_fmaf(0.5f, hsp[1], AW[idx]) * hsp[0]; if (j & 1) ev2[j >> 1] |= e << 16; else ev2[j >> 1] = e; }
            __builtin_amdgcn_sched_barrier(0);
            f32x4 st[8];
#pragma unroll
            for (int k = 0; k < 8; ++k) st[k] = ((const f32x4*)sdown)[tid + 512 * k];
            __syncthreads();
#pragma unroll
            for (int k = 0; k < 8; ++k) ((LAS f32x4*)SC)[tid + 512 * k] = st[k];
            __syncthreads();
            __builtin_amdgcn_sched_barrier(0);
            float gq[32];
#pragma unroll
            for (int k = 0; k < 8; ++k) st[k] = ((const f32x4*)sup)[tid + 512 * k];
#pragma unroll
            for (int j = 0; j < 32; ++j) gq[j] = sel_g[(size_t)tb * 128 + wave * 2048 + j * 64 + lane];
            __builtin_amdgcn_sched_barrier(0);
#pragma unroll
            for (int j = 0; j < 32; ++j) { const unsigned e = (j & 1) ? (ev2[j >> 1] >> 16) : (ev2[j >> 1] & 0xffffu); const float x = wr[j] * SC[e];
                wr[j] = 0.5f * x * (1.0f + erf_as(x * 0.70710678118654752f)); }
#pragma unroll
            for (int j = 0; j < 32; j += 8)
                asm volatile("" : "+v"(wr[j]), "+v"(wr[j + 1]), "+v"(wr[j + 2]), "+v"(wr[j + 3]), "+v"(wr[j + 4]), "+v"(wr[j + 5]), "+v"(wr[j + 6]), "+v"(wr[j + 7]));
            __builtin_amdgcn_sched_barrier(0);
            __syncthreads();
#pragma unroll
            for (int k = 0; k < 8; ++k) ((LAS f32x4*)SC)[tid + 512 * k] = st[k];
            if (tid < 256) ((LAS f32x4*)(lds + GA_GATE_OFF))[tid] = ((const f32x4*)(modsL + (size_t)(tb >> 11) * 6144 + 5 * 1024))[tid];
            __syncthreads();
            __builtin_amdgcn_sched_barrier(0);
#pragma unroll
            for (int j = 0; j < 32; ++j) { const int idx = wave * 2048 + j * 64 + lane; const unsigned e = (j & 1) ? (ev2[j >> 1] >> 16) : (ev2[j >> 1] & 0xffffu);
                const float g = gq[j]; wr[j] = dummy ? 0.f : wr[j] * (((mode & 2) ? -g : g) * SC[e]); }
#pragma unroll
            for (int j = 0; j < 32; j += 8)
                asm volatile("" : "+v"(wr[j]), "+v"(wr[j + 1]), "+v"(wr[j + 2]), "+v"(wr[j + 3]), "+v"(wr[j + 4]), "+v"(wr[j + 5]), "+v"(wr[j + 6]), "+v"(wr[j + 7]));
        }
        __syncthreads();
        {
            LAS unsigned char* WA = lds + GA_WA_OFF + wave * 3072; LAS float* WS = (LAS float*)(lds + GA_WS_OFF) + wave * 16;
#pragma unroll
            for (int tk = 0; tk < 16; ++tk) {
                float m = fmaxf(fabsf(wr[2 * tk]), fabsf(wr[2 * tk + 1]));
                m = wave_max(m);
                const float inv = m > 0.f ? 6.0f / m : 0.f;
                if (lane == 0) WS[tk] = m * (1.0f / 6.0f);
#pragma unroll
                for (int hf = 0; hf < 2; ++hf) {
                    const float y = wr[2 * tk + hf] * inv;
                    const unsigned p1 = __builtin_amdgcn_cvt_scalef32_pk_fp4_f32(0u, y, 0.f, 1.0f, 0) & 15u; const float v1 = __builtin_amdgcn_cvt_scalef32_pk_f32_fp4(p1, 1.0f, 0)[0];
                    const float r1 = (y - v1) * 4.0f;
                    const unsigned p2 = __builtin_amdgcn_cvt_scalef32_pk_fp4_f32(0u, r1, 0.f, 1.0f, 0) & 15u; const float v2 = __builtin_amdgcn_cvt_scalef32_pk_f32_fp4(p2, 1.0f, 0)[0];
                    const float r2 = (r1 - v2) * 4.0f;
                    const unsigned p3 = __builtin_amdgcn_cvt_scalef32_pk_fp4_f32(0u, r2, 0.f, 1.0f, 0) & 15u;
                    const unsigned mine = p1 | (p2 << 8) | (p3 << 16);
                    const unsigned other = (unsigned)__builtin_amdgcn_update_dpp(0, (int)mine, 0xB1, 0xf, 0xf, true);
                    const unsigned both = mine | (other << 4);
                    if ((lane & 1) == 0) { LAS unsigned char* wp = WA + tk * 192 + hf * 96 + (lane >> 1);
                        wp[0] = (unsigned char)both; wp[32] = (unsigned char)(both >> 8); wp[64] = (unsigned char)(both >> 16); }
                }
            }
        }
        if (!(mode & 8)) {
            LAS unsigned char* img = lds + GA_IMG_OFF + wave * GA_IMG_WAVE;
            const int ir = 4 * (lane >> 5) + ((lane >> 3) & 1), rr = lane & 7;
            const unsigned rdo = (unsigned)(1024 * ir + 128 * rr + 8 * ((lane >> 4) & 1) + 16 * ((rr >> 1) | ((ir & 1) << 2)));
            const LAS unsigned char* WA = lds + GA_WA_OFF + wave * 3072 + (lane >> 5) * 16 + (lane & 31) * 32;
            const LAS float* WS = (const LAS float*)(lds + GA_WS_OFF) + wave * 16;
            const bool arow = (lane & 31) < 3;
            const brsrc_t rsu = ga_rsrc(up4);
            const unsigned ce16 = 16u * (unsigned)(c ^ (r >> 1));
            const unsigned char* const setr = setw;
#define GA_DMA8(se, buf, so) do { _Pragma("unroll") for (int i = 0; i < 8; ++i) { const unsigned en = ((i & 1) ? ((se)[i >> 1] >> 16) : ((se)[i >> 1] & 0xffffu)); \
                __builtin_amdgcn_raw_ptr_buffer_load_lds(rsu, (__attribute__((address_space(3))) void*)(img + (buf) * 8192 + i * 1024), 16, (int)((en << 7) + ((so) ^ (64u * (i & 1)))), 0, 0, 0); } } while (0)
#define GA_WAITV(n) asm volatile("s_waitcnt vmcnt(" #n ")" ::: "memory")
            const unsigned rda = (unsigned)(__UINTPTR_TYPE__)img + rdo, waa = (unsigned)(__UINTPTR_TYPE__)WA;
            float wsv; { const unsigned a = (unsigned)(__UINTPTR_TYPE__)(WS + (lane & 15)); asm volatile("ds_read_b32 %0, %1\n\ts_waitcnt lgkmcnt(0)" : "=v"(wsv) : "v"(a) : "memory"); }
            u32x4 seA = *(const u32x4*)setr, seB = *(const u32x4*)(setr + 128);
            { const u32x4 seC = *(const u32x4*)(setr + 256);
                GA_DMA8(seA, 0, ce16); GA_DMA8(seB, 1, ce16); seA = seC; }
            float acc8[8], x0[4], g0[4];
#pragma unroll 1
            for (int it = 0; it < 64; ++it) {
                const size_t t = (size_t)tb + wave * 16 + (it & 15); const int col = (it >> 4) * 256 + 128 * (lane >> 5) + (lane & 31);
                bf16* xp = xs + t * 1024 + col;
#pragma unroll
                for (int hf = 0; hf < 2; ++hf) {
                    GA_WAITV(8);
                    __builtin_amdgcn_sched_barrier(0);
                    typedef int i32x2_t __attribute__((ext_vector_type(2)));
                    i32x2_t b0[8], b1[8]; u32x4 wa;
                    { const unsigned a = waa + (unsigned)((it & 15) * 192 + hf * 96); asm volatile("ds_read_b128 %0, %1" : "=v"(wa) : "v"(a) : "memory"); }
                    if (hf == 0) {
                        const unsigned ga = (unsigned)(__UINTPTR_TYPE__)(lds + GA_GATE_OFF) + 4u * (unsigned)col;
                        asm volatile("ds_read_b32 %0, %4\n\tds_read_b32 %1, %4 offset:128\n\tds_read_b32 %2, %4 offset:256\n\tds_read_b32 %3, %4 offset:384"
                                     : "=v"(g0[0]), "=v"(g0[1]), "=v"(g0[2]), "=v"(g0[3]) : "v"(ga) : "memory"); }
#pragma unroll
                    for (int cb = 0; cb < 8; ++cb) { const unsigned a = (rda ^ (unsigned)(16 * cb)) + (unsigned)(hf * 8192);
                        asm volatile("ds_read_b64_tr_b4 %0, %1" : "=v"(b0[cb]) : "v"(a) : "memory");
                        asm volatile("ds_read_b64_tr_b4 %0, %1 offset:2048" : "=v"(b1[cb]) : "v"(a) : "memory"); }
                    asm volatile("s_waitcnt lgkmcnt(0)" : "+v"(b0[0]), "+v"(b0[1]), "+v"(b0[2]), "+v"(b0[3]), "+v"(b0[4]), "+v"(b0[5]), "+v"(b0[6]), "+v"(b0[7]) :: "memory");
                    asm volatile("" : "+v"(b1[0]), "+v"(b1[1]), "+v"(b1[2]), "+v"(b1[3]), "+v"(b1[4]), "+v"(b1[5]), "+v"(b1[6]), "+v"(b1[7]) :: "memory");
                    asm volatile("" : "+v"(wa) :: "memory");
                    if (hf == 0) asm volatile("" : "+v"(g0[0]), "+v"(g0[1]), "+v"(g0[2]), "+v"(g0[3]) :: "memory");
                    __builtin_amdgcn_sched_barrier(0);
                    const int itn = (it + 1) & 63; const unsigned son = ((unsigned)(itn >> 4) << 21) + ce16;
                    if (hf == 0) {
#pragma unroll
                        for (int j = 0; j < 4; ++j) x0[j] = __uint_as_float((unsigned)xp[32 * j] << 16);
                        seB = *(const u32x4*)(setr + (size_t)(itn & 15) * 256 + 128);
                        __builtin_amdgcn_sched_barrier(0);
                        GA_DMA8(seA, 0, son);
                    } else {
                        seA = *(const u32x4*)(setr + (size_t)((it + 2) & 15) * 256);
                        __builtin_amdgcn_sched_barrier(0);
                        GA_DMA8(seB, 1, son);
                    }
                    __builtin_amdgcn_sched_barrier(0);
                    i32x8 av; av[0] = arow ? (int)wa[0] : 0; av[1] = arow ? (int)wa[1] : 0; av[2] = arow ? (int)wa[2] : 0; av[3] = arow ? (int)wa[3] : 0; av[4] = 0; av[5] = 0; av[6] = 0; av[7] = 0;
#pragma unroll
                    for (int cb = 0; cb < 8; ++cb) {
                        i32x8 bv; bv[0] = b0[cb][0]; bv[1] = b0[cb][1]; bv[2] = b1[cb][0]; bv[3] = b1[cb][1]; bv[4] = 0; bv[5] = 0; bv[6] = 0; bv[7] = 0;
                        f32x16 dz;
#pragma unroll
                        for (int v = 0; v < 16; ++v) dz[v] = 0.f;
                        dz = __builtin_amdgcn_mfma_scale_f32_32x32x64_f8f6f4(av, bv, dz, 4, 4, 0, 0x7f7f7f7f, 0, 0x7f7f7f7f);
                        const float sdz = dz[0] + 0.25f * dz[1] + 0.0625f * dz[2];
                        acc8[cb] = hf ? acc8[cb] + sdz : sdz;
                    }
                    asm volatile("" : "+v"(acc8[0]), "+v"(acc8[1]), "+v"(acc8[2]), "+v"(acc8[3]), "+v"(acc8[4]), "+v"(acc8[5]), "+v"(acc8[6]), "+v"(acc8[7]));
                    if (hf == 1) { const float sw = __builtin_bit_cast(float, __builtin_amdgcn_readlane(__builtin_bit_cast(int, wsv), it & 15));
#pragma unroll
                        for (int j = 0; j < 4; ++j) { const u32x2 p = __builtin_amdgcn_permlane32_swap(__float_as_uint(acc8[j]), __float_as_uint(acc8[j + 4]), false, false);
                            xp[32 * j] = (bf16)(cvt_pk(x0[j] + g0[j] * (sw * __uint_as_float(p.x)), 0.f) & 0xffffu); } }
                    __builtin_amdgcn_sched_barrier(0);
                }
            }
            GA_WAITV(0);
        }
        if (!(mode & 16)) ga_norm16<FINAL>(xs, fout, H, ng, modsN, (size_t)tb + wave * 16, lane);
        __syncthreads();
    }
}

__device__ __forceinline__ void phase_conv(const bf16* BGU, const float* cw, bf16* Z, int G, int wg) {
    constexpr int R = 32;
#pragma unroll 1
    for (int cgi = wg * 512 + threadIdx.x; cgi < (NTOK / R) * 128; cgi += G * 512) {
        const int d0 = (cgi & 127) * 8, t0 = (cgi >> 7) * R, n0 = t0 & 2047;
        float w[3][8];
#pragma unroll
        for (int k = 0; k < 3; ++k) { const f32x4 w0 = *(const f32x4*)(cw + k * 1024 + d0), w1 = *(const f32x4*)(cw + k * 1024 + d0 + 4);
#pragma unroll
            for (int z = 0; z < 4; ++z) { w[k][z] = w0[z]; w[k][4 + z] = w1[z]; } }
        const bf16* bb = BGU + (size_t)t0 * 2048 + d0; const bf16* ub = bb + 1024;
        bf16* zp = Z + (size_t)t0 * 1024 + d0;
        const u32x4 zero = (u32x4){0u, 0u, 0u, 0u};
        u32x4 up = n0 == 0 ? zero : *(const u32x4*)(ub - 2048), uc = *(const u32x4*)ub;
        u32x4 un[4], bgn[4];
#pragma unroll
        for (int k = 0; k < 4; ++k) { un[k] = *(const u32x4*)(ub + (size_t)(k + 1) * 2048); bgn[k] = *(const u32x4*)(bb + (size_t)k * 2048); }
#pragma unroll 1
        for (int g = 0; g < R / 4; ++g) {
            u32x4 u1[4], bg[4];
#pragma unroll
            for (int k = 0; k < 4; ++k) { u1[k] = un[k]; bg[k] = bgn[k]; }
            if (g + 1 < R / 4) {
#pragma unroll
                for (int k = 0; k < 4; ++k) { const int tk = 4 * (g + 1) + k;
                    un[k] = (n0 + tk + 1 < 2048) ? *(const u32x4*)(ub + (size_t)(tk + 1) * 2048) : zero; bgn[k] = *(const u32x4*)(bb + (size_t)tk * 2048); }
            }
#pragma unroll
            for (int k = 0; k < 4; ++k) {
                u32x4 o;
#pragma unroll
                for (int q = 0; q < 4; ++q) {
                    const float yl = w[0][2 * q] * bf_lo(up[q]) + w[1][2 * q] * bf_lo(uc[q]) + w[2][2 * q] * bf_lo(u1[k][q]);
                    const float yh = w[0][2 * q + 1] * bf_hi(up[q]) + w[1][2 * q + 1] * bf_hi(uc[q]) + w[2][2 * q + 1] * bf_hi(u1[k][q]);
                    o[q] = cvt_pk(bf_lo(bg[k][q]) * yl, bf_hi(bg[k][q]) * yh); }
                *(u32x4*)(zp + (size_t)(4 * g + k) * 1024) = o;
                up = uc; uc = u1[k];
            }
        }
    }
}

__global__ void __launch_bounds__(NWAVES * 64, 2) fwd(Args args) {
    extern __shared__ __attribute__((aligned(16))) unsigned char lds_raw[];
    LAS unsigned char* lds = (LAS unsigned char*)lds_raw;
    const int tid = threadIdx.x, lane = tid & 63, wave = __builtin_amdgcn_readfirstlane(tid >> 6);
    const int G = gridDim.x, wg = blockIdx.x;
    const int gw = wg * NWAVES + wave, NGW = G * NWAVES;
    unsigned char* ws = args.ws;
    unsigned* ctl = (unsigned*)(ws + WS_CTL);
    for (int u = tid; u < (LDS_BYTES - LDSCTL_OFF) / 4; u += NWAVES * 64) ((LAS unsigned*)(lds + LDSCTL_OFF))[u] = 0u;
    __syncthreads();
    XcdBarrier bar; bar.bar = ctl + CW_BAR; bar.x = 0; bar.st = nullptr;
    if (N_LAUNCHES == 1) bar = xcd_barrier_post(ctl + CW_BAR, (volatile LAS unsigned*)(lds + MISC_OFF) + 8);
#define GRID_BAR() do { if (N_LAUNCHES == 1) xcd_barrier(bar); } while (0)
    const int lo = args.ph_lo, hi = args.ph_hi;
#ifndef PHASE_MASK
#define PHASE_MASK 0xffff
#endif
#define IN(k) (((PHASE_MASK >> (k)) & 1) && lo <= (k) && (k) < hi)
#define BOTH(k) (IN(k) && IN((k) + 1))
    const float* mods = (const float*)(ws + WS_MOD);
    float* xout = args.out; bf16* XS = (bf16*)(ws + WS_XS);
    bf16* H = (bf16*)(ws + WS_H);

    if (IN(0)) { for (int rep = 0; rep < NREP(0); ++rep) { phase_prep(args, lds, G, wg, rep, 0); __syncthreads(); } if (BOTH(0)) GRID_BAR(); }
    if (IN(1)) { for (int rep = 0; rep < ((PROBE_PHASE == 1 && PROBE_SUB == 1) ? 2 : 1); ++rep) { phase_prep(args, lds, G, wg, 0, 1); __syncthreads(); }
                 for (int rep = 0; rep < ((PROBE_PHASE == 1 && PROBE_SUB == 0) ? 2 : 1); ++rep) phase_norm<false>(args.in[0], args.in[2], args.in[6], mods, 0, H, nullptr, nullptr, nullptr, G, wg);
                 for (int rep = 0; rep < ((PROBE_PHASE == 1 && PROBE_SUB == 2) ? 2 : 1); ++rep) phase_wq8(args.in[16], (const float*)((const unsigned*)(ws + WS_CTL) + CW_COLMAX), ws + WS_WQ_T, lds, G, wg);
                 if (BOTH(1)) GRID_BAR(); }
    if (IN(2)) {
        for (int rep = 0; rep < NREP(2); ++rep) {
        { pg8::Gemm g{H, (const bf16*)(ws + WS_WIN_T), NTT, 1024, 1024, (const bf16*)(ws + WS_WIN_T) + (size_t)1024 * 1024, H}; pg8::DualOrder S; S.init(NTT, 1024, 1024, NTT, G, wg);
          pg8::EpiQKVF E{pg8::EpiBf16{(bf16*)(ws + WS_QK), 1024, 2, 0.125f}, pg8::EpiVF{(bf16*)(ws + WS_VT), (bf16*)(ws + WS_VTC), (bf16*)(ws + WS_FT)}};
          pg8::gemm_phase<pg8::EpiQKVF, pg8::DualOrder, true, true>(lds + RING_OFF, g, S, E); }
        }
        if (BOTH(2)) GRID_BAR();
    }
    if (IN(3)) {
        { LAS float* rpl = (LAS float*)(lds + NWAVES * ATT_WAVE_LDS); for (int e = tid; e < 8 * 15 * 31; e += NWAVES * 64) rpl[e] = args.in[11][e]; __syncthreads();
          for (int rep = 0; rep < ((PROBE_PHASE == 3 && PROBE_SUB != 2) ? 2 : 1); ++rep)
          for (int u0 = wg; u0 < 1024; u0 += G) {
              int u = u0; if (G == 256) { const int xcd = wg & 7, idx = wg >> 3, round = u0 >> 8; u = ((xcd * 16 + round * 4 + (idx >> 3)) << 3) | (idx & 7); }
              const int b = u >> 6, h = (u >> 3) & 7, rq = u & 7;
              na_attn32_wave((const bf16*)(ws + WS_QK), (const bf16*)(ws + WS_VT), (const bf16*)(ws + WS_VTC), rpl + h * 465, lds + wave * ATT_WAVE_LDS, (bf16*)(ws + WS_A2), b, h, 4 * rq + 2 * (wave >> 2), wave & 3, lane);
          } }
        __syncthreads();
        for (int task0 = gw; task0 < 16 * 512; task0 += 4 * NGW) {
            u32x4 fv[4][4];
#pragma unroll
            for (int i = 0; i < 4; ++i) { const int task = min(task0 + i * NGW, 16 * 512 - 1); const bf16* fp = (const bf16*)(ws + WS_FT) + (size_t)task * 2048 + lane * 32;
#pragma unroll
                for (int q = 0; q < 4; ++q) fv[i][q] = *(const u32x4*)(fp + 8 * q); }
            float sacc[4];
#pragma unroll
            for (int i = 0; i < 4; ++i) { sacc[i] = 0.f;
#pragma unroll
                for (int q = 0; q < 4; ++q)
#pragma unroll
                    for (int z = 0; z < 4; ++z) sacc[i] += bf_lo(fv[i][q][z]) - bf_hi(fv[i][q][z]); }
#pragma unroll
            for (int i = 0; i < 4; ++i) sacc[i] = wave_sum(sacc[i]);
#pragma unroll
            for (int i = 0; i < 4; ++i) { const int task = task0 + i * NGW;
                if (lane == 0 && task < 16 * 512) { bf16* op = (bf16*)(ws + WS_A2) + ((size_t)(task >> 9) * 2048 + 1024) * 1536 + 512 + (task & 511); op[0] = (bf16)(cvt_pk(sacc[i], 0.f) & 0xffffu); op[512] = 0; } }
        }
        { pg8::Gemm g{(const bf16*)(ws + WS_DFT), (const bf16*)(ws + WS_FT), 2048, 8192, 2048}; pg8::StaticOrder S; S.init(2048, 8192, G, wg);
          pg8::EpiDft E{(bf16*)(ws + WS_A2)};
          pg8::gemm_phase<pg8::EpiDft, pg8::StaticOrder, true, true>(lds + RING_OFF, g, S, E);
          if (PROBE_PHASE == 3 && PROBE_SUB != 1) pg8::gemm_phase<pg8::EpiDft, pg8::StaticOrder, true, true>(lds + RING_OFF, g, S, E); }
        if (BOTH(3)) GRID_BAR();
    }
    if (IN(4)) {
        pg8::Gemm g{(const bf16*)(ws + WS_A2), (const bf16*)(ws + WS_WOUT_T), NTOK, 1024, 1536}; pg8::StaticOrder S; S.init(NTOK, 1024, G, wg);
        pg8::EpiResB<true> E{args.in[0], XS, mods + 2 * 1024, 6144, 1.f};
        pg8::gemm_phase<pg8::EpiResB<true>, pg8::StaticOrder, true, true>(lds + RING_OFF, g, S, E); if (PROBE_PHASE == 4) pg8::gemm_phase<pg8::EpiResB<true>, pg8::StaticOrder, true, true>(lds + RING_OFF, g, S, E);
        if (BOTH(4)) GRID_BAR();
    }
#define PEER_LAYER(L, pb) do { \
        const float* modsL = mods + (size_t)(L) * 17 * 6144; \
        if (IN(pb)) { for (int rep = 0; rep < NREP(pb); ++rep) phase_norm<true>(XS, nullptr, args.in[7] + (L) * 1024, modsL, 3, nullptr, ws + WS_HQ, ws + WS_HQ8, (float*)(ws + WS_HS), G, wg); if (BOTH(pb)) GRID_BAR(); } \
        if (IN((pb) + 1)) { \
              \
            pg8::Gemm g{(const bf16*)(ws + WS_HQ8), (const bf16*)(ws + WS_WQ_T) + (size_t)(L) * 2048 * 512, NTOK, 2048, 512}; pg8::StaticOrder S; S.init(NTOK, 2048, G, wg); \
            pg8::EpiQ8 E{(bf16*)(ws + WS_PQ), (const float*)(ws + WS_HS), (const float*)((const unsigned*)(ws + WS_CTL) + CW_COLMAX) + (L) * 2048}; \
            pg8::gemm_phase<pg8::EpiQ8, pg8::StaticOrder, true, true>(lds + RING_OFF, g, S, E); if (PROBE_PHASE == (pb) + 1) pg8::gemm_phase<pg8::EpiQ8, pg8::StaticOrder, true, true>(lds + RING_OFF, g, S, E); \
            if (BOTH((pb) + 1)) GRID_BAR(); \
        } \
        if (IN((pb) + 2)) { \
            const bf16* KEYS = (const bf16*)(ws + WS_KEYS) + (size_t)(L) * 8 * 2 * 128 * 128; \
            for (int rep = 0; rep < NREP((pb) + 2); ++rep) phase_topk(lds, (const bf16*)(ws + WS_PQ), KEYS, (int*)(ws + WS_SELE), (float*)(ws + WS_SELG), args.in[18] + (size_t)(L) * 16384 * 1024, args.in[19] + (size_t)(L) * 16384 * 1024, ws + WS_TAB + (size_t)(2 * (L)) * 8 * MiB, (float*)(ws + WS_TSC) + (2 * (L)) * 16384, G, wg); \
            if (BOTH((pb) + 2)) GRID_BAR(); \
        } \
        if (IN((pb) + 3)) { \
            const unsigned char* down8 = ws + WS_TAB + (size_t)(2 * (L)) * 8 * MiB; const unsigned char* up8 = ws + WS_TAB + (size_t)(2 * (L) + 1) * 8 * MiB; \
            const float* sdn = (const float*)(ws + WS_TSC) + (2 * (L)) * 16384; const float* sup = sdn + 16384; \
            for (int grep_ = 0; grep_ < ((PROBE_PHASE == (pb) + 3 && PROBE_SUB >= 3) ? 3 : 1); ++grep_) { const int GMODE = (PROBE_PHASE != (pb) + 3 || PROBE_SUB < 3) ? 0 : (PROBE_SUB == 3) ? ((grep_ == 1) ? 2 : 0) : (PROBE_SUB == 4) ? (((grep_ == 1) ? 2 : 0) | (grep_ < 2 ? 16 : 0)) : (grep_ < 2 ? 12 : 0); \
            if ((L) == 0) phase_gather<false>(lds, H, ws + WS_HQ, (const float*)(ws + WS_HS), (const int*)(ws + WS_SELE), (const float*)(ws + WS_SELG), down8, up8, sdn, sup, modsL, XS, xout, args.in[6] + 1024, mods + (size_t)17 * 6144, G, wg, GMODE); \
            else phase_gather<true>(lds, H, ws + WS_HQ, (const float*)(ws + WS_HS), (const int*)(ws + WS_SELE), (const float*)(ws + WS_SELG), down8, up8, sdn, sup, modsL, XS, xout, args.in[8], nullptr, G, wg, GMODE); } \
            if (PROBE_PHASE == (pb) + 3 && PROBE_SUB < 3) phase_gather<true>(lds, H, ws + WS_HQ, (const float*)(ws + WS_HS), (const int*)(ws + WS_SELE), (const float*)(ws + WS_SELG), down8, up8, sdn, sup, modsL, XS, xout, args.in[8], nullptr, G, wg, 17 | (PROBE_SUB == 1 ? 8 : PROBE_SUB == 2 ? 4 : 0)); \
            if (BOTH((pb) + 3)) GRID_BAR(); \
        } } while (0)

    PEER_LAYER(0, 5);
    if (IN(9)) {
        pg8::Gemm g{H, (const bf16*)(ws + WS_CVIN_T), NTOK, 3072, 1024}; pg8::StaticOrder S; S.init(NTOK, 3072, G, wg);
        pg8::EpiCv E{(bf16*)(ws + WS_BCV)};
        pg8::gemm_phase<pg8::EpiCv, pg8::StaticOrder, true, true>(lds + RING_OFF, g, S, E); if (PROBE_PHASE == 9) pg8::gemm_phase<pg8::EpiCv, pg8::StaticOrder, true, true>(lds + RING_OFF, g, S, E);
        if (BOTH(9)) GRID_BAR();
    }
    if (IN(10)) { for (int rep = 0; rep < NREP(10); ++rep) phase_conv((const bf16*)(ws + WS_BCV), args.in[14], H, G, wg); if (BOTH(10)) GRID_BAR(); }
    if (IN(11)) {
        pg8::Gemm g{H, (const bf16*)(ws + WS_CVOUT_T), NTOK, 1024, 1024}; pg8::StaticOrder S; S.init(NTOK, 1024, G, wg);
        pg8::EpiResB<false> E{XS, XS, mods + (size_t)17 * 6144 + 2 * 1024, 6144, 1.f};
        pg8::gemm_phase<pg8::EpiResB<false>, pg8::StaticOrder, true, true>(lds + RING_OFF, g, S, E);
        if (PROBE_PHASE == 11) { pg8::EpiResB<false> E0{XS, XS, mods + (size_t)17 * 6144 + 2 * 1024, 6144, __int_as_float(args.pad)}; pg8::gemm_phase<pg8::EpiResB<false>, pg8::StaticOrder, true, true>(lds + RING_OFF, g, S, E0); }
        if (BOTH(11)) GRID_BAR();
    }
    PEER_LAYER(1, 12);
#undef PEER_LAYER
#undef IN
#undef BOTH
#undef GRID_BAR
}

extern "C" void kernel_launch(void* const* d_in, const int* in_sizes, int n_in, void* d_out, int out_size, void* d_ws, size_t ws_size, hipStream_t stream) {
    static int grid = 0;
    if (grid == 0) {
        if (n_in != 20 || out_size != NTOK * D || ws_size < WS_END) { fprintf(stderr, "kernel_launch: unexpected shapes (n_in %d, out %d, ws %zu); nothing launched\n", n_in, out_size, ws_size); grid = -1; return; }
        int dev = 0, cus = 0;
        if (hipGetDevice(&dev) != hipSuccess || hipDeviceGetAttribute(&cus, hipDeviceAttributeMultiprocessorCount, dev) != hipSuccess) { grid = -1; return; }
        if (hipFuncSetAttribute((const void*)fwd, hipFuncAttributeMaxDynamicSharedMemorySize, LDS_BYTES) != hipSuccess) { fprintf(stderr, "kernel_launch: hipFuncSetAttribute failed\n"); grid = -1; return; }
        int per_cu = 0;
        if (hipOccupancyMaxActiveBlocksPerMultiprocessor(&per_cu, (const void*)fwd, NWAVES * 64, LDS_BYTES) != hipSuccess || per_cu < 1) fprintf(stderr, "kernel_launch: occupancy query reports %d\n", per_cu);
        (void)hipGetLastError();
        grid = cus;
    }
    if (grid < 0) return;
    (void)hipMemsetAsync((char*)d_ws + WS_CTL, 0, CTL_ZERO_BYTES, stream);
    Args a{};
    for (int i = 0; i < 20; ++i) a.in[i] = (const float*)d_in[i];
    a.out = (float*)d_out; a.ws = (unsigned char*)d_ws;
    for (int li = 0; li < N_LAUNCHES; ++li) {
        a.ph_lo = (N_LAUNCHES == 1) ? 0 : li; a.ph_hi = (N_LAUNCHES == 1) ? N_PHASES : li + 1; a.li = li;
        hipLaunchKernelGGL(fwd, dim3(grid), dim3(NWAVES * 64), LDS_BYTES, stream, a);
    }
}
```
